# Optimizing an MI355X kernel written in HIP

```python
import math
import jax, jax.numpy as jnp
from jax import lax
import numpy as np

D_MODEL = 1024
BATCH = 8
SEQ = 4096
DEPTH = 2

GRID_W = 64
CTX_LEN = 256
HEAD_DIM = 64
N_BRANCH = 4
BRANCH_W = D_MODEL // 4
POOL_WINDOWS = (2, 4, 8, 16)
POOL_GROUPS = 4
POOL_GW = BRANCH_W // POOL_GROUPS
DIFF_HEADS = 4
DIFF_DQ = HEAD_DIM // 2
DIFF_DV = HEAD_DIM
NAT_HEADS = 4
NAT_WIN_R = 8
NAT_WIN_C = 16
GQA_HEADS = 4
GQA_KV_HEADS = 2
ROPE_THETA = 10000.0
QBLK = 128
N_GROUPS = 4
EXPERTS_PER_GROUP = 8
N_EXPERTS = N_GROUPS * EXPERTS_PER_GROUP
TOP_K_IN_GROUP = 2
D_EXPERT = 512
RMS_EPS = 1e-6
NEG_INF = -1e30
SPLIT_WIDTHS = (BRANCH_W,
                DIFF_HEADS * HEAD_DIM, DIFF_HEADS * HEAD_DIM, DIFF_HEADS * DIFF_DV,
                NAT_HEADS * HEAD_DIM, NAT_HEADS * HEAD_DIM, NAT_HEADS * HEAD_DIM,
                GQA_HEADS * HEAD_DIM, GQA_KV_HEADS * HEAD_DIM, GQA_KV_HEADS * HEAD_DIM,
                N_BRANCH * D_MODEL)
IN_COLS = sum(SPLIT_WIDTHS)
CTX_KV_IDX = (2, 3, 5, 6, 8, 9)

kernel_name = 'hybrid_pool_diff_nat_gqa_hmoe_dit'


def _rmsnorm(x, g):
    xf = x.astype(jnp.float32)
    y = xf * lax.rsqrt(jnp.mean(xf * xf, axis=-1, keepdims=True) + RMS_EPS)
    return y.astype(x.dtype) * g


def _modulate(x, g, shift, scale):
    return _rmsnorm(x, g) * (1.0 + scale[:, None]) + shift[:, None]


def _split_cols(a):
    outs, o = [], 0
    for w in SPLIT_WIDTHS:
        outs.append(a[..., o:o + w])
        o += w
    return outs


def _rope_1d(x, pos):
    half = x.shape[-1] // 2
    inv = ROPE_THETA ** (-jnp.arange(half, dtype=jnp.float32) / half)
    ang = pos.astype(jnp.float32)[:, None] * inv[None, :]
    cos = jnp.cos(ang).astype(x.dtype)
    sin = jnp.sin(ang).astype(x.dtype)
    x1, x2 = x[..., :half], x[..., half:]
    return jnp.concatenate([x1 * cos - x2 * sin, x1 * sin + x2 * cos], axis=-1)


def _axial_rope(x):
    n, d = x.shape[-2], x.shape[-1]
    t = jnp.arange(n, dtype=jnp.int32)
    h = d // 2
    return jnp.concatenate([_rope_1d(x[..., :h], t // GRID_W), _rope_1d(x[..., h:], t % GRID_W)], axis=-1)


def _heads(a, n_heads):
    b, n, _ = a.shape
    return a.reshape(b, n, n_heads, -1).transpose(0, 2, 1, 3)


def _unheads(o):
    b, h, n, d = o.shape
    return o.transpose(0, 2, 1, 3).reshape(b, n, h * d)


def _sweep_queries(fn, q):
    n = q.shape[-2]
    nb = n // QBLK
    qb = jnp.moveaxis(q.reshape(q.shape[:-2] + (nb, QBLK, q.shape[-1])), -3, 0)
    out = jnp.moveaxis(lax.map(fn, qb), 0, -3)
    return out.reshape(out.shape[:-3] + (n, out.shape[-1]))


def _dense_core(q, k, v, scale):
    s = jnp.einsum('bhqd,bhkd->bhqk', q, k).astype(jnp.float32) * scale
    p = jax.nn.softmax(s, axis=-1)
    return jnp.einsum('bhqk,bhkd->bhqd', p.astype(v.dtype), v)


def _pool_mixer(u, pool_w, pool_scale):
    b, n, ch = u.shape
    cs = jnp.concatenate([jnp.zeros((b, 1, ch), jnp.float32), jnp.cumsum(u.astype(jnp.float32), axis=1)], axis=1)
    win = jnp.repeat(jnp.array(POOL_WINDOWS, jnp.int32), POOL_GW)
    t = jnp.arange(n, dtype=jnp.int32)[:, None]
    lo = jnp.clip(t - win // 2, 0, n)
    hi = jnp.clip(t + win - win // 2, 0, n)
    chan = jnp.arange(ch)[None, :]
    mean = (cs[:, hi, chan] - cs[:, lo, chan]) / (hi - lo).astype(jnp.float32)
    pooled = (mean - u.astype(jnp.float32)).astype(u.dtype)
    y = jnp.einsum('bngc,gcd->bngd', pooled.reshape(b, n, POOL_GROUPS, POOL_GW), pool_w)
    return y.reshape(b, n, ch) * pool_scale


def _diff_core(qb, k, v, lam):
    s = jnp.einsum('bhcqd,bhckd->bhcqk', qb, k).astype(jnp.float32) * (DIFF_DQ ** -0.5)
    p = jax.nn.softmax(s, axis=-1)
    pd = p[:, :, 0] - lam * p[:, :, 1]
    return jnp.einsum('bhqk,bhkd->bhqd', pd.astype(v.dtype), v)


def _diff_attention(q_l, k_l, v_l, q_c, k_c, v_c, lam_p, norm_g, layer, need_ctx):
    lam_init = 0.8 - 0.6 * math.exp(-0.3 * layer)
    lf = lam_p.astype(jnp.float32)
    lam = jnp.exp(jnp.sum(lf[0] * lf[1])) - jnp.exp(jnp.sum(lf[2] * lf[3])) + lam_init

    def qk_heads(a):
        b, n, _ = a.shape
        return a.reshape(b, n, DIFF_HEADS, 2, DIFF_DQ).transpose(0, 2, 3, 1, 4)

    def finish(o, dtype):
        return _unheads(_rmsnorm(o, norm_g) * (1.0 - lam_init)).astype(dtype)

    k_ctx = qk_heads(k_c)
    v_ctx = _heads(v_c, DIFF_HEADS)
    k_all = jnp.concatenate([_axial_rope(qk_heads(k_l)), k_ctx], axis=3)
    v_all = jnp.concatenate([_heads(v_l, DIFF_HEADS), v_ctx], axis=2)
    o_l = _sweep_queries(lambda qb: _diff_core(qb, k_all, v_all, lam), _axial_rope(qk_heads(q_l)))
    y_l = finish(o_l, q_l.dtype)
    y_c = finish(_diff_core(qk_heads(q_c), k_ctx, v_ctx, lam), q_c.dtype) if need_ctx else None
    return y_l, y_c


def _neighbourhood_attention(q_l, k_l, v_l, q_c, k_c, v_c, rpb, need_ctx):
    b, n, _ = q_l.shape
    rows = n // GRID_W
    kr = min(NAT_WIN_R, rows)
    kc = min(NAT_WIN_C, GRID_W)
    scale = HEAD_DIM ** -0.5

    def grid(a):
        return a.reshape(b, rows, GRID_W, NAT_HEADS, HEAD_DIM).transpose(0, 3, 1, 2, 4)

    qg, kg, vg = grid(q_l), grid(k_l), grid(v_l)
    k_ctx, v_ctx = _heads(k_c, NAT_HEADS), _heads(v_c, NAT_HEADS)
    r = jnp.arange(rows, dtype=jnp.int32)
    row_idx = jnp.clip(r - kr // 2, 0, rows - kr)[:, None] + jnp.arange(kr, dtype=jnp.int32)[None, :]
    dr = row_idx - r[:, None] + (NAT_WIN_R - 1)
    j = jnp.arange(GRID_W, dtype=jnp.int32)
    col_start = jnp.clip(j - kc // 2, 0, GRID_W - kc)
    valid = (j[None, :] >= col_start[:, None]) & (j[None, :] < col_start[:, None] + kc)
    dc = jnp.clip(j[None, :] - j[:, None], -(NAT_WIN_C - 1), NAT_WIN_C - 1) + (NAT_WIN_C - 1)

    def row_block(args):
        q_r, ridx, dr_r = args
        kb = kg[:, :, ridx]
        vb = vg[:, :, ridx]
        bias = rpb[:, dr_r[None, :, None], dc[:, None, :]].astype(jnp.float32)
        s_band = jnp.einsum('bhqd,bhnwd->bhqnw', q_r, kb).astype(jnp.float32) * scale + bias[None]
        s_band = jnp.where(valid[:, None, :], s_band, NEG_INF).reshape(b, NAT_HEADS, GRID_W, kr * GRID_W)
        s_ctx = jnp.einsum('bhqd,bhkd->bhqk', q_r, k_ctx).astype(jnp.float32) * scale
        p = jax.nn.softmax(jnp.concatenate([s_band, s_ctx], axis=-1), axis=-1)
        p_band = p[..., :kr * GRID_W].reshape(b, NAT_HEADS, GRID_W, kr, GRID_W).astype(vb.dtype)
        p_ctx = p[..., kr * GRID_W:].astype(v_ctx.dtype)
        return (jnp.einsum('bhqnw,bhnwd->bhqd', p_band, vb)
                + jnp.einsum('bhqk,bhkd->bhqd', p_ctx, v_ctx))

    o = lax.map(row_block, (jnp.moveaxis(qg, 2, 0), row_idx, dr))
    y_l = o.transpose(1, 0, 3, 2, 4).reshape(b, n, NAT_HEADS * HEAD_DIM)
    y_c = _unheads(_dense_core(_heads(q_c, NAT_HEADS), k_ctx, v_ctx, scale)) if need_ctx else None
    return y_l, y_c


def _gqa_core(qb, k, v):
    s = jnp.einsum('bhgqd,bhkd->bhgqk', qb, k).astype(jnp.float32) * (HEAD_DIM ** -0.5)
    p = jax.nn.softmax(s, axis=-1)
    return jnp.einsum('bhgqk,bhkd->bhgqd', p.astype(v.dtype), v)


def _gqa_attention(q_l, k_l, v_l, q_c, k_c, v_c, q_norm, k_norm, need_ctx):
    grp = GQA_HEADS // GQA_KV_HEADS

    def q_heads(a):
        b, n, _ = a.shape
        return _rmsnorm(a.reshape(b, n, GQA_KV_HEADS, grp, HEAD_DIM), q_norm).transpose(0, 2, 3, 1, 4)

    def k_heads(a):
        b, n, _ = a.shape
        return _rmsnorm(a.reshape(b, n, GQA_KV_HEADS, HEAD_DIM), k_norm).transpose(0, 2, 1, 3)

    def merge(o):
        b, h, g, n, d = o.shape
        return o.transpose(0, 3, 1, 2, 4).reshape(b, n, h * g * d)

    k_ctx, v_ctx = k_heads(k_c), _heads(v_c, GQA_KV_HEADS)
    k_all = jnp.concatenate([_axial_rope(k_heads(k_l)), k_ctx], axis=2)
    v_all = jnp.concatenate([_heads(v_l, GQA_KV_HEADS), v_ctx], axis=2)
    y_l = merge(_sweep_queries(lambda qb: _gqa_core(qb, k_all, v_all), _axial_rope(q_heads(q_l))))
    y_c = merge(_gqa_core(q_heads(q_c), k_ctx, v_ctx)) if need_ctx else None
    return y_l, y_c


def _merge_branches(branches, gate_logits, w_branch, w_out):
    b, n, _ = gate_logits.shape
    gates = jax.nn.sigmoid(gate_logits.astype(jnp.float32)).astype(gate_logits.dtype).reshape(b, n, N_BRANCH, D_MODEL)
    merged = gates[:, :, 0] * (branches[0] @ w_branch[0])
    for i in range(1, N_BRANCH):
        merged = merged + gates[:, :, i] * (branches[i] @ w_branch[i])
    return merged @ w_out


def _mixer(h_lat, h_ctx, w_in, pool_w, pool_scale, diff_lam, diff_g, rpb, q_norm, k_norm, w_branch, w_out, layer, need_ctx):
    pl = _split_cols(h_lat @ w_in)
    if need_ctx:
        pc = _split_cols(h_ctx @ w_in)
    else:
        pc = [h_ctx @ blk if i in CTX_KV_IDX else None for i, blk in enumerate(_split_cols(w_in))]
    d_l, d_c = _diff_attention(pl[1], pl[2], pl[3], pc[1], pc[2], pc[3], diff_lam, diff_g, layer, need_ctx)
    n_l, n_c = _neighbourhood_attention(pl[4], pl[5], pl[6], pc[4], pc[5], pc[6], rpb, need_ctx)
    g_l, g_c = _gqa_attention(pl[7], pl[8], pl[9], pc[7], pc[8], pc[9], q_norm, k_norm, need_ctx)
    out_l = _merge_branches((_pool_mixer(pl[0], pool_w, pool_scale), d_l, n_l, g_l), pl[10], w_branch, w_out)
    out_c = None
    if need_ctx:
        out_c = _merge_branches((_pool_mixer(pc[0], pool_w, pool_scale), d_c, n_c, g_c), pc[10], w_branch, w_out)
    return out_l, out_c


def _moe(h, w_rg, b_rg, w_re, b_re, w_gate, w_up, w_down):
    b, n, d = h.shape
    t = h.reshape(b * n, d)
    nt = t.shape[0]
    tok = jnp.arange(nt)
    g_logits = (t @ w_rg).astype(jnp.float32) + b_rg.astype(jnp.float32)
    g_prob = jax.nn.softmax(g_logits, axis=-1)
    grp = jnp.argmax(g_logits, axis=-1)
    w_grp = g_prob[tok, grp][:, None]
    e_logits = ((t @ w_re).astype(jnp.float32) + b_re.astype(jnp.float32)).reshape(nt, N_GROUPS, EXPERTS_PER_GROUP)
    top_v, top_i = lax.top_k(e_logits[tok, grp], TOP_K_IN_GROUP)
    weights = jax.nn.softmax(top_v, axis=-1) * w_grp
    eid = grp[:, None] * EXPERTS_PER_GROUP + top_i
    comb = jnp.sum(jax.nn.one_hot(eid, N_EXPERTS, dtype=jnp.float32) * weights[..., None], axis=1).astype(h.dtype)
    y = jnp.zeros_like(t)
    for e in range(N_EXPERTS):
        a = jax.nn.silu(t @ w_gate[e]) * (t @ w_up[e])
        y = y + comb[:, e:e + 1] * (a @ w_down[e])
    return y.reshape(b, n, d)


def setup_inputs(seed: int = 0) -> dict:
    key = jax.random.key(seed)
    ks = iter(jax.random.split(key, 32))
    L, D = DEPTH, D_MODEL

    def nrm(shape, s):
        return jax.random.normal(next(ks), shape, jnp.float32) * s

    return {
        'x': nrm((BATCH, SEQ, D), 1.0),
        'c': nrm((BATCH, D), 1.0),
        'ctx': nrm((BATCH, CTX_LEN, D), 1.0),
        'c_ctx': nrm((D,), 1.0),
        'w_mod': nrm((L, D, 6 * D), 0.5 * D ** -0.5),
        'b_mod': nrm((L, 6 * D), 0.02),
        'g_mix': 1.0 + nrm((L, D), 0.02),
        'g_ffn': 1.0 + nrm((L, D), 0.02),
        'w_in': nrm((L, D, IN_COLS), D ** -0.5),
        'pool_w': nrm((L, POOL_GROUPS, POOL_GW, POOL_GW), POOL_GW ** -0.5),
        'pool_scale': 1.0 + nrm((L, BRANCH_W), 0.02),
        'diff_lambda': nrm((L, 4, DIFF_DQ), 0.1),
        'diff_norm_g': 1.0 + nrm((L, DIFF_DV), 0.02),
        'nat_rpb': nrm((L, NAT_HEADS, 2 * NAT_WIN_R - 1, 2 * NAT_WIN_C - 1), 0.02),
        'gqa_q_norm': 1.0 + nrm((L, HEAD_DIM), 0.02),
        'gqa_k_norm': 1.0 + nrm((L, HEAD_DIM), 0.02),
        'w_branch': nrm((L, N_BRANCH, BRANCH_W, D), BRANCH_W ** -0.5),
        'w_out': nrm((L, D, D), D ** -0.5),
        'w_router_group': nrm((L, D, N_GROUPS), D ** -0.5),
        'b_router_group': nrm((L, N_GROUPS), 0.01),
        'w_router_expert': nrm((L, D, N_EXPERTS), D ** -0.5),
        'b_router_expert': nrm((L, N_EXPERTS), 0.01),
        'w_exp_gate': nrm((L, N_EXPERTS, D, D_EXPERT), D ** -0.5),
        'w_exp_up': nrm((L, N_EXPERTS, D, D_EXPERT), D ** -0.5),
        'w_exp_down': nrm((L, N_EXPERTS, D_EXPERT, D), D_EXPERT ** -0.5),
        'g_final': 1.0 + nrm((D,), 0.02),
    }


def reference(x, c, ctx, c_ctx, w_mod, b_mod, g_mix, g_ffn, w_in, pool_w, pool_scale, diff_lambda, diff_norm_g,
              nat_rpb, gqa_q_norm, gqa_k_norm, w_branch, w_out, w_router_group, b_router_group, w_router_expert,
              b_router_expert, w_exp_gate, w_exp_up, w_exp_down, g_final):
    x_lat, x_ctx = x, ctx
    s_lat = jax.nn.silu(c)
    s_ctx = jax.nn.silu(c_ctx)[None]
    for l in range(DEPTH):
        need_ctx = l < DEPTH - 1
        sh1, sc1, gt1, sh2, sc2, gt2 = jnp.split(s_lat @ w_mod[l] + b_mod[l], 6, axis=-1)
        csh1, csc1, cgt1, csh2, csc2, cgt2 = jnp.split(s_ctx @ w_mod[l] + b_mod[l], 6, axis=-1)
        h_lat = _modulate(x_lat, g_mix[l], sh1, sc1)
        h_ctx = _modulate(x_ctx, g_mix[l], csh1, csc1)
        o_lat, o_ctx = _mixer(h_lat, h_ctx, w_in[l], pool_w[l], pool_scale[l], diff_lambda[l], diff_norm_g[l],
                              nat_rpb[l], gqa_q_norm[l], gqa_k_norm[l], w_branch[l], w_out[l], l, need_ctx)
        x_lat = x_lat + gt1[:, None] * o_lat
        x_lat = x_lat + gt2[:, None] * _moe(_modulate(x_lat, g_ffn[l], sh2, sc2), w_router_group[l], b_router_group[l],
                                            w_router_expert[l], b_router_expert[l], w_exp_gate[l], w_exp_up[l], w_exp_down[l])
        if need_ctx:
            x_ctx = x_ctx + cgt1[:, None] * o_ctx
            x_ctx = x_ctx + cgt2[:, None] * _moe(_modulate(x_ctx, g_ffn[l], csh2, csc2), w_router_group[l], b_router_group[l],
                                                 w_router_expert[l], b_router_expert[l], w_exp_gate[l], w_exp_up[l], w_exp_down[l])
    return _rmsnorm(x_lat, g_final)
```

```cpp
#include <hip/hip_runtime.h>
#include <cstdint>
#include <cstdio>

#ifndef MK_CHECK
#define MK_CHECK 0
#endif
#ifndef MK_CHK_MODE
#define MK_CHK_MODE 0
#endif
#ifndef MK_MULTI
#define MK_MULTI 0
#endif

#define GAS __attribute__((address_space(1)))
#define LAS __attribute__((address_space(3)))
typedef unsigned short bf16_t;
typedef short bf16x8 __attribute__((ext_vector_type(8)));
typedef float f32x4 __attribute__((ext_vector_type(4)));
typedef float f32x2 __attribute__((ext_vector_type(2)));
typedef float f32x16 __attribute__((ext_vector_type(16)));
typedef unsigned u32x4 __attribute__((ext_vector_type(4)));
typedef unsigned u32x2 __attribute__((ext_vector_type(2)));

constexpr int D = 1024, NB = 8, SEQ = 4096, CTXL = 256, TPB = SEQ + CTXL  , T = NB * TPB  ;
constexpr int LDP = 2560;
constexpr int NGATE = 4096, NIN = 6400;
constexpr int C_DQ = 256, C_DK = 512, C_DV = 768, C_NQ = 1024, C_NK = 1280, C_NV = 1536, C_GQ = 1792, C_GK = 2048, C_GV = 2176, C_POOL = 2304;
constexpr int NEXP = 32, DEXP = 512;
constexpr int MPAD = 77824;
constexpr float RMS_EPS = 1e-6f;
constexpr float LOG2E = 1.4426950408889634f;

constexpr size_t MiB = 1u << 20;
constexpr size_t WS_CTL = 0, CTL_ZERO_BYTES = 1 * MiB;
constexpr size_t WS_MOD = 1 * MiB;
constexpr size_t WS_ROUTE = 2 * MiB;
constexpr size_t WS_ROWW = 4 * MiB;
constexpr size_t WS_XCTX = 5 * MiB;
constexpr size_t WS_WIN = 13 * MiB;
constexpr size_t WS_WOUT = 38 * MiB;
constexpr size_t WS_WBR = 42 * MiB;
constexpr size_t WS_H = 46 * MiB;
constexpr size_t WS_PROJ = 114 * MiB;
constexpr size_t WS_GATES = 284 * MiB;
constexpr size_t WS_VT = 556 * MiB;
constexpr size_t WS_END = 599 * MiB;
constexpr size_t WS_GUT = WS_GATES, WS_DT = WS_GATES + 64 * MiB, WS_HMID = WS_GATES + 96 * MiB;
static_assert((size_t)T * LDP * 2 <= WS_GATES - WS_PROJ && (size_t)MPAD * 1024 * 2 <= WS_GATES - WS_PROJ, "proj region");
static_assert((size_t)T * NGATE * 2 <= WS_VT - WS_GATES && 96 * MiB + (size_t)MPAD * 512 * 2 <= WS_VT - WS_GATES, "gates region");
static_assert((size_t)NB * 10 * 64 * TPB * 2 <= WS_END - WS_VT, "vt region");
constexpr int CW_BAR = 1024;
constexpr int CW_CNT = 8192;
constexpr int CW_Q = 8448;

constexpr int RING_BYTES = 131072;
constexpr int LDS_MISC = 155648;
constexpr int LDS_BYTES = 159744;
constexpr int LDS_TILE_E = LDS_MISC + 512;
static_assert(LDS_TILE_E + 320 * 4 <= LDS_BYTES, "lds map");

#define RLX_AGENT __ATOMIC_RELAXED, __HIP_MEMORY_SCOPE_AGENT
__device__ __forceinline__ unsigned f2bf(float f) { unsigned u = __builtin_bit_cast(unsigned, f); return (u + 0x7fffu + ((u >> 16) & 1u)) >> 16; }
__device__ __forceinline__ unsigned pk2(float lo, float hi) { return f2bf(lo) | (f2bf(hi) << 16); }
__device__ __forceinline__ float bflo(unsigned w) { return __builtin_bit_cast(float, w << 16); }
__device__ __forceinline__ float bfhi(unsigned w) { return __builtin_bit_cast(float, w & 0xffff0000u); }
__device__ __forceinline__ float bf2f(bf16_t h) { return __builtin_bit_cast(float, (unsigned)h << 16); }
typedef __bf16 bf16x2_t __attribute__((ext_vector_type(2)));
__device__ __forceinline__ unsigned cvt_pk_bf16(float lo, float hi) { f32x2 v = {lo, hi}; bf16x2_t b = __builtin_convertvector(v, bf16x2_t); return __builtin_bit_cast(unsigned, b); }
template <int M> __device__ __forceinline__ float swz_xor(float v) { return __builtin_bit_cast(float, __builtin_amdgcn_ds_swizzle(__builtin_bit_cast(int, v), (M << 10) | 0x1f)); }
__device__ __forceinline__ void plswap32(float& a, float& b) { asm volatile("s_nop 1\n\tv_permlane32_swap_b32 %0, %1\n\ts_nop 1" : "+v"(a), "+v"(b)); }
__device__ __forceinline__ float half_sum(float v) { float a = v, b = v; plswap32(a, b); return a + b; }
__device__ __forceinline__ float half_max(float v) { float a = v, b = v; plswap32(a, b); return fmaxf(a, b); }
__device__ __forceinline__ float wave_sum(float v) {
    v += swz_xor<1>(v); v += swz_xor<2>(v); v += swz_xor<4>(v); v += swz_xor<8>(v); v += swz_xor<16>(v);
    return half_sum(v);
}
__device__ __forceinline__ float fast_exp2(float x) { return __builtin_amdgcn_exp2f(x); }
__device__ __forceinline__ float fast_rcp(float x) { return __builtin_amdgcn_rcpf(x); }
__device__ __forceinline__ float sigmoidf_(float x) { return fast_rcp(1.0f + fast_exp2(-x * LOG2E)); }

#define XB_TMO      128
#define XB_XCNT(j)  (256  + 64 * (j))
#define XB_XSUB(j)  (1280 + 64 * (j))
#define XB_XGEN(j)  (2304 + 64 * (j))
#define XB_TOP      3328
#define XB_TOPGEN   3392
#define XCD_BAR_WORDS 3456
#define XB_SPIN_CAP (1u << 20)
__device__ __forceinline__ unsigned xb_ld(unsigned* p)              { return __hip_atomic_load(p, __ATOMIC_RELAXED, __HIP_MEMORY_SCOPE_AGENT); }
__device__ __forceinline__ unsigned xb_add(unsigned* p, unsigned v) { return __hip_atomic_fetch_add(p, v, __ATOMIC_RELAXED, __HIP_MEMORY_SCOPE_AGENT); }
__device__ __forceinline__ unsigned xb_xcc_id() { return (unsigned)__builtin_amdgcn_s_getreg((3 << 11) | 20) & 0xFu; }
#define XB_SPIN(cond, bar) do { unsigned _sp = 0; while (cond) { __builtin_amdgcn_s_sleep(1); \
    if ((++_sp & 255u) == 0u) { if (xb_ld(&(bar)[XB_TMO])) break; if (_sp > XB_SPIN_CAP) { atomicAdd(&(bar)[XB_TMO], 1u); break; } } } } while (0)
struct XcdBarrier { unsigned* bar; unsigned x; volatile LAS unsigned* st; };
__device__ __forceinline__ XcdBarrier xcd_barrier_post(unsigned* bar, volatile LAS unsigned* st) {
    XcdBarrier b; b.bar = bar; b.x = xb_xcc_id(); b.st = st;
    if (threadIdx.x == 0) (void)xb_add(&bar[XB_XCNT(b.x)], 1u);
    return b;
}
__device__ __forceinline__ void xcd_barrier_complete(unsigned* bar, unsigned x, unsigned& nloc, unsigned& nx) {
    const unsigned G = gridDim.x * gridDim.y * gridDim.z;
    unsigned sum, cnt, mine, sp = 0u;
    for (;;) {
        sum = 0u; cnt = 0u; mine = 0u;
#pragma unroll
        for (unsigned j = 0; j < 16; ++j) { const unsigned c = xb_ld(&bar[XB_XCNT(j)]); sum += c; cnt += (c > 0u) ? 1u : 0u; mine = (j == x) ? c : mine; }
        if (sum == G) break;
        __builtin_amdgcn_s_sleep(1);
        if ((++sp & 255u) == 0u) { if (xb_ld(&bar[XB_TMO])) break; if (sp > XB_SPIN_CAP) { atomicAdd(&bar[XB_TMO], 1u); break; } }
    }
    nloc = mine > 0u ? mine : 1u; nx = cnt > 0u ? cnt : 1u;
}
__device__ __forceinline__ void xcd_barrier(const XcdBarrier& b) {
    asm volatile("s_waitcnt vmcnt(0)" ::: "memory");
    __syncthreads();
    if (threadIdx.x == 0) {
        unsigned* bar = b.bar;
        __builtin_amdgcn_s_waitcnt(0);
        unsigned nloc = b.st[0], nx = b.st[1];
        if (nloc == 0u) { xcd_barrier_complete(bar, b.x, nloc, nx); b.st[0] = nloc; b.st[1] = nx; }
        const unsigned old = xb_add(&bar[XB_XSUB(b.x)], 1u);
        const unsigned gen = old / nloc;
        if (old + 1u == (gen + 1u) * nloc) {
            __builtin_amdgcn_fence(__ATOMIC_RELEASE, "agent");
            asm volatile("s_waitcnt vmcnt(0)" ::: "memory");
            const unsigned og = xb_add(&bar[XB_TOP], 1u);
            const unsigned tg = og / nx;
            if (og + 1u == (tg + 1u) * nx) xb_add(&bar[XB_TOPGEN], 1u);
            else XB_SPIN(xb_ld(&bar[XB_TOPGEN]) == tg, bar);
            __builtin_amdgcn_fence(__ATOMIC_ACQUIRE, "agent");
            xb_add(&bar[XB_XGEN(b.x)], 1u);
            asm volatile("s_waitcnt vmcnt(0)" ::: "memory");
        } else {
            XB_SPIN(xb_ld(&bar[XB_XGEN(b.x)]) == gen, bar);
            __builtin_amdgcn_fence(__ATOMIC_ACQUIRE, "agent");
            asm volatile("s_waitcnt vmcnt(0)" ::: "memory");
        }
    }
    __syncthreads();
}

namespace pg8 {
constexpr int BM = 256, BK = 64, HALF = 128, HTB = HALF * BK * 2, STAGE_BYTES = 8 * HTB, NXCD = 8, WGM = 8;
__host__ __device__ __forceinline__ int lds_byte(int r, int c) { const int st = (r >> 4) * 2 + (c >> 5), rr = r & 15, cc = c & 31, ob = rr * 64 + cc * 2; return st * 1024 + (ob ^ (((ob >> 9) & 1) << 5)); }
__host__ __device__ __forceinline__ void stage_rc(int b, int& R, int& C) { const int st = b / 1024, sb = b % 1024, swz = sb ^ (((sb >> 9) & 1) << 5); R = (st >> 1) * 16 + swz / 64; C = (st & 1) * 32 + (swz % 64) / 2; }
__host__ __device__ __forceinline__ int perm32(int rho) { const int n = rho >> 4, i = rho & 15; return 8 * (i >> 2) + 4 * n + (i & 3); }

struct Unit { int pm, pn, aux, pad; const char* A; const char* B; };
struct Gemm { int lda, ldb, K; };

__device__ __forceinline__ bool tile_order(int nM, int nN, int G, int c, int i, int& pm, int& pn) {
    const int nwg = nM * nN; const long L = (long)i * G + c; if (L >= nwg) return false;
    int wgid = (int)L; { const int q = nwg / NXCD, r = nwg % NXCD, xcd = wgid % NXCD, off = wgid / NXCD; wgid = (xcd < r ? xcd * (q + 1) : r * (q + 1) + (xcd - r) * q) + off; }
    const int nig = WGM * nN, gid = wgid / nig, fm = gid * WGM, gsz = (nM - fm) < WGM ? (nM - fm) : WGM;
    pm = fm + ((wgid % nig) % gsz); pn = (wgid % nig) / gsz; return true;
}

template <class Epi, class Sched, bool ALIGN_EPI>
__device__ __forceinline__ void gemm_phase(LAS unsigned char* lds, const Gemm g, const Sched& S, const Epi& E) {
    int tid_ = threadIdx.x; asm volatile("" : "+v"(tid_));
    const int tid = tid_, wid = __builtin_amdgcn_readfirstlane(tid >> 6), lane = tid & 63, wr = wid >> 2, wc = wid & 3, fr = lane & 15, fq = lane >> 4;
    const int nt = g.K / BK;
    unsigned voffA[2], voffB[2];
#pragma unroll
    for (int i = 0; i < 2; ++i) { int R, C; stage_rc(tid * 16 + i * 8192, R, C); const int Rb = (R & ~31) + perm32(R & 31);
        voffA[i] = (unsigned)(R * g.lda + C * 2); voffB[i] = (unsigned)(Rb * g.ldb + C * 2); }
    const size_t kstep = (size_t)(BK * 2);
    const size_t hsA = (size_t)HALF * g.lda, hsB = (size_t)HALF * g.ldb;
    const unsigned ldsw = (unsigned)wid * 1024u;
    const int aoff = lds_byte(wr * 64 + fr, fq * 8), boff = lds_byte(wc * 32 + fr, fq * 8);
#define PG8_SA(b, h) (((b) * 2 + (h)) * HTB)
#define PG8_SB(b, h) ((4 + (b) * 2 + (h)) * HTB)
#define PG8_STAGE(bufoff, gbase, voff) do { _Pragma("unroll") for (int _i = 0; _i < 2; ++_i) \
        __builtin_amdgcn_global_load_lds((const unsigned*)((const char*)(gbase) + (voff)[_i]), (LAS unsigned*)(lds + (bufoff) + ldsw + _i * 8192), 16, 0, 0); } while (0)
#define PG8_LDA(dst, b, h) do { _Pragma("unroll") for (int m = 0; m < 4; ++m) _Pragma("unroll") for (int k = 0; k < 2; ++k) dst[m][k] = *(const LAS bf16x8*)(lds + PG8_SA(b, h) + aoff + m * 2048 + k * 1024); } while (0)
#define PG8_LDB(dst, b, h) do { _Pragma("unroll") for (int n = 0; n < 2; ++n) _Pragma("unroll") for (int k = 0; k < 2; ++k) dst[n][k] = *(const LAS bf16x8*)(lds + PG8_SB(b, h) + boff + n * 2048 + k * 1024); } while (0)
#define PG8_MMA(ai, bj, At, Bt) do { __builtin_amdgcn_s_setprio(1); _Pragma("unroll") for (int m = 0; m < 4; ++m) _Pragma("unroll") for (int n = 0; n < 2; ++n) _Pragma("unroll") for (int k = 0; k < 2; ++k) \
        acc[ai][bj][m][n] = __builtin_amdgcn_mfma_f32_16x16x32_bf16(Bt[n][k], At[m][k], acc[ai][bj][m][n], 0, 0, 0); __builtin_amdgcn_s_setprio(0); } while (0)
#define PG8_WAIT_V(n) asm volatile("s_waitcnt vmcnt(" #n ")" ::: "memory")
#define PG8_WAIT_L(n) asm volatile("s_waitcnt lgkmcnt(" #n ")" ::: "memory")
#define PG8_BAR __builtin_amdgcn_s_barrier()
#define PG8_SCHED __builtin_amdgcn_sched_barrier(0)
    Unit cur, nxt; int ui = 0;
    if (!S.next(0, cur)) return;
    f32x4 acc[2][2][4][2];
#pragma unroll
    for (int a = 0; a < 2; ++a)
#pragma unroll
        for (int b = 0; b < 2; ++b)
#pragma unroll
            for (int m = 0; m < 4; ++m)
#pragma unroll
                for (int n = 0; n < 2; ++n) acc[a][b][m][n] = (f32x4){0.f, 0.f, 0.f, 0.f};
    bf16x8 At[4][2], B0[2][2], B1[2][2];
    const char* cA = cur.A; const char* cB = cur.B;
    PG8_STAGE(PG8_SB(0, 0), cB, voffB); PG8_STAGE(PG8_SB(0, 1), cB + hsB, voffB); PG8_STAGE(PG8_SA(0, 0), cA, voffA); PG8_STAGE(PG8_SA(0, 1), cA + hsA, voffA);
    if (wr == 1) PG8_BAR;
    PG8_WAIT_V(2); PG8_BAR;
    PG8_STAGE(PG8_SB(1, 0), cB + kstep, voffB); PG8_STAGE(PG8_SA(1, 0), cA + kstep, voffA); PG8_STAGE(PG8_SB(1, 1), cB + hsB + kstep, voffB);
    PG8_WAIT_V(6); PG8_BAR;
    for (;;) {
        const bool has_next = S.next(ui + 1, nxt);
        const char* nA = has_next ? nxt.A : cA; const char* nB = has_next ? nxt.B : cB;
        for (int t = 0; t < nt; t += 2) {
            const bool last = (t == nt - 2);
            const char* a1 = cA + (size_t)(t + 1) * kstep;
            const char* a2 = last ? nA : cA + (size_t)(t + 2) * kstep; const char* b2 = last ? nB : cB + (size_t)(t + 2) * kstep;
            const char* a3 = a2 + kstep; const char* b3 = b2 + kstep;
            PG8_LDB(B0, 0, 0); PG8_LDB(B1, 0, 1); PG8_SCHED; PG8_LDA(At, 0, 0); PG8_STAGE(PG8_SA(1, 1), a1 + hsA, voffA);
            PG8_WAIT_V(8); PG8_WAIT_L(0); PG8_BAR; PG8_MMA(0, 0, At, B0); PG8_MMA(0, 1, At, B1); PG8_BAR; PG8_SCHED;
            PG8_LDA(At, 0, 1); PG8_STAGE(PG8_SB(0, 0), b2, voffB); PG8_STAGE(PG8_SB(0, 1), b2 + hsB, voffB); PG8_STAGE(PG8_SA(0, 0), a2, voffA);
            PG8_WAIT_V(8); PG8_WAIT_L(0); PG8_BAR; PG8_MMA(1, 0, At, B0); PG8_MMA(1, 1, At, B1); PG8_BAR; PG8_SCHED;
            PG8_LDB(B0, 1, 0); PG8_LDB(B1, 1, 1); PG8_SCHED; PG8_LDA(At, 1, 0); PG8_STAGE(PG8_SA(0, 1), a2 + hsA, voffA);
            PG8_WAIT_V(8); PG8_WAIT_L(0); PG8_BAR; PG8_MMA(0, 0, At, B0); PG8_MMA(0, 1, At, B1); PG8_BAR; PG8_SCHED;
            PG8_LDA(At, 1, 1); PG8_STAGE(PG8_SB(1, 0), b3, voffB); PG8_STAGE(PG8_SB(1, 1), b3 + hsB, voffB); PG8_STAGE(PG8_SA(1, 0), a3, voffA);
            PG8_WAIT_V(8); PG8_WAIT_L(0); PG8_BAR; PG8_MMA(1, 0, At, B0); PG8_MMA(1, 1, At, B1); PG8_BAR; PG8_SCHED;
        }
        if constexpr (ALIGN_EPI) { if (wr == 0) PG8_BAR; }
        E(acc, cur, wr, wc, fr, fq);
        if (!has_next) break;
#pragma unroll
        for (int a = 0; a < 2; ++a)
#pragma unroll
            for (int b = 0; b < 2; ++b)
#pragma unroll
                for (int m = 0; m < 4; ++m)
#pragma unroll
                    for (int n = 0; n < 2; ++n) acc[a][b][m][n] = (f32x4){0.f, 0.f, 0.f, 0.f};
        cur = nxt; cA = nA; cB = nB; ++ui;
        if constexpr (ALIGN_EPI) { if (wr == 1) PG8_BAR; }
    }
    PG8_WAIT_V(0);
    if constexpr (!ALIGN_EPI) { if (wr == 0) PG8_BAR; }
    PG8_BAR;
#undef PG8_SA
#undef PG8_SB
#undef PG8_STAGE
#undef PG8_LDA
#undef PG8_LDB
#undef PG8_MMA
#undef PG8_WAIT_V
#undef PG8_WAIT_L
#undef PG8_BAR
#undef PG8_SCHED
}
}

struct Args {
    const float* in[26];
    float* out; unsigned char* ws;
    int ph_lo, ph_hi;
};
struct Frame {
    LAS unsigned char* lds;
    unsigned char* ws; float* out;
    int tid, lane, wave, vcu, G, bx;
};
__device__ __forceinline__ const float* inptr(int i) {
    const __attribute__((address_space(4))) unsigned char* kp = (const __attribute__((address_space(4))) unsigned char*)__builtin_amdgcn_kernarg_segment_ptr();
    asm volatile("" : "+s"(kp));
    return *(const float* const __attribute__((address_space(4)))*)(kp + 8 * i);
}
__device__ __forceinline__ Frame launder(const Frame& F) {
    Frame P = F; int t = F.tid; unsigned char* w = F.ws; float* o = F.out; int g = F.G, v = F.vcu, wv = F.wave, bx = F.bx;
    asm volatile("" : "+v"(t), "+s"(w), "+s"(o), "+s"(g), "+s"(v), "+s"(wv), "+s"(bx));
    P.tid = t; P.lane = t & 63; P.ws = w; P.out = o; P.G = g; P.vcu = v; P.wave = wv; P.bx = bx; return P;
}
enum { I_X = 0, I_C, I_CTX, I_CCTX, I_WMOD, I_BMOD, I_GMIX, I_GFFN, I_WIN, I_POOLW, I_POOLS, I_DLAM, I_DNG, I_RPB, I_QN, I_KN, I_WBR, I_WOUT, I_WRG, I_BRG, I_WRE, I_BRE, I_WEG, I_WEU, I_WED, I_GFIN };
#define WSF(off) ((float*)(F.ws + (off)))
#define WSB(off) ((bf16_t*)(F.ws + (off)))
#define WSU(off) ((unsigned*)(F.ws + (off)))

template <class RowMap>
__device__ __forceinline__ void transpose_item(const float* W, int K, int N, bf16_t* WT, int ldt, LAS float* scr, int item, int lane, const RowMap& rm) {
    const int nblk = N / 32, kb = item / nblk, nb = item % nblk, k0 = 64 * kb, n0 = 32 * nb;
#pragma unroll 8
    for (int i = 0; i < 32; ++i) { const int kk = 2 * i + (lane >> 5); scr[kk * 33 + (lane & 31)] = W[(size_t)(k0 + kk) * N + n0 + (lane & 31)]; }
    asm volatile("s_waitcnt lgkmcnt(0)" ::: "memory");
    const int c = lane & 7;
#pragma unroll
    for (int j = 0; j < 4; ++j) { const int n = (lane >> 3) + 8 * j; const LAS float* s = scr + (8 * c) * 33 + n;
        u32x4 o; o.x = pk2(s[0 * 33], s[1 * 33]); o.y = pk2(s[2 * 33], s[3 * 33]); o.z = pk2(s[4 * 33], s[5 * 33]); o.w = pk2(s[6 * 33], s[7 * 33]);
        *(u32x4*)(WT + (size_t)rm(n0 + n) * ldt + k0 + 8 * c) = o; }
    asm volatile("s_waitcnt lgkmcnt(0)" ::: "memory");
}
struct RowId { __device__ __forceinline__ int operator()(int n) const { return n; } };
struct RowGU { int up; __device__ __forceinline__ int operator()(int n) const { return 256 * (n >> 7) + 128 * up + (n & 127); } };

__device__ __forceinline__ void p0_prologue(Frame& F) {
    LAS float* scr = (LAS float*)(F.lds + F.wave * 16384);
    const int gw = F.vcu * 8 + F.wave, NGW = F.G * 8;
    const float *w_in = inptr(I_WIN), *w_out = inptr(I_WOUT), *w_branch = inptr(I_WBR), *pool_w = inptr(I_POOLW), *pool_scale = inptr(I_POOLS);
    bf16_t *WIN = WSB(WS_WIN), *WOUT = WSB(WS_WOUT), *WBR = WSB(WS_WBR); float* MOD = WSF(WS_MOD);
    constexpr int I_IN = 16 * 200, I_OUT = 16 * 32, I_BR = 4 * 32;
    constexpr int PER_L = I_IN + I_OUT + 3 * I_BR, NITEMS = 2 * PER_L;
    for (int it = gw; it < NITEMS; it += NGW) {
        const int l = it / PER_L; int r = it % PER_L;
        if (r < I_IN) { transpose_item(w_in + (size_t)l * D * NIN, D, NIN, WIN + (size_t)l * NIN * D, D, scr, r, F.lane, RowId{}); continue; } r -= I_IN;
        if (r < I_OUT) { transpose_item(w_out + (size_t)l * D * D, D, D, WOUT + (size_t)l * D * D, D, scr, r, F.lane, RowId{}); continue; } r -= I_OUT;
        const int br = 1 + r / I_BR; r %= I_BR;
        transpose_item(w_branch + ((size_t)l * 4 + br) * 256 * D, 256, D, WBR + ((size_t)l * 4 + br) * D * 256, 256, scr, r, F.lane, RowId{});
    }
    for (int it = gw; it < 2 * 4 * 16 * 8; it += NGW) {
        const int l = it >> 9, g = (it >> 7) & 3, n = ((it >> 3) & 15) * 64 + F.lane, c8 = it & 7;
        const float* pw = pool_w + (size_t)(l * 4 + g) * 4096 + c8 * 8 * 64;
        const float* ps = pool_scale + l * 256 + 64 * g;
        const float* wb = w_branch + ((size_t)(l * 4 + 0) * 256 + 64 * g) * D + n;
        float o[8];
#pragma unroll
        for (int cc = 0; cc < 8; ++cc) o[cc] = 0.f;
#pragma unroll 4
        for (int cp = 0; cp < 64; ++cp) { const float w = ps[cp] * wb[(size_t)cp * D];
#pragma unroll
            for (int cc = 0; cc < 8; ++cc) o[cc] += pw[cc * 64 + cp] * w; }
        u32x4 w; w.x = pk2(o[0], o[1]); w.y = pk2(o[2], o[3]); w.z = pk2(o[4], o[5]); w.w = pk2(o[6], o[7]);
        *(u32x4*)(WBR + ((size_t)l * 4 + 0) * D * 256 + (size_t)n * 256 + 64 * g + c8 * 8) = w;
    }
    if (F.vcu < 192) {
        const float *cvec = inptr(I_C), *c_ctx = inptr(I_CCTX), *w_mod = inptr(I_WMOD), *b_mod = inptr(I_BMOD);
        __syncthreads();
        LAS float* sv = (LAS float*)(F.lds);
        LAS float* part = (LAS float*)(F.lds + 65536);
        for (int i = F.tid; i < 9 * 1024; i += 512) { const int bb = i >> 10, k = i & 1023; const float v = bb < 8 ? cvec[bb * 1024 + k] : c_ctx[k]; sv[i] = v / (1.0f + __expf(-v)); }
        __syncthreads();
        const int l = F.vcu / 96, j = (F.vcu % 96) * 64 + F.lane;
        float acc[9];
#pragma unroll
        for (int bb = 0; bb < 9; ++bb) acc[bb] = 0.f;
        const float* wm = w_mod + (size_t)l * D * 6144 + j;
        for (int k = F.wave * 128; k < F.wave * 128 + 128; ++k) { const float w = wm[(size_t)k * 6144];
#pragma unroll
            for (int bb = 0; bb < 9; ++bb) acc[bb] += sv[bb * 1024 + k] * w; }
#pragma unroll
        for (int bb = 0; bb < 9; ++bb) part[(F.wave * 9 + bb) * 64 + F.lane] = acc[bb];
        __syncthreads();
        for (int i = F.tid; i < 9 * 64; i += 512) { const int bb = i >> 6, jj = i & 63; float s = 0.f;
#pragma unroll
            for (int w = 0; w < 8; ++w) s += part[(w * 9 + bb) * 64 + jj];
            const int col = (F.vcu % 96) * 64 + jj;
            MOD[((size_t)l * 9 + bb) * 6144 + col] = s + b_mod[l * 6144 + col]; }
        __syncthreads();
    }
    if (F.vcu == 200 && F.tid < 2) {
        const float* diff_lambda = inptr(I_DLAM);
        const int l = F.tid; const float* lf = diff_lambda + l * 128; float s0 = 0.f, s1 = 0.f;
        for (int i = 0; i < 32; ++i) { s0 += lf[i] * lf[32 + i]; s1 += lf[64 + i] * lf[96 + i]; }
        const float lam_init = 0.8f - 0.6f * expf(-0.3f * (float)l);
        MOD[131072 + l] = expf(s0) - expf(s1) + lam_init;
    }
}

__device__ __forceinline__ void phase_modulate(Frame& F, int l) {
    const int gw = F.vcu * 8 + F.wave, NGW = F.G * 8;
    const float *xin = inptr(I_X), *ctxin = inptr(I_CTX), *g_mix = inptr(I_GMIX), *g_final = inptr(I_GFIN);
    float *MOD = WSF(WS_MOD), *XCTX = WSF(WS_XCTX); unsigned* ROUTE = WSU(WS_ROUTE); bf16_t *Y = WSB(WS_PROJ), *H = WSB(WS_H);
    for (int row = gw; row < T; row += NGW) {
        const int b = row / TPB, t = row % TPB; const bool isctx = t >= SEQ;
        if (isctx && l == 2) continue;
        const int mb = isctx ? 8 : b;
        f32x4 v[4];
        if (l == 0) {
            const f32x4* src = (const f32x4*)(isctx ? ctxin + ((size_t)b * CTXL + (t - SEQ)) * D : xin + ((size_t)b * SEQ + t) * D) + F.lane;
#pragma unroll
            for (int j = 0; j < 4; ++j) v[j] = src[64 * j];
        } else {
            float* xr = isctx ? XCTX + ((size_t)b * CTXL + (t - SEQ)) * D : F.out + ((size_t)b * SEQ + t) * D;
            const f32x4* src = (const f32x4*)xr + F.lane;
#pragma unroll
            for (int j = 0; j < 4; ++j) v[j] = src[64 * j];
            if (!(isctx && l == 2)) {
                const unsigned p0 = ROUTE[(size_t)row * 8 + 6], p1 = ROUTE[(size_t)row * 8 + 7];
                const u32x2* y0 = (const u32x2*)(Y + (size_t)p0 * D) + F.lane; const u32x2* y1 = (const u32x2*)(Y + (size_t)p1 * D) + F.lane;
                const f32x4* gt = (const f32x4*)(MOD + ((size_t)(l - 1) * 9 + mb) * 6144 + 5 * 1024) + F.lane;
#pragma unroll
                for (int j = 0; j < 4; ++j) { const u32x2 a = y0[64 * j], c2 = y1[64 * j]; const f32x4 g = gt[64 * j];
                    v[j].x += g.x * (bflo(a.x) + bflo(c2.x)); v[j].y += g.y * (bfhi(a.x) + bfhi(c2.x)); v[j].z += g.z * (bflo(a.y) + bflo(c2.y)); v[j].w += g.w * (bfhi(a.y) + bfhi(c2.y)); }
                if (l < 2) { f32x4* dst = (f32x4*)xr + F.lane;
#pragma unroll
                    for (int j = 0; j < 4; ++j) dst[64 * j] = v[j]; }
            }
        }
        float ss = 0.f;
#pragma unroll
        for (int j = 0; j < 4; ++j) ss += (v[j].x * v[j].x + v[j].y * v[j].y) + (v[j].z * v[j].z + v[j].w * v[j].w);
        const float r = rsqrtf(wave_sum(ss) * (1.0f / D) + RMS_EPS);
        if (l == 2) {
            f32x4* dst = (f32x4*)(F.out + ((size_t)b * SEQ + t) * D) + F.lane; const f32x4* g = (const f32x4*)g_final + F.lane;
#pragma unroll
            for (int j = 0; j < 4; ++j) dst[64 * j] = v[j] * r * g[64 * j];
        } else {
            const f32x4* g = (const f32x4*)(g_mix + l * D) + F.lane;
            const f32x4* sh = (const f32x4*)(MOD + ((size_t)l * 9 + mb) * 6144) + F.lane; const f32x4* sc = sh + 256;
            u32x2* dst = (u32x2*)(H + (size_t)row * D) + F.lane;
#pragma unroll
            for (int j = 0; j < 4; ++j) { const f32x4 o = (v[j] * r * g[64 * j]) * (sc[64 * j] + 1.0f) + sh[64 * j]; u32x2 w; w.x = pk2(o.x, o.y); w.y = pk2(o.z, o.w); dst[64 * j] = w; }
        }
    }
}

struct SchedIn {
    int G, c; const char* A; const char* B;
    __device__ __forceinline__ bool next(int i, pg8::Unit& u) const {
        int pm, pn; if (!pg8::tile_order(T / 256, NIN / 256, G, c, i, pm, pn)) return false;
        u.pm = pm; u.pn = pn; u.aux = 0; u.pad = 0; u.A = A + (size_t)pm * 256 * (D * 2); u.B = B + (size_t)pn * 256 * (D * 2); return true; }
};
struct EpiIn {
    bf16_t* PROJ; bf16_t* GATES;
    __device__ __forceinline__ void operator()(const f32x4 (&acc)[2][2][4][2], const pg8::Unit& u, int wr, int wc, int fr, int fq) const {
        const int row0 = u.pm * 256 + wr * 64 + fr; const bool gate = u.pn >= 9;
        bf16_t* base = gate ? GATES + (size_t)(u.pn - 9) * 256 + wc * 32 + 8 * fq : PROJ + (size_t)u.pn * 256 + wc * 32 + 8 * fq;
        const size_t ldc = gate ? NGATE : LDP;
#pragma unroll
        for (int ai = 0; ai < 2; ++ai)
#pragma unroll
            for (int m = 0; m < 4; ++m) { bf16_t* rowp = base + (size_t)(row0 + ai * 128 + m * 16) * ldc;
#pragma unroll
                for (int bj = 0; bj < 2; ++bj) { f32x4 v0 = acc[ai][bj][m][0], v1 = acc[ai][bj][m][1];
                    if (gate) { v0.x = sigmoidf_(v0.x); v0.y = sigmoidf_(v0.y); v0.z = sigmoidf_(v0.z); v0.w = sigmoidf_(v0.w); v1.x = sigmoidf_(v1.x); v1.y = sigmoidf_(v1.y); v1.z = sigmoidf_(v1.z); v1.w = sigmoidf_(v1.w); }
                    u32x4 w; w.x = cvt_pk_bf16(v0.x, v0.y); w.y = cvt_pk_bf16(v0.z, v0.w); w.z = cvt_pk_bf16(v1.x, v1.y); w.w = cvt_pk_bf16(v1.z, v1.w);
                    *(u32x4*)(rowp + bj * 128) = w; } }
    }
};
__device__ __forceinline__ int branch_col(int br) { return br == 0 ? C_POOL : (br == 1 ? C_DQ : (br == 2 ? C_NQ : C_GQ)); }
struct SchedMerge {
    int G, c, nM, skip; const char* PROJ; const char* WBR;
    __device__ __forceinline__ bool next(int i, pg8::Unit& u) const {
        int pm, pn; if (!pg8::tile_order(nM, 4, G, c, i >> 2, pm, pn)) return false;
        if (skip) pm += pm >> 4;
        const int br = i & 3; u.pm = pm; u.pn = pn; u.aux = br; u.pad = 0;
        u.A = PROJ + ((size_t)pm * 256 * LDP + branch_col(br)) * 2; u.B = WBR + ((size_t)br * D * 256 + (size_t)pn * 256 * 256) * 2; return true; }
};
struct EpiMerge {
    bf16_t* MERGED; const bf16_t* GATES;
    __device__ __forceinline__ void operator()(const f32x4 (&acc)[2][2][4][2], const pg8::Unit& u, int wr, int wc, int fr, int fq) const {
        const int row0 = u.pm * 256 + wr * 64 + fr, col0 = u.pn * 256 + wc * 32 + 8 * fq, br = u.aux;
#pragma unroll
        for (int ai = 0; ai < 2; ++ai)
#pragma unroll
            for (int m = 0; m < 4; ++m) { const size_t row = (size_t)(row0 + ai * 128 + m * 16);
#pragma unroll
                for (int bj = 0; bj < 2; ++bj) {
                    const u32x4 gq = *(const u32x4*)(GATES + row * NGATE + br * 1024 + col0 + bj * 128);
                    f32x4 v0 = acc[ai][bj][m][0], v1 = acc[ai][bj][m][1];
                    v0.x *= bflo(gq.x); v0.y *= bfhi(gq.x); v0.z *= bflo(gq.y); v0.w *= bfhi(gq.y); v1.x *= bflo(gq.z); v1.y *= bfhi(gq.z); v1.z *= bflo(gq.w); v1.w *= bfhi(gq.w);
                    u32x4* dst = (u32x4*)(MERGED + row * D + col0 + bj * 128);
                    if (br > 0) { const u32x4 o = *dst; v0.x += bflo(o.x); v0.y += bfhi(o.x); v0.z += bflo(o.y); v0.w += bfhi(o.y); v1.x += bflo(o.z); v1.y += bfhi(o.z); v1.z += bflo(o.w); v1.w += bfhi(o.w); }
                    u32x4 w; w.x = cvt_pk_bf16(v0.x, v0.y); w.y = cvt_pk_bf16(v0.z, v0.w); w.z = cvt_pk_bf16(v1.x, v1.y); w.w = cvt_pk_bf16(v1.z, v1.w);
                    *dst = w; } }
    }
};
struct SchedOut {
    int G, c, nM, skip; const char* A; const char* B;
    __device__ __forceinline__ bool next(int i, pg8::Unit& u) const {
        int pm, pn; if (!pg8::tile_order(nM, 4, G, c, i, pm, pn)) return false;
        if (skip) pm += pm >> 4;
        u.pm = pm; u.pn = pn; u.aux = 0; u.pad = 0; u.A = A + (size_t)pm * 256 * (D * 2); u.B = B + (size_t)pn * 256 * (D * 2); return true; }
};
struct EpiOut {
    const float* xlat_src; const float* xctx_src; float* out; float* XCTX; const float* MODL;
    __device__ __forceinline__ void operator()(const f32x4 (&acc)[2][2][4][2], const pg8::Unit& u, int wr, int wc, int fr, int fq) const {
        const int b = u.pm / 17, j = u.pm % 17; const bool isctx = j == 16;
        const size_t rbase = isctx ? (size_t)b * CTXL : (size_t)b * SEQ + j * 256;
        const float* src = isctx ? xctx_src : xlat_src; float* dst = isctx ? XCTX : out;
        const float* gt = MODL + (size_t)(isctx ? 8 : b) * 6144 + 2 * 1024;
        const int r0 = wr * 64 + fr, col0 = u.pn * 256 + wc * 32 + 8 * fq;
        f32x4 g[2][2];
#pragma unroll
        for (int bj = 0; bj < 2; ++bj) { g[bj][0] = *(const f32x4*)(gt + col0 + bj * 128); g[bj][1] = *(const f32x4*)(gt + col0 + bj * 128 + 4); }
#pragma unroll
        for (int ai = 0; ai < 2; ++ai)
#pragma unroll
            for (int m = 0; m < 4; ++m) { const size_t off = (rbase + r0 + ai * 128 + m * 16) * D + col0;
#pragma unroll
                for (int bj = 0; bj < 2; ++bj) {
                    const f32x4 x0 = *(const f32x4*)(src + off + bj * 128), x1 = *(const f32x4*)(src + off + bj * 128 + 4);
                    *(f32x4*)(dst + off + bj * 128) = x0 + g[bj][0] * acc[ai][bj][m][0];
                    *(f32x4*)(dst + off + bj * 128 + 4) = x1 + g[bj][1] * acc[ai][bj][m][1]; } }
    }
};
template <int KD>
struct SchedMoe {
    int G, c, ntiles; const LAS int* tile_e; const char* A; const char* B;
    __device__ __forceinline__ bool next(int i, pg8::Unit& u) const {
        const int L = i * G + c; if (L >= ntiles * 4) return false;
        const int k = L >> 2, j = L & 3, e = __builtin_amdgcn_readfirstlane(tile_e[k]);
        u.pm = k; u.pn = j; u.aux = e; u.pad = 0; u.A = A + (size_t)k * (256 * KD * 2); u.B = B + ((size_t)e * 1024 + (size_t)j * 256) * (KD * 2); return true; }
};
struct EpiGU {
    bf16_t* HMID;
    __device__ __forceinline__ void operator()(const f32x4 (&acc)[2][2][4][2], const pg8::Unit& u, int wr, int wc, int fr, int fq) const {
        const int row0 = u.pm * 256 + wr * 64 + fr, col0 = u.pn * 128 + wc * 32 + 8 * fq;
#pragma unroll
        for (int ai = 0; ai < 2; ++ai)
#pragma unroll
            for (int m = 0; m < 4; ++m) {
                float h[8];
#pragma unroll
                for (int n = 0; n < 2; ++n)
#pragma unroll
                    for (int e = 0; e < 4; ++e) { const float gv = acc[ai][0][m][n][e], uv = acc[ai][1][m][n][e]; h[n * 4 + e] = gv * sigmoidf_(gv) * uv; }
                u32x4 w; w.x = cvt_pk_bf16(h[0], h[1]); w.y = cvt_pk_bf16(h[2], h[3]); w.z = cvt_pk_bf16(h[4], h[5]); w.w = cvt_pk_bf16(h[6], h[7]);
                *(u32x4*)(HMID + (size_t)(row0 + ai * 128 + m * 16) * DEXP + col0) = w; }
    }
};
struct EpiDown {
    bf16_t* Y; const float* ROWW;
    __device__ __forceinline__ void operator()(const f32x4 (&acc)[2][2][4][2], const pg8::Unit& u, int wr, int wc, int fr, int fq) const {
        const int row0 = u.pm * 256 + wr * 64 + fr, col0 = u.pn * 256 + wc * 32 + 8 * fq;
#pragma unroll
        for (int ai = 0; ai < 2; ++ai)
#pragma unroll
            for (int m = 0; m < 4; ++m) { const size_t row = (size_t)(row0 + ai * 128 + m * 16); const float w8 = ROWW[row];
#pragma unroll
                for (int bj = 0; bj < 2; ++bj) { const f32x4 v0 = acc[ai][bj][m][0] * w8, v1 = acc[ai][bj][m][1] * w8;
                    u32x4 w; w.x = cvt_pk_bf16(v0.x, v0.y); w.y = cvt_pk_bf16(v0.z, v0.w); w.z = cvt_pk_bf16(v1.x, v1.y); w.w = cvt_pk_bf16(v1.z, v1.w);
                    *(u32x4*)(Y + row * D + col0 + bj * 128) = w; } }
    }
};

__device__ __forceinline__ void rope8(float (&v)[8], float (&o)[8], float pos, int i0, float inv_half, bool second) {
#pragma unroll
    for (int e = 0; e < 8; ++e) {
        const float inv = exp2f(-(float)(i0 + e) * inv_half * 13.287712379549449f);
        float sn, cs; sincosf(pos * inv, &sn, &cs);
        v[e] = second ? (o[e] * sn + v[e] * cs) : (v[e] * cs - o[e] * sn);
    }
}
__device__ __forceinline__ void phase_post(Frame& F, int l) {
    const int gw = F.vcu * 8 + F.wave, NGW = F.G * 8, lane = F.lane;
    const float *gqa_q_norm = inptr(I_QN), *gqa_k_norm = inptr(I_KN); bf16_t *PROJ = WSB(WS_PROJ), *VT = WSB(WS_VT);
    for (int row = gw; row < T; row += NGW) {
        const int b = row / TPB, t = row % TPB; const bool isctx = t >= SEQ;
        bf16_t* pr = PROJ + (size_t)row * LDP;
        const float prow = (float)(t >> 6), pcol = (float)(t & 63);
        {
            u32x4 w = *(const u32x4*)(pr + C_DQ + lane * 8);
            float v[8] = {bflo(w.x), bfhi(w.x), bflo(w.y), bfhi(w.y), bflo(w.z), bfhi(w.z), bflo(w.w), bfhi(w.w)};
            if (!isctx) {
                float o[8];
#pragma unroll
                for (int e = 0; e < 8; ++e) o[e] = swz_xor<1>(v[e]);
                rope8(v, o, (lane & 2) ? pcol : prow, 0, 1.0f / 8.0f, (lane & 1) != 0);
            }
            const float sc = lane < 32 ? 0.17677669529663687f * LOG2E : 1.0f;
#pragma unroll
            for (int e = 0; e < 8; ++e) v[e] *= sc;
            w.x = pk2(v[0], v[1]); w.y = pk2(v[2], v[3]); w.z = pk2(v[4], v[5]); w.w = pk2(v[6], v[7]);
            *(u32x4*)(pr + C_DQ + lane * 8) = w;
        }
        if (lane < 32) {
            u32x4 w = *(const u32x4*)(pr + C_NQ + lane * 8); const float sc = 0.125f * LOG2E;
            w.x = pk2(bflo(w.x) * sc, bfhi(w.x) * sc); w.y = pk2(bflo(w.y) * sc, bfhi(w.y) * sc); w.z = pk2(bflo(w.z) * sc, bfhi(w.z) * sc); w.w = pk2(bflo(w.w) * sc, bfhi(w.w) * sc);
            *(u32x4*)(pr + C_NQ + lane * 8) = w;
        }
        {
            const bool act = lane < 48; const int lc = act ? lane : 0;
            u32x4 w = *(const u32x4*)(pr + C_GQ + lc * 8);
            float v[8] = {bflo(w.x), bfhi(w.x), bflo(w.y), bfhi(w.y), bflo(w.z), bfhi(w.z), bflo(w.w), bfhi(w.w)};
            float ss = 0.f;
#pragma unroll
            for (int e = 0; e < 8; ++e) ss += v[e] * v[e];
            ss += swz_xor<1>(ss); ss += swz_xor<2>(ss); ss += swz_xor<4>(ss);
            const float r = rsqrtf(ss * (1.0f / 64.0f) + RMS_EPS);
            const float* gn = (lc < 32 ? gqa_q_norm : gqa_k_norm) + l * 64 + (lc & 7) * 8;
#pragma unroll
            for (int e = 0; e < 8; ++e) v[e] = v[e] * r * gn[e];
            float o[8];
#pragma unroll
            for (int e = 0; e < 8; ++e) o[e] = swz_xor<2>(v[e]);
            if (!isctx) rope8(v, o, (lc & 4) ? pcol : prow, (lc & 1) * 8, 1.0f / 16.0f, (lc & 2) != 0);
            const float sc = lc < 32 ? 0.125f * LOG2E : 1.0f;
#pragma unroll
            for (int e = 0; e < 8; ++e) v[e] *= sc;
            w.x = pk2(v[0], v[1]); w.y = pk2(v[2], v[3]); w.z = pk2(v[4], v[5]); w.w = pk2(v[6], v[7]);
            if (act) *(u32x4*)(pr + C_GQ + lc * 8) = w;
        }
        {
            const int win = 2 << (lane >> 4), n = isctx ? CTXL : SEQ, ts = isctx ? t - SEQ : t;
            const int lo = max(ts - win / 2, 0), hi = min(ts + win / 2, n);
            const bf16_t* ub = PROJ + ((size_t)(row - ts)) * LDP + lane * 4;
            float s0 = 0.f, s1 = 0.f, s2 = 0.f, s3 = 0.f;
            for (int i = lo; i < hi; ++i) { const u32x2 w = *(const u32x2*)(ub + (size_t)i * LDP); s0 += bflo(w.x); s1 += bfhi(w.x); s2 += bflo(w.y); s3 += bfhi(w.y); }
            const float inv = 1.0f / (float)(hi - lo);
            const u32x2 w = *(const u32x2*)(ub + (size_t)ts * LDP);
            u32x2 o; o.x = pk2(s0 * inv - bflo(w.x), s1 * inv - bfhi(w.x)); o.y = pk2(s2 * inv - bflo(w.y), s3 * inv - bfhi(w.y));
            *(u32x2*)(pr + C_POOL + lane * 4) = o;
        }
    }
    LAS bf16_t* scr = (LAS bf16_t*)(F.lds + F.wave * 16384);
    for (int it = gw; it < (T / 64) * 10; it += NGW) {
        const int tt = it / 10, vh = it % 10, b = tt / 68, key0 = (tt % 68) * 64;
        const int vcol = vh < 4 ? C_DV + 64 * vh : (vh < 8 ? C_NV + 64 * (vh - 4) : C_GV + 64 * (vh - 8));
        const bf16_t* src = PROJ + ((size_t)tt * 64 + lane) * LDP + vcol;
#pragma unroll
        for (int c = 0; c < 8; ++c) { const u32x4 w = *(const u32x4*)(src + c * 8);
            scr[(c * 8 + 0) * 66 + lane] = (bf16_t)(w.x & 0xffff); scr[(c * 8 + 1) * 66 + lane] = (bf16_t)(w.x >> 16);
            scr[(c * 8 + 2) * 66 + lane] = (bf16_t)(w.y & 0xffff); scr[(c * 8 + 3) * 66 + lane] = (bf16_t)(w.y >> 16);
            scr[(c * 8 + 4) * 66 + lane] = (bf16_t)(w.z & 0xffff); scr[(c * 8 + 5) * 66 + lane] = (bf16_t)(w.z >> 16);
            scr[(c * 8 + 6) * 66 + lane] = (bf16_t)(w.w & 0xffff); scr[(c * 8 + 7) * 66 + lane] = (bf16_t)(w.w >> 16); }
        asm volatile("s_waitcnt lgkmcnt(0)" ::: "memory");
        bf16_t* dst = VT + (((size_t)b * 10 + vh) * 64 + lane) * TPB + key0;
        const LAS unsigned* rd = (const LAS unsigned*)(scr + lane * 66);
#pragma unroll
        for (int c = 0; c < 8; ++c) { u32x4 w; w.x = rd[c * 4 + 0]; w.y = rd[c * 4 + 1]; w.z = rd[c * 4 + 2]; w.w = rd[c * 4 + 3]; *(u32x4*)(dst + c * 8) = w; }
        asm volatile("s_waitcnt lgkmcnt(0)" ::: "memory");
    }
}

constexpr int ATT_K = 0, ATT_V = 16384, ATT_BIAS = 32768, ATT_Q = 36864;
template <int MODE>
__device__ __forceinline__ void attn_unit(Frame& F, int l, int b, int h, int qt, bool gq = false) {
    LAS unsigned char* lds = F.lds;
    bf16_t* PROJ = WSB(WS_PROJ); const bf16_t* VT = WSB(WS_VT);
    int tid_ = F.tid; asm volatile("" : "+v"(tid_));
    const int tid = tid_, lane = tid & 63, wid = F.wave, r32 = lane & 31, hi = lane >> 5;
    const int qcol = (MODE == 0 || gq) ? C_GQ + 64 * h : (MODE == 1 ? C_DQ + 64 * h : C_NQ + 64 * h);
    const int kcol = (MODE == 0 || gq) ? C_GK + 64 * (h >> 1) : (MODE == 1 ? C_DK + 64 * h : C_NK + 64 * h);
    const int vh = (MODE == 0 || gq) ? 8 + (h >> 1) : (MODE == 1 ? h : 4 + h);
    const size_t rowbase = (size_t)b * TPB;
    const size_t qrow = rowbase + (size_t)qt * 256 + wid * 32 + r32;
    int a0, nA, b0 = 0, nBt = 0;
    if (qt == 16) { a0 = 64; nA = 4; }
    else if (MODE == 2 && !gq) { a0 = 64; nA = 4; b0 = min(max(4 * qt - 4, 0), 56); nBt = min(max(4 * qt - 1, 0), 56) + 8 - b0; }
    else { a0 = 0; nA = 68; }
    const int ntl = nA + nBt;
    bf16x8 qr[4];
    { const bf16_t* qp = PROJ + qrow * LDP + qcol + 8 * hi;
#pragma unroll
      for (int s = 0; s < 4; ++s) qr[s] = *(const bf16x8*)(qp + 16 * s); }
    const int srow = tid >> 3, sch = tid & 7;
    const bf16_t* kg = PROJ + (rowbase + srow) * LDP + kcol + sch * 8;
    const bf16_t* vg = VT + (((size_t)b * 10 + vh) * 64 + srow) * TPB + sch * 8;
    const int swz = (srow >> 1) & 7;
    const int kst = srow * 128 + ((sch ^ swz) << 4), vst = ATT_V + srow * 128 + ((sch ^ swz) << 4);
    const bool vswap = (srow & 16) != 0;
    const int rsw = (r32 >> 1) & 7;
    const int kfr = r32 * 128;
    const int vfr = ATT_V + r32 * 128 + 8 * (hi ^ ((r32 >> 4) & 1));
    if (MODE == 2 && qt < 16 && !gq) { for (int i = tid; i < 465; i += 512) ((LAS float*)(lds + ATT_BIAS))[i] = inptr(I_RPB)[((size_t)l * 4 + h) * 465 + i] * LOG2E; }
    float m0 = -1e30f, l0 = 0.f, m1 = -1e30f, l1 = 0.f;
    f32x16 oA[2], oB[2];
#pragma unroll
    for (int i = 0; i < 2; ++i) { oA[i] = (f32x16){}; oB[i] = (f32x16){}; }
    const int qgr = 4 * qt + (wid >> 1), qj = 32 * (wid & 1) + r32;
    const int wstart = min(max(qgr - 4, 0), 56), cst = min(max(qj - 8, 0), 48);

    auto tile_key0 = [&](int i) -> int { return (i < nA ? a0 + i : b0 + (i - nA)) * 64; };
    u32x4 kreg, vreg;
    { const int k0 = tile_key0(0); kreg = *(const u32x4*)(kg + (size_t)k0 * LDP); vreg = *(const u32x4*)(vg + k0); }
    { *(LAS u32x4*)(lds + kst) = kreg; u32x4 vv = vreg; if (vswap) vv = (u32x4){vreg.z, vreg.w, vreg.x, vreg.y}; *(LAS u32x4*)(lds + vst) = vv; }
    __syncthreads();
    for (int i = 0; i < ntl; ++i) {
        const int buf = (i & 1) * 8192;
        if (i + 1 < ntl) { const int k0 = tile_key0(i + 1); kreg = *(const u32x4*)(kg + (size_t)k0 * LDP); vreg = *(const u32x4*)(vg + k0); }
        bool part = true; int dr = 0;
        if (MODE == 2 && i >= nA) { const int kr = b0 + (i - nA); part = (kr >= wstart) && (kr < wstart + 8); dr = kr - qgr + 7; }
        if (part) {
#pragma unroll
            for (int c = 0; c < (MODE == 1 ? 2 : 1); ++c) {
                f32x16 p0 = (f32x16){}, p1 = (f32x16){};
#pragma unroll
                for (int s = (MODE == 1 ? 2 * c : 0); s < (MODE == 1 ? 2 * c + 2 : 4); ++s) {
                    const bf16x8 k0f = *(const LAS bf16x8*)(lds + buf + kfr + (((2 * s + hi) ^ rsw) << 4));
                    const bf16x8 k1f = *(const LAS bf16x8*)(lds + buf + kfr + 4096 + (((2 * s + hi) ^ rsw) << 4));
                    p0 = __builtin_amdgcn_mfma_f32_32x32x16_bf16(k0f, qr[s], p0, 0, 0, 0);
                    p1 = __builtin_amdgcn_mfma_f32_32x32x16_bf16(k1f, qr[s], p1, 0, 0, 0);
                }
                if (MODE == 2 && i >= nA) {
                    const LAS float* bt = (const LAS float*)(lds + ATT_BIAS) + dr * 31 + 15 - qj;
#pragma unroll
                    for (int r = 0; r < 16; ++r) { const int kj = (r & 3) + 8 * (r >> 2) + 4 * hi;
                        { const int ix = min(max(kj - qj, -15), 15) + qj; const bool ok = (kj >= cst) && (kj < cst + 16); p0[r] = ok ? p0[r] + bt[ix] : -1e30f; }
                        { const int k2 = kj + 32; const int ix = min(max(k2 - qj, -15), 15) + qj; const bool ok = (k2 >= cst) && (k2 < cst + 16); p1[r] = ok ? p1[r] + bt[ix] : -1e30f; } }
                }
                float& mm = (c == 0) ? m0 : m1; float& ll = (c == 0) ? l0 : l1; f32x16* oo = (c == 0) ? oA : oB;
                float mx = fmaxf(p0[0], p1[0]);
#pragma unroll
                for (int r = 1; r < 16; ++r) mx = fmaxf(mx, fmaxf(p0[r], p1[r]));
                mx = half_max(mx);
                const float mnew = fmaxf(mm, mx), alpha = fast_exp2(mm - mnew); mm = mnew;
                float rs = 0.f;
#pragma unroll
                for (int r = 0; r < 16; ++r) { p0[r] = fast_exp2(p0[r] - mnew); p1[r] = fast_exp2(p1[r] - mnew); rs += p0[r] + p1[r]; }
                ll = ll * alpha + rs;
#pragma unroll
                for (int r = 0; r < 16; ++r) { oo[0][r] *= alpha; oo[1][r] *= alpha; }
                bf16x8 pk[4];
#pragma unroll
                for (int s = 0; s < 4; ++s) { u32x4 w;
                    if (s < 2) { w.x = cvt_pk_bf16(p0[8 * s + 0], p0[8 * s + 1]); w.y = cvt_pk_bf16(p0[8 * s + 2], p0[8 * s + 3]); w.z = cvt_pk_bf16(p0[8 * s + 4], p0[8 * s + 5]); w.w = cvt_pk_bf16(p0[8 * s + 6], p0[8 * s + 7]); }
                    else { const int q8 = 8 * (s - 2); w.x = cvt_pk_bf16(p1[q8 + 0], p1[q8 + 1]); w.y = cvt_pk_bf16(p1[q8 + 2], p1[q8 + 3]); w.z = cvt_pk_bf16(p1[q8 + 4], p1[q8 + 5]); w.w = cvt_pk_bf16(p1[q8 + 6], p1[q8 + 7]); }
                    pk[s] = __builtin_bit_cast(bf16x8, w); }
#pragma unroll
                for (int db = 0; db < 2; ++db)
#pragma unroll
                    for (int s = 0; s < 4; ++s) {
                        const u32x2 lo = *(const LAS u32x2*)(lds + buf + vfr + 4096 * db + (((2 * s) ^ rsw) << 4));
                        const u32x2 hh = *(const LAS u32x2*)(lds + buf + vfr + 4096 * db + (((2 * s + 1) ^ rsw) << 4));
                        const u32x4 vv = (u32x4){lo.x, lo.y, hh.x, hh.y};
                        oo[db] = __builtin_amdgcn_mfma_f32_32x32x16_bf16(__builtin_bit_cast(bf16x8, vv), pk[s], oo[db], 0, 0, 0);
                    }
            }
        }
        if (i + 1 < ntl) { const int nb = ((i + 1) & 1) * 8192; *(LAS u32x4*)(lds + nb + kst) = kreg; u32x4 vv = vreg; if (vswap) vv = (u32x4){vreg.z, vreg.w, vreg.x, vreg.y}; *(LAS u32x4*)(lds + nb + vst) = vv; }
        __syncthreads();
    }
    bf16_t* op = PROJ + qrow * LDP + qcol + 4 * hi;
    if (MODE == 1) {
        const float lam = WSF(WS_MOD)[131072 + l], lam_init = 0.8f - 0.6f * expf(-0.3f * (float)l);
        const float i0 = 1.0f / half_sum(l0), i1 = lam / half_sum(l1);
        float ss = 0.f;
#pragma unroll
        for (int db = 0; db < 2; ++db)
#pragma unroll
            for (int r = 0; r < 16; ++r) { const float v = oA[db][r] * i0 - oB[db][r] * i1; oA[db][r] = v; ss += v * v; }
        ss = half_sum(ss);
        const float rn = rsqrtf(ss * (1.0f / 64.0f) + RMS_EPS) * (1.0f - lam_init);
        const float* gn = inptr(I_DNG) + l * 64 + 4 * hi;
#pragma unroll
        for (int db = 0; db < 2; ++db)
#pragma unroll
            for (int g4 = 0; g4 < 4; ++g4) { const f32x4 g = *(const f32x4*)(gn + 32 * db + 8 * g4);
                u32x2 w; w.x = pk2(oA[db][4 * g4 + 0] * rn * g.x, oA[db][4 * g4 + 1] * rn * g.y); w.y = pk2(oA[db][4 * g4 + 2] * rn * g.z, oA[db][4 * g4 + 3] * rn * g.w);
                *(u32x2*)(op + 32 * db + 8 * g4) = w; }
    } else {
        const float i0 = 1.0f / half_sum(l0);
#pragma unroll
        for (int db = 0; db < 2; ++db)
#pragma unroll
            for (int g4 = 0; g4 < 4; ++g4) { u32x2 w; w.x = pk2(oA[db][4 * g4 + 0] * i0, oA[db][4 * g4 + 1] * i0); w.y = pk2(oA[db][4 * g4 + 2] * i0, oA[db][4 * g4 + 3] * i0);
                *(u32x2*)(op + 32 * db + 8 * g4) = w; }
    }
}
template <int MODE>
__device__ __forceinline__ void attn_queue(Frame& F, int l, unsigned* qctr, int nq, bool gq = false) {
    const int total = NB * 4 * nq;
    volatile LAS int* slot = (volatile LAS int*)(F.lds + LDS_MISC + 64);
    for (;;) {
        if (F.tid == 0) slot[0] = (int)__hip_atomic_fetch_add(qctr, 1u, RLX_AGENT);
        __syncthreads();
        const int id = slot[0];
        __syncthreads();
        if (id >= total) break;
        const int qt = id % nq, bh = id / nq;
        attn_unit<MODE>(F, l, bh >> 2, bh & 3, qt, gq);
    }
}

__device__ __forceinline__ void phase_router(Frame& F, int l) {
    const float *w_eg = inptr(I_WEG), *w_eu = inptr(I_WEU), *w_ed = inptr(I_WED), *w_rg = inptr(I_WRG), *w_re = inptr(I_WRE), *b_rg = inptr(I_BRG), *b_re = inptr(I_BRE), *g_ffn = inptr(I_GFFN);
    bf16_t *GUT = WSB(WS_GUT), *DT = WSB(WS_DT), *H = WSB(WS_H); float *XCTX = WSF(WS_XCTX), *MOD = WSF(WS_MOD); unsigned *ROUTE = WSU(WS_ROUTE), *ctl = WSU(WS_CTL);
    {
        LAS float* scr = (LAS float*)(F.lds + F.wave * 16384) ;
        const int gw = F.vcu * 8 + F.wave, NGW = F.G * 8;
        constexpr int I_G = 16 * 16, I_D = 8 * 32, PER_E = 2 * I_G + I_D;
        for (int it = gw; it < NEXP * PER_E; it += NGW) {
            const int e = it / PER_E; int r = it % PER_E;
            const size_t eo = ((size_t)l * NEXP + e);
            if (r < I_G) { transpose_item(w_eg + eo * D * DEXP, D, DEXP, GUT + (size_t)e * 1024 * 1024, 1024, scr, r, F.lane, RowGU{0}); continue; } r -= I_G;
            if (r < I_G) { transpose_item(w_eu + eo * D * DEXP, D, DEXP, GUT + (size_t)e * 1024 * 1024, 1024, scr, r, F.lane, RowGU{1}); continue; } r -= I_G;
            transpose_item(w_ed + eo * DEXP * D, DEXP, D, DT + (size_t)e * 1024 * 512, 512, scr, r, F.lane, RowId{});
        }
    }
    __syncthreads();
    LAS float* wt = (LAS float*)F.lds;
    LAS int* lcnt = (LAS int*)(F.lds + 147456);
    LAS unsigned* rinfo = (LAS unsigned*)(F.lds + 147456 + 256);
    for (int i = F.tid; i < 1024 * 36; i += 512) { const int k = i / 36, o = i % 36; wt[i] = o < 4 ? w_rg[((size_t)l * D + k) * 4 + o] : w_re[((size_t)l * D + k) * 32 + (o - 4)]; }
    if (F.tid < 64) lcnt[F.tid] = 0;
    __syncthreads();
    const int row_base = F.vcu * 136;
    for (int rl = F.wave; rl < 136; rl += 8) {
        const int row = row_base + rl; const int b = row / TPB, t = row % TPB; const bool isctx = t >= SEQ;
        if (isctx && l == 1) { if (F.lane == 0) rinfo[rl * 6] = 0xffffffffu; continue; }
        const int mb = isctx ? 8 : b;
        const float* xr = isctx ? XCTX + ((size_t)b * CTXL + (t - SEQ)) * D : F.out + ((size_t)b * SEQ + t) * D;
        float xv[16]; float ss = 0.f;
#pragma unroll
        for (int i = 0; i < 16; ++i) { xv[i] = xr[F.lane + 64 * i]; ss += xv[i] * xv[i]; }
        const float r = rsqrtf(wave_sum(ss) * (1.0f / D) + RMS_EPS);
        const float* gf = g_ffn + l * D; const float* sh = MOD + ((size_t)l * 9 + mb) * 6144 + 3 * 1024; const float* sc = sh + 1024;
        bf16_t* h2 = H + (size_t)row * D;
        float acc[36];
#pragma unroll
        for (int o = 0; o < 36; ++o) acc[o] = 0.f;
#pragma unroll
        for (int i = 0; i < 16; ++i) { const int k = F.lane + 64 * i; const float hv = xv[i] * r * gf[k] * (1.0f + sc[k]) + sh[k];
            h2[k] = (bf16_t)f2bf(hv);
            const LAS f32x4* wp = (const LAS f32x4*)(wt + k * 36);
#pragma unroll
            for (int q = 0; q < 9; ++q) { const f32x4 w = wp[q]; acc[4 * q + 0] += hv * w.x; acc[4 * q + 1] += hv * w.y; acc[4 * q + 2] += hv * w.z; acc[4 * q + 3] += hv * w.w; } }
#pragma unroll
        for (int o = 0; o < 36; ++o) acc[o] = wave_sum(acc[o]);
        float gl[4];
#pragma unroll
        for (int g = 0; g < 4; ++g) gl[g] = acc[g] + b_rg[l * 4 + g];
        int grp = 0; float gm = gl[0];
#pragma unroll
        for (int g = 1; g < 4; ++g) if (gl[g] > gm) { gm = gl[g]; grp = g; }
        float gs = 0.f;
#pragma unroll
        for (int g = 0; g < 4; ++g) gs += __expf(gl[g] - gm);
        const float wgrp = 1.0f / gs;
        LAS float* wsc = (LAS float*)(F.lds + 150976 + F.wave * 256);
        if (F.lane == 0) {
#pragma unroll
            for (int o = 0; o < 32; ++o) wsc[o] = acc[4 + o]; }
        asm volatile("s_waitcnt lgkmcnt(0)" ::: "memory");
        float ev[8];
#pragma unroll
        for (int j = 0; j < 8; ++j) ev[j] = wsc[grp * 8 + j] + b_re[l * 32 + grp * 8 + j];
        asm volatile("s_waitcnt lgkmcnt(0)" ::: "memory");
        int i1 = 0; float v1 = ev[0];
#pragma unroll
        for (int j = 1; j < 8; ++j) if (ev[j] > v1) { v1 = ev[j]; i1 = j; }
        int i2 = -1; float v2 = -3.0e38f;
#pragma unroll
        for (int j = 0; j < 8; ++j) if (j != i1 && ev[j] > v2) { v2 = ev[j]; i2 = j; }
        const float e2 = __expf(v2 - v1), w1 = wgrp / (1.0f + e2), w2 = wgrp * e2 / (1.0f + e2);
        if (F.lane == 0) {
            const int ea = grp * 8 + i1, eb = grp * 8 + i2;
            const int sa = __hip_atomic_fetch_add(lcnt + ea, 1, __ATOMIC_RELAXED, __HIP_MEMORY_SCOPE_WORKGROUP);
            const int sb = __hip_atomic_fetch_add(lcnt + eb, 1, __ATOMIC_RELAXED, __HIP_MEMORY_SCOPE_WORKGROUP);
            rinfo[rl * 6 + 0] = (unsigned)ea; rinfo[rl * 6 + 1] = (unsigned)eb; rinfo[rl * 6 + 2] = (unsigned)sa; rinfo[rl * 6 + 3] = (unsigned)sb;
            rinfo[rl * 6 + 4] = __builtin_bit_cast(unsigned, w1); rinfo[rl * 6 + 5] = __builtin_bit_cast(unsigned, w2);
        }
    }
    __syncthreads();
    if (F.tid < 32) lcnt[32 + F.tid] = (int)__hip_atomic_fetch_add(ctl + CW_CNT + l * 32 + F.tid, (unsigned)lcnt[F.tid], RLX_AGENT);
    __syncthreads();
    if (F.tid < 136) { const int rl = F.tid; const unsigned ea = rinfo[rl * 6];
        if (ea != 0xffffffffu) { const unsigned eb = rinfo[rl * 6 + 1]; unsigned* ro = ROUTE + (size_t)(row_base + rl) * 8;
            ro[0] = ea; ro[1] = eb; ro[2] = rinfo[rl * 6 + 2] + (unsigned)lcnt[32 + ea]; ro[3] = rinfo[rl * 6 + 3] + (unsigned)lcnt[32 + eb]; ro[4] = rinfo[rl * 6 + 4]; ro[5] = rinfo[rl * 6 + 5]; } }
    __syncthreads();
}
__device__ __forceinline__ int build_tiles(Frame& F, int l) {
    LAS int* offs = (LAS int*)(F.lds + LDS_MISC + 128);
    LAS int* tile_e = (LAS int*)(F.lds + LDS_TILE_E);
    __syncthreads();
    if (F.tid == 0) { int o = 0, k = 0;
        for (int e = 0; e < NEXP; ++e) { const int c = (int)__hip_atomic_load(WSU(WS_CTL) + CW_CNT + l * 32 + e, RLX_AGENT); offs[e] = o; const int nt = (c + 255) >> 8;
            for (int j = 0; j < nt && k < MPAD / 256; ++j) tile_e[k++] = e; o += nt << 8; }
        offs[32] = k; }
    __syncthreads();
    return __builtin_amdgcn_readfirstlane(offs[32]);
}
__device__ __forceinline__ void phase_scatter(Frame& F, int l) {
    (void)build_tiles(F, l);
    const LAS int* offs = (const LAS int*)(F.lds + LDS_MISC + 128);
    const int gw = F.vcu * 8 + F.wave, NGW = F.G * 8;
    unsigned* ROUTE = WSU(WS_ROUTE); float* ROWW = WSF(WS_ROWW); bf16_t *H = WSB(WS_H), *SORTED = WSB(WS_PROJ);
    for (int row = gw; row < T; row += NGW) {
        if (l == 1 && (row % TPB) >= SEQ) continue;
        unsigned* ro = ROUTE + (size_t)row * 8;
        const unsigned ea = ro[0], eb = ro[1];
        const unsigned pa = (unsigned)offs[ea] + ro[2], pb = (unsigned)offs[eb] + ro[3];
        const u32x4* src = (const u32x4*)(H + (size_t)row * D) + F.lane;
        const u32x4 v0 = src[0], v1 = src[64];
        if (pa < (unsigned)MPAD && pb < (unsigned)MPAD) {
            u32x4* da = (u32x4*)(SORTED + (size_t)pa * D) + F.lane; u32x4* db = (u32x4*)(SORTED + (size_t)pb * D) + F.lane;
            da[0] = v0; da[64] = v1; db[0] = v0; db[64] = v1;
            if (F.lane == 0) { ROWW[pa] = __builtin_bit_cast(float, ro[4]); ROWW[pb] = __builtin_bit_cast(float, ro[5]); ro[6] = pa; ro[7] = pb; }
        }
    }
}

#define IN(k) (lo <= (k) && (k) < hi)
#define SEAM(k) do { if (IN(k) && IN((k) + 1)) { XcdBarrier b2 = bar; asm volatile("" : "+s"(b2.bar)); xcd_barrier(b2); } } while (0)
template <int l>
__device__ __forceinline__ void run_layer(const Frame& F0, const XcdBarrier& bar, int lo, int hi) {
    constexpr int P = 1 + 10 * l;
        if (IN(P + 0)) { Frame F = launder(F0); phase_modulate(F, l); } SEAM(P + 0);
        if (IN(P + 1)) { Frame F = launder(F0);
            pg8::Gemm g{D * 2, D * 2, D}; SchedIn S{F.G, F.bx, (const char*)WSB(WS_H), (const char*)(WSB(WS_WIN) + (size_t)l * NIN * D)}; EpiIn E{WSB(WS_PROJ), WSB(WS_GATES)};
            pg8::gemm_phase<EpiIn, SchedIn, true>(F.lds, g, S, E);
        } SEAM(P + 1);
        if (IN(P + 2)) { Frame F = launder(F0); phase_post(F, l); } SEAM(P + 2);
        if (IN(P + 3)) { Frame F = launder(F0);
            const int nq = l == 0 ? 17 : 16;
            attn_queue<0>(F, l, WSU(WS_CTL) + CW_Q + (l * 4 + 1) * 64, nq);
            attn_queue<1>(F, l, WSU(WS_CTL) + CW_Q + (l * 4 + 0) * 64, nq);
            attn_queue<2>(F, l, WSU(WS_CTL) + CW_Q + (l * 4 + 2) * 64, nq);
        } SEAM(P + 3);
        if (IN(P + 4)) { Frame F = launder(F0);
            pg8::Gemm g{LDP * 2, 256 * 2, 256}; SchedMerge S{F.G, F.bx, l == 0 ? 136 : 128, l, (const char*)WSB(WS_PROJ), (const char*)(WSB(WS_WBR) + (size_t)l * 4 * D * 256)}; EpiMerge E{WSB(WS_H), WSB(WS_GATES)};
            pg8::gemm_phase<EpiMerge, SchedMerge, true>(F.lds, g, S, E);
        } SEAM(P + 4);
        if (IN(P + 5)) { Frame F = launder(F0);
            pg8::Gemm g{D * 2, D * 2, D}; SchedOut S{F.G, F.bx, l == 0 ? 136 : 128, l, (const char*)WSB(WS_H), (const char*)(WSB(WS_WOUT) + (size_t)l * D * D)};
            EpiOut E{l == 0 ? inptr(I_X) : (const float*)F.out, l == 0 ? inptr(I_CTX) : (const float*)WSF(WS_XCTX), F.out, WSF(WS_XCTX), WSF(WS_MOD) + (size_t)l * 9 * 6144};
            pg8::gemm_phase<EpiOut, SchedOut, true>(F.lds, g, S, E);
        } SEAM(P + 5);
        if (IN(P + 6)) { Frame F = launder(F0); phase_router(F, l); } SEAM(P + 6);
        if (IN(P + 7)) { Frame F = launder(F0); phase_scatter(F, l); } SEAM(P + 7);
        if (IN(P + 8)) { Frame F = launder(F0);
            const int ntiles = build_tiles(F, l);
            pg8::Gemm g{D * 2, D * 2, D}; SchedMoe<1024> S{F.G, F.vcu, ntiles, (const LAS int*)(F.lds + LDS_TILE_E), (const char*)WSB(WS_PROJ), (const char*)WSB(WS_GUT)}; EpiGU E{WSB(WS_HMID)};
            pg8::gemm_phase<EpiGU, SchedMoe<1024>, true>(F.lds, g, S, E);
        } SEAM(P + 8);
        if (IN(P + 9)) { Frame F = launder(F0);
            const int ntiles = build_tiles(F, l);
            pg8::Gemm g{DEXP * 2, DEXP * 2, DEXP}; SchedMoe<512> S{F.G, F.vcu, ntiles, (const LAS int*)(F.lds + LDS_TILE_E), (const char*)WSB(WS_HMID), (const char*)WSB(WS_DT)}; EpiDown E{WSB(WS_PROJ), WSF(WS_ROWW)};
            pg8::gemm_phase<EpiDown, SchedMoe<512>, true>(F.lds, g, S, E);
        } SEAM(P + 9);
    }
constexpr int N_PHASES = 22;
__global__ void __launch_bounds__(512, 2) fwd_kernel(Args args) {
    extern __shared__ __attribute__((aligned(16))) unsigned char lds_raw[];
    Frame F0;
    F0.lds = (LAS unsigned char*)lds_raw;
    F0.tid = threadIdx.x; F0.lane = F0.tid & 63; F0.wave = __builtin_amdgcn_readfirstlane(F0.tid >> 6);
    F0.G = gridDim.x; F0.bx = blockIdx.x; { const int bx = blockIdx.x; F0.vcu = (F0.G % 8 == 0) ? (bx % 8) * (F0.G / 8) + bx / 8 : bx; }
    F0.ws = args.ws; F0.out = args.out;
    for (int u = F0.tid; u < (LDS_BYTES - LDS_MISC) / 4; u += 512) ((LAS unsigned*)(F0.lds + LDS_MISC))[u] = 0u;
    __syncthreads();
    const int lo = args.ph_lo, hi = args.ph_hi;
    XcdBarrier bar; bar.bar = ((unsigned*)(F0.ws + WS_CTL)) + CW_BAR; bar.x = 0; bar.st = nullptr;
    if (hi - lo > 1) bar = xcd_barrier_post(((unsigned*)(F0.ws + WS_CTL)) + CW_BAR, (volatile LAS unsigned*)(F0.lds + LDS_MISC + 32));

    if (IN(0)) { Frame F = launder(F0); p0_prologue(F); } SEAM(0);
    run_layer<0>(F0, bar, lo, hi);
    run_layer<1>(F0, bar, lo, hi);
    if (IN(21)) { Frame F = launder(F0); phase_modulate(F, 2); }
#undef IN
#undef SEAM
}


#if MK_CHECK
constexpr size_t WS_CHK = 512 * 1024;
constexpr size_t WS_CHKBUF = WS_END;
__device__ __forceinline__ unsigned hsh(unsigned x) { x ^= x >> 16; x *= 0x7feb352du; x ^= x >> 15; x *= 0x846ca68bu; x ^= x >> 16; return x; }
__device__ __forceinline__ void chk_put(unsigned* CHK, int id, float err) { if (!(err >= 0.f)) err = 1e30f; atomicMax(CHK + id, __builtin_bit_cast(unsigned, err)); }
__device__ __forceinline__ float ref_rope_elem(const float* v, int nd, int idx, int t) {
    if (idx >= nd) return 0.f;
    const int h = nd / 2, half = h / 2; const int sec = idx / h, ii = idx % h; const float pos = sec == 0 ? (float)(t / 64) : (float)(t % 64);
    const int i = ii % half; const float inv = powf(10000.0f, -(float)i / (float)half); const float ang = pos * inv, cs = cosf(ang), sn = sinf(ang);
    const float x1 = v[sec * h + i], x2 = v[sec * h + half + i];
    return ii < half ? x1 * cs - x2 * sn : x1 * sn + x2 * cs;
}
__global__ void chk_kernel(Args args, int which, int l) {
    unsigned char* ws = args.ws; unsigned* CHK = (unsigned*)(ws + WS_CHK);
    const float* const* in = args.in;
    const bf16_t* H = (const bf16_t*)(ws + WS_H); const bf16_t* PROJ = (const bf16_t*)(ws + WS_PROJ); const bf16_t* GATES = (const bf16_t*)(ws + WS_GATES); const bf16_t* VT = (const bf16_t*)(ws + WS_VT);
    const float* MOD = (const float*)(ws + WS_MOD); const float* XCTX = (const float*)(ws + WS_XCTX); const unsigned* ROUTE = (const unsigned*)(ws + WS_ROUTE); const float* ROWW = (const float*)(ws + WS_ROWW);
    float* CB = (float*)(ws + WS_CHKBUF);
    const int s = blockIdx.x, tid = threadIdx.x; const unsigned h1 = hsh(s * 2654435761u + 12345u + (which == 5 ? 4 : which) * 977u), h2 = hsh(h1 + 0x9e3779b9u), h3 = hsh(h2 + 77u);
    const int id = l * 16 + which;
    __shared__ float sh[4608]; __shared__ float red[64];
    if (which == 0) {
        if (tid != 0) return; const int ll = s & 1, bb = (s >> 1) % 9, j = h1 % 6144; float acc = 0.f;
        for (int k = 0; k < 1024; ++k) { const float v = bb < 8 ? in[I_C][bb * 1024 + k] : in[I_CCTX][k]; acc += v / (1.f + expf(-v)) * in[I_WMOD][((size_t)ll * 1024 + k) * 6144 + j]; }
        acc += in[I_BMOD][ll * 6144 + j]; chk_put(CHK, id, fabsf(acc - MOD[((size_t)ll * 9 + bb) * 6144 + j]));
    } else if (which == 1) {
        if (tid != 0) return; const int row = h1 % T, col = h2 % 1024, b = row / TPB, t = row % TPB; const bool ic = t >= SEQ;
        const float* x = ic ? in[I_CTX] + ((size_t)b * CTXL + t - SEQ) * D : in[I_X] + ((size_t)b * SEQ + t) * D; float ss = 0.f;
        for (int k = 0; k < 1024; ++k) ss += x[k] * x[k];
        const float r = 1.0f / sqrtf(ss / 1024.f + 1e-6f); const float* m = MOD + (size_t)(ic ? 8 : b) * 6144;
        const float e = x[col] * r * in[I_GMIX][col] * (1.f + m[1024 + col]) + m[col]; chk_put(CHK, id, fabsf(e - bf2f(H[(size_t)row * D + col])));
    } else if (which == 2) {
        if (tid != 0) return; const int row = h1 % T, col = h2 % NIN; float acc = 0.f;
        for (int k = 0; k < 1024; ++k) acc += bf2f(H[(size_t)row * D + k]) * in[I_WIN][((size_t)l * 1024 + k) * NIN + col];
        const float got = col < 2304 ? bf2f(PROJ[(size_t)row * LDP + col]) : bf2f(GATES[(size_t)row * NGATE + col - 2304]);
        const float e = col < 2304 ? acc : 1.f / (1.f + expf(-acc)); chk_put(CHK, id, fabsf(e - got));
    } else if (which == 3) {
        const int kind = s % 7, row = h1 % T, b = row / TPB, t = row % TPB; const bool ic = t >= SEQ;
        int c0 = 0, nd = 64; const int hh = h2 & 3;
        if (kind == 0) { c0 = C_DQ + 32 * (h2 & 7); nd = 32; } else if (kind == 1) { c0 = C_DK + 32 * (h2 & 7); nd = 32; } else if (kind == 2) c0 = C_GQ + 64 * hh; else if (kind == 3) c0 = C_GK + 64 * (hh & 1);
        else if (kind == 4) c0 = C_NQ + 64 * hh; else if (kind == 5) c0 = 64 * hh; else c0 = (h3 % 10 < 4 ? C_DV + 64 * (h3 % 10) : (h3 % 10 < 8 ? C_NV + 64 * (h3 % 10 - 4) : C_GV + 64 * (h3 % 10 - 8)));
        if (kind == 5) {
            const int ch = c0 + tid, win = 2 << (ch / 64), n = ic ? CTXL : SEQ, ts = ic ? t - SEQ : t, lo = max(ts - win / 2, 0), hi = min(ts + win / 2, n); float sum = 0.f, self = 0.f;
            for (int i = lo; i < hi; ++i) { const size_t r2 = (size_t)(row - ts + i); float acc = 0.f; for (int k = 0; k < 1024; ++k) acc += bf2f(H[r2 * D + k]) * in[I_WIN][((size_t)l * 1024 + k) * NIN + ch]; sum += acc; if (i == ts) self = acc; }
            chk_put(CHK, id, fabsf(sum / (float)(hi - lo) - self - bf2f(PROJ[(size_t)row * LDP + C_POOL + ch]))); return; }
        float acc = 0.f; if (tid < nd) for (int k = 0; k < 1024; ++k) acc += bf2f(H[(size_t)row * D + k]) * in[I_WIN][((size_t)l * 1024 + k) * NIN + c0 + tid];
        sh[tid] = acc; __syncthreads();
        if (kind == 6) { const int vh = h3 % 10; chk_put(CHK, id, fabsf(acc - bf2f(VT[(((size_t)b * 10 + vh) * 64 + tid) * TPB + t]))); return; }
        float* v = sh + 64;
        if (kind == 2 || kind == 3) { float ss = 0.f; for (int i = 0; i < 64; ++i) ss += sh[i] * sh[i]; const float r = 1.f / sqrtf(ss / 64.f + 1e-6f); const float* g = (kind == 2 ? in[I_QN] : in[I_KN]) + l * 64; v[tid] = sh[tid] * r * g[tid]; }
        else v[tid] = sh[tid];
        __syncthreads();
        float e = v[tid]; if (!ic && kind <= 3) e = ref_rope_elem(v, nd, tid, t);
        if (kind == 0) e *= 0.17677669529663687f * LOG2E; if (kind == 2 || kind == 4) e *= 0.125f * LOG2E;
        if (tid < nd) chk_put(CHK, id, fabsf(e - bf2f(PROJ[(size_t)row * LDP + c0 + tid])));
    } else if (which == 4 || which == 5) {
        const int mode = s % 3, nq = l == 0 ? 17 : 16, b = h1 % NB, h = h2 & 3, qt = h3 % nq, q = qt * 256 + (hsh(h3) & 255); const size_t rowb = (size_t)b * TPB;
        const int qcol = mode == 0 ? C_GQ + 64 * h : (mode == 1 ? C_DQ + 64 * h : C_NQ + 64 * h), kcol = mode == 0 ? C_GK + 64 * (h >> 1) : (mode == 1 ? C_DK + 64 * h : C_NK + 64 * h), vcol = mode == 0 ? C_GV + 64 * (h >> 1) : (mode == 1 ? C_DV + 64 * h : C_NV + 64 * h);
        if (which == 5) { const float er = fabsf(CB[s * 64 + tid] - bf2f(PROJ[(rowb + q) * LDP + qcol + tid])); chk_put(CHK, l * 16 + (mode == 0 ? 5 : 11 + mode), er);
            if (l == 0 && mode == MK_CHK_MODE) { const float ex = CB[s * 64 + tid], gt = bf2f(PROJ[(rowb + q) * LDP + qcol + tid]);
                atomicAdd((float*)(CHK + 60), ex * gt); atomicAdd((float*)(CHK + 61), ex * ex); atomicAdd((float*)(CHK + 62), gt * gt); } return; }
        const bool ic = q >= SEQ; const int k_lo = ic ? SEQ : 0, k_hi = TPB;
        float outv = 0.f, out2 = 0.f;
        for (int map = 0; map < (mode == 1 ? 2 : 1); ++map) {
            float mx = -3e38f;
            for (int k = k_lo + tid; k < k_hi; k += 64) { float sc = 0.f; const int d0 = mode == 1 ? 32 * map : 0, dn = mode == 1 ? 32 : 64;
                for (int d = 0; d < dn; ++d) sc += bf2f(PROJ[(rowb + q) * LDP + qcol + d0 + d]) * bf2f(PROJ[(rowb + k) * LDP + kcol + d0 + d]);
                if (mode == 2 && !ic) { if (k < SEQ) { const int r = q / 64, j = q % 64, kr = k / 64, kj = k % 64, ws_ = min(max(r - 4, 0), 56), cs = min(max(j - 8, 0), 48);
                        if (kr >= ws_ && kr < ws_ + 8 && kj >= cs && kj < cs + 16) sc += in[I_RPB][(((size_t)l * 4 + h) * 15 + (kr - r + 7)) * 31 + min(max(kj - j, -15), 15) + 15] * LOG2E; else sc = -1e30f; } }
                sh[k] = sc; mx = fmaxf(mx, sc); }
            red[tid] = mx; __syncthreads(); mx = -3e38f; for (int i = 0; i < 64; ++i) mx = fmaxf(mx, red[i]); __syncthreads();
            float sum = 0.f, o = 0.f;
            for (int k = k_lo; k < k_hi; ++k) { const float p = exp2f(sh[k] - mx); sum += p; o += p * bf2f(PROJ[(rowb + k) * LDP + vcol + tid]); }
            __syncthreads();
            if (map == 0) outv = o / sum; else out2 = o / sum;
        }
        if (mode == 1) { const float lam = MOD[131072 + l], li = 0.8f - 0.6f * expf(-0.3f * (float)l); const float v = outv - lam * out2; red[tid] = v * v; __syncthreads(); float ss = 0.f; for (int i = 0; i < 64; ++i) ss += red[i];
            outv = v / sqrtf(ss / 64.f + 1e-6f) * in[I_DNG][l * 64 + tid] * (1.f - li); }
        CB[s * 64 + tid] = outv;
    } else if (which == 12) {
        const unsigned hh = hsh(h1 + tid * 7919u); const int b = hh % NB, vh = (hh >> 4) % 10, d = (hh >> 8) & 63; int key = (hh >> 14) % TPB; if (tid & 1) key = SEQ + (key & 255);
        const int vcol = vh < 4 ? C_DV + 64 * vh : (vh < 8 ? C_NV + 64 * (vh - 4) : C_GV + 64 * (vh - 8));
        if (VT[(((size_t)b * 10 + vh) * 64 + d) * TPB + key] != PROJ[((size_t)b * TPB + key) * LDP + vcol + d]) { atomicAdd(CHK + 58, 1u); atomicOr(CHK + 59, (1u << vh) | (key >= SEQ ? 1024u : 2048u)); }
    } else if (which == 6) {
        if (tid != 0) return; const int nM = l == 0 ? T : NB * SEQ; int row = h1 % nM; if (l == 1) row = (row / SEQ) * TPB + row % SEQ; const int n = h2 % 1024; float tot = 0.f;
        for (int br = 0; br < 4; ++br) { float acc = 0.f;
            if (br == 0) { for (int g = 0; g < 4; ++g) for (int dp = 0; dp < 64; ++dp) { float y = 0.f; for (int c = 0; c < 64; ++c) y += bf2f(PROJ[(size_t)row * LDP + C_POOL + 64 * g + c]) * in[I_POOLW][(((size_t)l * 4 + g) * 64 + c) * 64 + dp];
                    acc += y * in[I_POOLS][l * 256 + 64 * g + dp] * in[I_WBR][(((size_t)l * 4 + 0) * 256 + 64 * g + dp) * D + n]; } }
            else { const int c0 = branch_col(br); for (int k = 0; k < 256; ++k) acc += bf2f(PROJ[(size_t)row * LDP + c0 + k]) * in[I_WBR][(((size_t)l * 4 + br) * 256 + k) * D + n]; }
            tot += acc * bf2f(GATES[(size_t)row * NGATE + br * 1024 + n]); }
        chk_put(CHK, id, fabsf(tot - bf2f(H[(size_t)row * D + n])));
    } else if (which == 7) {
        if (tid != 0 || l != 0) return; const int row = h1 % T, n = h2 % 1024, b = row / TPB, t = row % TPB; const bool ic = t >= SEQ; float acc = 0.f;
        for (int k = 0; k < 1024; ++k) acc += bf2f(H[(size_t)row * D + k]) * in[I_WOUT][((size_t)l * 1024 + k) * D + n];
        const size_t xo = ic ? ((size_t)b * CTXL + t - SEQ) * D + n : ((size_t)b * SEQ + t) * D + n;
        const float e = (ic ? in[I_CTX] : in[I_X])[xo] + MOD[((size_t)l * 9 + (ic ? 8 : b)) * 6144 + 2048 + n] * acc; chk_put(CHK, id, fabsf(e - (ic ? XCTX : args.out)[xo]));
    } else if (which == 8) {
        if (tid != 0) return; int row = h1 % T; if (l == 1) { row = h1 % (NB * SEQ); row = (row / SEQ) * TPB + row % SEQ; } const int b = row / TPB, t = row % TPB; const bool ic = t >= SEQ;
        const float* x = ic ? XCTX + ((size_t)b * CTXL + t - SEQ) * D : args.out + ((size_t)b * SEQ + t) * D; float ss = 0.f; for (int k = 0; k < 1024; ++k) ss += x[k] * x[k];
        const float r = 1.f / sqrtf(ss / 1024.f + 1e-6f); const float* m = MOD + ((size_t)l * 9 + (ic ? 8 : b)) * 6144; float* lg = red; for (int o = 0; o < 36; ++o) lg[o] = 0.f; float herr = 0.f;
        for (int k = 0; k < 1024; ++k) { const float hv = x[k] * r * in[I_GFFN][l * 1024 + k] * (1.f + m[4096 + k]) + m[3072 + k]; herr = fmaxf(herr, fabsf(hv - bf2f(H[(size_t)row * D + k])));
            for (int o = 0; o < 4; ++o) lg[o] += hv * in[I_WRG][((size_t)l * 1024 + k) * 4 + o]; for (int o = 0; o < 32; ++o) lg[4 + o] += hv * in[I_WRE][((size_t)l * 1024 + k) * 32 + o]; }
        for (int o = 0; o < 4; ++o) lg[o] += in[I_BRG][l * 4 + o]; for (int o = 0; o < 32; ++o) lg[4 + o] += in[I_BRE][l * 32 + o];
        int g = 0; for (int o = 1; o < 4; ++o) if (lg[o] > lg[g]) g = o; float gs = 0.f; for (int o = 0; o < 4; ++o) gs += expf(lg[o] - lg[g]);
        int i1 = 0; for (int j = 1; j < 8; ++j) if (lg[4 + g * 8 + j] > lg[4 + g * 8 + i1]) i1 = j; int i2 = -1; for (int j = 0; j < 8; ++j) if (j != i1 && (i2 < 0 || lg[4 + g * 8 + j] > lg[4 + g * 8 + i2])) i2 = j;
        const float v1 = lg[4 + g * 8 + i1], v2 = lg[4 + g * 8 + i2], e2 = expf(v2 - v1), w1 = 1.f / gs / (1.f + e2), w2 = 1.f / gs * e2 / (1.f + e2);
        const unsigned* ro = ROUTE + (size_t)row * 8; float err = herr;
        if (ro[0] != (unsigned)(g * 8 + i1) || ro[1] != (unsigned)(g * 8 + i2)) err = 10.f; else err = fmaxf(err, fmaxf(fabsf(w1 - __builtin_bit_cast(float, ro[4])), fabsf(w2 - __builtin_bit_cast(float, ro[5]))));
        chk_put(CHK, id, err);
    } else if (which == 9) {
        if (tid != 0) return; int row = h1 % T; if (l == 1) { row = h1 % (NB * SEQ); row = (row / SEQ) * TPB + row % SEQ; } const unsigned* ro = ROUTE + (size_t)row * 8; const unsigned* ctl = (const unsigned*)(ws + WS_CTL);
        int off = 0, ofa = 0, ofb = 0; for (int e = 0; e < 32; ++e) { const int c = (int)ctl[CW_CNT + l * 32 + e]; if (e == (int)ro[0]) ofa = off; if (e == (int)ro[1]) ofb = off; off += ((c + 255) >> 8) << 8; }
        float err = 0.f; if (ro[6] != ofa + ro[2] || ro[7] != ofb + ro[3] || ro[2] >= ctl[CW_CNT + l * 32 + ro[0]] || ro[3] >= ctl[CW_CNT + l * 32 + ro[1]]) err = 10.f;
        const bf16_t* S0 = PROJ; for (int k = 0; k < 1024; ++k) { if (S0[(size_t)ro[6] * D + k] != H[(size_t)row * D + k] || S0[(size_t)ro[7] * D + k] != H[(size_t)row * D + k]) err = 5.f; }
        if (ROWW[ro[6]] != __builtin_bit_cast(float, ro[4]) || ROWW[ro[7]] != __builtin_bit_cast(float, ro[5])) err = 3.f; chk_put(CHK, id, err);
    } else if (which == 10 || which == 11) {
        if (tid != 0) return; int row = h1 % T; if (l == 1) { row = h1 % (NB * SEQ); row = (row / SEQ) * TPB + row % SEQ; } const unsigned* ro = ROUTE + (size_t)row * 8; const int sl = h2 & 1; const int e = ro[sl], pos = ro[6 + sl];
        const bf16_t* HM = (const bf16_t*)(ws + WS_HMID);
        if (which == 10) { const int col = h3 % 512; float g = 0.f, u = 0.f; for (int k = 0; k < 1024; ++k) { const float a = bf2f(PROJ[(size_t)pos * D + k]); g += a * in[I_WEG][(((size_t)l * 32 + e) * 1024 + k) * 512 + col]; u += a * in[I_WEU][(((size_t)l * 32 + e) * 1024 + k) * 512 + col]; }
            chk_put(CHK, id, fabsf(g / (1.f + expf(-g)) * u - bf2f(HM[(size_t)pos * 512 + col]))); }
        else { const int n = h3 % 1024; float acc = 0.f; for (int k = 0; k < 512; ++k) acc += bf2f(HM[(size_t)pos * 512 + k]) * in[I_WED][(((size_t)l * 32 + e) * 512 + k) * 1024 + n];
            chk_put(CHK, id, fabsf(acc * __builtin_bit_cast(float, ro[4 + sl]) - bf2f(PROJ[(size_t)pos * D + n]))); }
    }
}
__global__ void chk_encode(Args args) {
    const unsigned* CHK = (const unsigned*)(args.ws + WS_CHK);
    const int order[24] = {0, 1, 2, 3, 12, 13, 5, 6, 7, 8, 9, 10, 11, 16 + 2, 16 + 3, 16 + 5, 16 + 12, 16 + 13, 16 + 6, 16 + 8, 16 + 9, 16 + 10, 16 + 11, -1};
    const float tol[14] = {1e-3f, 0.03f, 0.04f, 0.04f, 0.f, 0.03f, 0.04f, 0.02f, 0.02f, 0.5f, 0.04f, 0.04f, 0.03f, 0.03f};
    float k = 0.f;
    for (int r = 0; r < 24 && order[r] >= 0; ++r) { const float e = __builtin_bit_cast(float, CHK[order[r]]); if (e > tol[order[r] & 15]) { float dg = floorf(log10f(e) + 5.f); dg = fminf(fmaxf(dg, 1.f), 9.f); k = sqrtf(dg * powf(10.f, (float)(r + 2))); break; } }
    float k2 = 0.f;
    if (k == 0.f) return;
    for (size_t i = (size_t)blockIdx.x * blockDim.x + threadIdx.x; i < (size_t)NB * SEQ * D; i += (size_t)gridDim.x * blockDim.x) args.out[i] = (i == 12345 && k2 > 0.f) ? k2 : k;
}
#endif

extern "C" void kernel_launch(void* const* d_in, const int* in_sizes, int n_in, void* d_out, int out_size, void* d_ws, size_t ws_size, hipStream_t stream) {
    static int grid = 0;
    if (grid == 0) {
        if (n_in != 26 || ws_size < WS_END) { fprintf(stderr, "kernel_launch: need 26 inputs and %zu bytes of workspace (got %d, %zu)\n", (size_t)WS_END, n_in, ws_size); grid = -1; return; }
        int dev = 0, cus = 0, per_cu = 0;
        if (hipGetDevice(&dev) != hipSuccess || hipDeviceGetAttribute(&cus, hipDeviceAttributeMultiprocessorCount, dev) != hipSuccess) { grid = -1; return; }
        if (hipFuncSetAttribute((const void*)fwd_kernel, hipFuncAttributeMaxDynamicSharedMemorySize, LDS_BYTES) != hipSuccess) { fprintf(stderr, "kernel_launch: hipFuncSetAttribute failed\n"); grid = -1; return; }
        if (hipOccupancyMaxActiveBlocksPerMultiprocessor(&per_cu, (const void*)fwd_kernel, 512, LDS_BYTES) != hipSuccess || per_cu < 1) { fprintf(stderr, "kernel_launch: occupancy query says %d\n", per_cu); }
        (void)hipGetLastError();
        grid = cus;
    }
    if (grid < 0) return;
    (void)hipMemsetAsync((char*)d_ws + WS_CTL, 0, CTL_ZERO_BYTES, stream);
    Args a{};
    for (int i = 0; i < 26; ++i) a.in[i] = (const float*)d_in[i];
    a.out = (float*)d_out; a.ws = (unsigned char*)d_ws;
#if MK_MULTI
    for (int p = 0; p < N_PHASES; ++p) {
#if MK_CHECK
        const int lq = p == 0 ? 0 : (p - 1) / 10, ph = p == 0 ? -1 : (p - 1) % 10;
        if (p < 21 && ph == 3) hipLaunchKernelGGL(chk_kernel, dim3(192), dim3(64), 0, stream, a, 4, lq);
#endif
        a.ph_lo = p; a.ph_hi = p + 1; hipLaunchKernelGGL(fwd_kernel, dim3(grid), dim3(512), LDS_BYTES, stream, a);
#if MK_CHECK
        if (p == 0) hipLaunchKernelGGL(chk_kernel, dim3(256), dim3(64), 0, stream, a, 0, 0);
        if (p == 1) hipLaunchKernelGGL(chk_kernel, dim3(256), dim3(64), 0, stream, a, 1, 0);
        if (p < 21 && ph == 1) hipLaunchKernelGGL(chk_kernel, dim3(512), dim3(64), 0, stream, a, 2, lq);
        if (p < 21 && ph == 2) hipLaunchKernelGGL(chk_kernel, dim3(448), dim3(64), 0, stream, a, 3, lq);
        if (p < 21 && ph == 3) hipLaunchKernelGGL(chk_kernel, dim3(192), dim3(64), 0, stream, a, 5, lq);
        if (p == 4) hipLaunchKernelGGL(chk_kernel, dim3(1024), dim3(64), 0, stream, a, 12, 0);
        if (p < 21 && ph == 4) hipLaunchKernelGGL(chk_kernel, dim3(256), dim3(64), 0, stream, a, 6, lq);
        if (p < 21 && ph == 5) hipLaunchKernelGGL(chk_kernel, dim3(256), dim3(64), 0, stream, a, 7, lq);
        if (p < 21 && ph == 6) hipLaunchKernelGGL(chk_kernel, dim3(256), dim3(64), 0, stream, a, 8, lq);
        if (p < 21 && ph == 7) hipLaunchKernelGGL(chk_kernel, dim3(128), dim3(64), 0, stream, a, 9, lq);
        if (p < 21 && ph == 8) hipLaunchKernelGGL(chk_kernel, dim3(256), dim3(64), 0, stream, a, 10, lq);
        if (p < 21 && ph == 9) hipLaunchKernelGGL(chk_kernel, dim3(256), dim3(64), 0, stream, a, 11, lq);
#endif
    }
#if MK_CHECK
    hipLaunchKernelGGL(chk_encode, dim3(1024), dim3(256), 0, stream, a);
#endif
#else
    a.ph_lo = 0; a.ph_hi = N_PHASES;
    hipLaunchKernelGGL(fwd_kernel, dim3(grid), dim3(512), LDS_BYTES, stream, a);
#endif
}
```

```cpp
#include <hip/hip_runtime.h>
#include <cstdint>
#include <cstdio>

#ifndef MK_CHECK
#define MK_CHECK 0
#endif
#ifndef MK_CHK_MODE
#define MK_CHK_MODE 0
#endif
#ifndef MK_STAMP
#define MK_STAMP 0
#endif
#ifndef MK_STAMP_A
#define MK_STAMP_A 0
#define MK_STAMP_B 0
#endif
#ifndef MK_MULTI
#define MK_MULTI 0
#endif

#define GAS __attribute__((address_space(1)))
#define LAS __attribute__((address_space(3)))
typedef unsigned short bf16_t;
typedef short bf16x8 __attribute__((ext_vector_type(8)));
typedef float f32x4 __attribute__((ext_vector_type(4)));
typedef float f32x2 __attribute__((ext_vector_type(2)));
typedef float f32x16 __attribute__((ext_vector_type(16)));
typedef unsigned u32x4 __attribute__((ext_vector_type(4)));
typedef unsigned u32x2 __attribute__((ext_vector_type(2)));

constexpr int D = 1024, NB = 8, SEQ = 4096, CTXL = 256, TPB = SEQ + CTXL  , T = NB * TPB  ;
constexpr int LDP = 3584;
constexpr int NGATE = 4096, NIN = 6400;
constexpr int C_DQ = 256, C_DK = 512, C_DV = 768, C_NQ = 1024, C_NK = 1280, C_NV = 1536, C_GQ = 1792, C_GK = 2048, C_GV = 2176, C_POOL = 2304, C_H = 2560;
constexpr int NEXP = 32, DEXP = 512;
constexpr int MPAD = 77824;
constexpr float RMS_EPS = 1e-6f;
constexpr float LOG2E = 1.4426950408889634f;

constexpr size_t MiB = 1u << 20;
constexpr size_t WS_CTL = 0, CTL_ZERO_BYTES = 1 * MiB;
constexpr size_t WS_MOD = 1 * MiB;
constexpr size_t WS_ROUTE = 2 * MiB;
constexpr size_t WS_ROWW = 4 * MiB;
constexpr size_t WS_XCTX = 5 * MiB;
constexpr size_t WS_WIN = 13 * MiB;
constexpr size_t WS_WOUT = 38 * MiB;
constexpr size_t WS_WBR = 42 * MiB;
constexpr size_t WS_H = 58 * MiB;
constexpr size_t WS_PROJ = 126 * MiB;
constexpr size_t WS_X2 = 364 * MiB;
constexpr size_t WS_VT = 536 * MiB;
constexpr size_t WS_END = 624 * MiB;
constexpr size_t WS_DT = WS_X2, WS_HMID = WS_X2 + 32 * MiB, WS_GUT = WS_X2 + 108 * MiB;
constexpr size_t WS_SLAB = WS_VT + 43 * MiB;
constexpr size_t WS_PRIV = WS_SLAB + 16 * MiB;
constexpr size_t WS_Y = WS_GUT;
static_assert((size_t)T * LDP * 2 <= WS_X2 - WS_PROJ && (size_t)MPAD * 1024 * 2 <= WS_X2 - WS_PROJ, "proj region");
static_assert(108 * MiB + 64 * MiB == WS_VT - WS_X2 && WS_Y + (size_t)MPAD * 1024 * 2 <= WS_END, "x2 / y region");
static_assert((size_t)NB * 10 * 64 * TPB * 2 <= WS_END - WS_VT, "vt region");
constexpr int CW_BAR = 1024;
constexpr int CW_CNT = 8192;
constexpr int CW_Q = 8448;
constexpr int CW_XQ = 16384;

constexpr int RING_BYTES = 131072;
constexpr int LDS_MISC = 155648;
constexpr int LDS_BYTES = 159744;
constexpr int LDS_TILE_E = LDS_MISC + 512;
static_assert(LDS_TILE_E + 320 * 4 <= LDS_BYTES, "lds map");

#define RLX_AGENT __ATOMIC_RELAXED, __HIP_MEMORY_SCOPE_AGENT
__device__ __forceinline__ unsigned f2bf(float f) { unsigned u = __builtin_bit_cast(unsigned, f); return (u + 0x7fffu + ((u >> 16) & 1u)) >> 16; }
__device__ __forceinline__ unsigned pk2(float lo, float hi) { return f2bf(lo) | (f2bf(hi) << 16); }
__device__ __forceinline__ float bflo(unsigned w) { return __builtin_bit_cast(float, w << 16); }
__device__ __forceinline__ float bfhi(unsigned w) { return __builtin_bit_cast(float, w & 0xffff0000u); }
__device__ __forceinline__ float bf2f(bf16_t h) { return __builtin_bit_cast(float, (unsigned)h << 16); }
typedef __bf16 bf16x2_t __attribute__((ext_vector_type(2)));
__device__ __forceinline__ unsigned cvt_pk_bf16(float lo, float hi) { f32x2 v = {lo, hi}; bf16x2_t b = __builtin_convertvector(v, bf16x2_t); return __builtin_bit_cast(unsigned, b); }
template <int CTRL, int ROWM = 0xf> __device__ __forceinline__ float dpp_f(float v) { return __builtin_bit_cast(float, __builtin_amdgcn_update_dpp(0, __builtin_bit_cast(int, v), CTRL, ROWM, 0xf, false)); }
template <int M> __device__ __forceinline__ float swz_xor(float v) {
    static_assert(M == 1 || M == 2, "quad permutes only");
    return M == 1 ? dpp_f<0xB1>(v) : dpp_f<0x4E>(v);
}
__device__ __forceinline__ float sum8(float v) { v += dpp_f<0xB1>(v); v += dpp_f<0x4E>(v); v += dpp_f<0x141>(v); return v; }
__device__ __forceinline__ void plswap32(float& a, float& b) { asm volatile("s_nop 1\n\tv_permlane32_swap_b32 %0, %1\n\ts_nop 1" : "+v"(a), "+v"(b)); }
__device__ __forceinline__ float half_sum(float v) { float a = v, b = v; plswap32(a, b); return a + b; }
__device__ __forceinline__ float half_max(float v) { float a = v, b = v; plswap32(a, b); return fmaxf(a, b); }
__device__ __forceinline__ float wave_sum(float v) {
    v = sum8(v); v += dpp_f<0x140>(v);
    v += __builtin_bit_cast(float, __builtin_amdgcn_update_dpp(0, __builtin_bit_cast(int, v), 0x142, 0xa, 0xf, true));
    v += __builtin_bit_cast(float, __builtin_amdgcn_update_dpp(0, __builtin_bit_cast(int, v), 0x143, 0xc, 0xf, true));
    return __builtin_bit_cast(float, __builtin_amdgcn_readlane(__builtin_bit_cast(int, v), 63));
}
__device__ __forceinline__ float fast_exp2(float x) { return __builtin_amdgcn_exp2f(x); }
__device__ __forceinline__ float fast_rcp(float x) { return __builtin_amdgcn_rcpf(x); }
__device__ __forceinline__ float sigmoidf_(float x) { return fast_rcp(1.0f + fast_exp2(-x * LOG2E)); }

#define XB_TMO      128
#define XB_XCNT(j)  (256  + 64 * (j))
#define XB_XSUB(j)  (1280 + 64 * (j))
#define XB_XGEN(j)  (2304 + 64 * (j))
#define XB_TOP      3328
#define XB_TOPGEN   3392
#define XCD_BAR_WORDS 3456
#define XB_SPIN_CAP (1u << 20)
__device__ __forceinline__ unsigned xb_ld(unsigned* p)              { return __hip_atomic_load(p, __ATOMIC_RELAXED, __HIP_MEMORY_SCOPE_AGENT); }
__device__ __forceinline__ unsigned xb_add(unsigned* p, unsigned v) { return __hip_atomic_fetch_add(p, v, __ATOMIC_RELAXED, __HIP_MEMORY_SCOPE_AGENT); }
__device__ __forceinline__ unsigned xb_xcc_id() { return (unsigned)__builtin_amdgcn_s_getreg((3 << 11) | 20) & 0xFu; }
#define XB_SPIN(cond, bar) do { unsigned _sp = 0; while (cond) { __builtin_amdgcn_s_sleep(1); \
    if ((++_sp & 255u) == 0u) { if (xb_ld(&(bar)[XB_TMO])) break; if (_sp > XB_SPIN_CAP) { atomicAdd(&(bar)[XB_TMO], 1u); break; } } } } while (0)
struct XcdBarrier { unsigned* bar; unsigned x; volatile LAS unsigned* st; };
__device__ __forceinline__ XcdBarrier xcd_barrier_post(unsigned* bar, volatile LAS unsigned* st) {
    XcdBarrier b; b.bar = bar; b.x = xb_xcc_id(); b.st = st;
    if (threadIdx.x == 0) (void)xb_add(&bar[XB_XCNT(b.x)], 1u);
    return b;
}
__device__ __forceinline__ void xcd_barrier_complete(unsigned* bar, unsigned x, unsigned& nloc, unsigned& nx) {
    const unsigned G = gridDim.x * gridDim.y * gridDim.z;
    unsigned sum, cnt, mine, sp = 0u;
    for (;;) {
        sum = 0u; cnt = 0u; mine = 0u;
#pragma unroll
        for (unsigned j = 0; j < 16; ++j) { const unsigned c = xb_ld(&bar[XB_XCNT(j)]); sum += c; cnt += (c > 0u) ? 1u : 0u; mine = (j == x) ? c : mine; }
        if (sum == G) break;
        __builtin_amdgcn_s_sleep(1);
        if ((++sp & 255u) == 0u) { if (xb_ld(&bar[XB_TMO])) break; if (sp > XB_SPIN_CAP) { atomicAdd(&bar[XB_TMO], 1u); break; } }
    }
    nloc = mine > 0u ? mine : 1u; nx = cnt > 0u ? cnt : 1u;
}
__device__ __forceinline__ void xcd_barrier(const XcdBarrier& b) {
    asm volatile("s_waitcnt vmcnt(0)" ::: "memory");
    __syncthreads();
    if (threadIdx.x == 0) {
        unsigned* bar = b.bar;
        __builtin_amdgcn_s_waitcnt(0);
        unsigned nloc = b.st[0], nx = b.st[1];
        if (nloc == 0u) { xcd_barrier_complete(bar, b.x, nloc, nx); b.st[0] = nloc; b.st[1] = nx; }
        const unsigned old = xb_add(&bar[XB_XSUB(b.x)], 1u);
        const unsigned gen = old / nloc;
        if (old + 1u == (gen + 1u) * nloc) {
            __builtin_amdgcn_fence(__ATOMIC_RELEASE, "agent");
            asm volatile("s_waitcnt vmcnt(0)" ::: "memory");
            const unsigned og = xb_add(&bar[XB_TOP], 1u);
            const unsigned tg = og / nx;
            if (og + 1u == (tg + 1u) * nx) xb_add(&bar[XB_TOPGEN], 1u);
            else XB_SPIN(xb_ld(&bar[XB_TOPGEN]) == tg, bar);
            __builtin_amdgcn_fence(__ATOMIC_ACQUIRE, "agent");
            xb_add(&bar[XB_XGEN(b.x)], 1u);
            asm volatile("s_waitcnt vmcnt(0)" ::: "memory");
        } else {
            XB_SPIN(xb_ld(&bar[XB_XGEN(b.x)]) == gen, bar);
            __builtin_amdgcn_fence(__ATOMIC_ACQUIRE, "agent");
            asm volatile("s_waitcnt vmcnt(0)" ::: "memory");
        }
    }
    __syncthreads();
}

namespace pg8 {
constexpr int BM = 256, BK = 64, HALF = 128, HTB = HALF * BK * 2, STAGE_BYTES = 8 * HTB, NXCD = 8, WGM = 8;
__host__ __device__ __forceinline__ int lds_byte(int r, int c) { const int st = (r >> 4) * 2 + (c >> 5), rr = r & 15, cc = c & 31, ob = rr * 64 + cc * 2; return st * 1024 + (ob ^ (((ob >> 9) & 1) << 5)); }
__host__ __device__ __forceinline__ void stage_rc(int b, int& R, int& C) { const int st = b / 1024, sb = b % 1024, swz = sb ^ (((sb >> 9) & 1) << 5); R = (st >> 1) * 16 + swz / 64; C = (st & 1) * 32 + (swz % 64) / 2; }
__host__ __device__ __forceinline__ int perm32(int rho) { const int n = rho >> 4, i = rho & 15; return 8 * (i >> 2) + 4 * n + (i & 3); }

struct Unit { int pm, pn, aux, nt; const char* A; const char* B; };
struct Gemm { int lda, ldb; };

__device__ __forceinline__ bool tile_order(int nM, int nN, int G, int c, int i, int& pm, int& pn) {
    const int nwg = nM * nN; const long L = (long)i * G + c; if (L >= nwg) return false;
    int wgid = (int)L; { const int q = nwg / NXCD, r = nwg % NXCD, xcd = wgid % NXCD, off = wgid / NXCD; wgid = (xcd < r ? xcd * (q + 1) : r * (q + 1) + (xcd - r) * q) + off; }
    const int nig = WGM * nN, gid = wgid / nig, fm = gid * WGM, gsz = (nM - fm) < WGM ? (nM - fm) : WGM;
    pm = fm + ((wgid % nig) % gsz); pn = (wgid % nig) / gsz; return true;
}

template <class Epi, class Sched, bool ALIGN_EPI, bool GATHER = false>
__device__ __forceinline__ void gemm_phase(LAS unsigned char* lds, const Gemm g, const Sched& S, const Epi& E, const char* Abase = nullptr, const LAS int* rm = nullptr) {
    int tid_ = threadIdx.x; asm volatile("" : "+v"(tid_));
    const int tid = tid_, wid = __builtin_amdgcn_readfirstlane(tid >> 6), lane = tid & 63, wr = wid >> 2, wc = wid & 3, fr = lane & 15, fq = lane >> 4;
    unsigned voffA[2], voffB[2];
#pragma unroll
    for (int i = 0; i < 2; ++i) { int R, C; stage_rc(tid * 16 + i * 8192, R, C); const int Rb = (R & ~31) + perm32(R & 31);
        voffA[i] = (unsigned)(R * g.lda + C * 2); voffB[i] = (unsigned)(Rb * g.ldb + C * 2); }
    const size_t kstep = (size_t)(BK * 2);
    const size_t hsA = (size_t)HALF * g.lda, hsB = (size_t)HALF * g.ldb;
    int rIdx[2], cOff[2];
#pragma unroll
    for (int i = 0; i < 2; ++i) { int R, C; stage_rc(tid * 16 + i * 8192, R, C); rIdx[i] = R; cOff[i] = C * 2; }
    unsigned vgc[2][2], vgn[2][2];
    auto load_vg = [&](unsigned (&v)[2][2], int unit_i) {
#pragma unroll
        for (int h = 0; h < 2; ++h)
#pragma unroll
            for (int i = 0; i < 2; ++i) v[h][i] = (unsigned)rm[unit_i * 256 + h * 128 + rIdx[i]] * (unsigned)g.lda + (unsigned)cOff[i]; };
    const unsigned ldsw = (unsigned)wid * 1024u;
    const int aoff = lds_byte(wr * 64 + fr, fq * 8), boff = lds_byte(wc * 32 + fr, fq * 8);
#define PG8_SA(b, h) (((b) * 2 + (h)) * HTB)
#define PG8_SB(b, h) ((4 + (b) * 2 + (h)) * HTB)
#define PG8_STAGE(bufoff, gbase, voff) do { _Pragma("unroll") for (int _i = 0; _i < 2; ++_i) \
        __builtin_amdgcn_global_load_lds((const unsigned*)((const char*)(gbase) + (voff)[_i]), (LAS unsigned*)(lds + (bufoff) + ldsw + _i * 8192), 16, 0, 0); } while (0)
#define PG8_STAGE_A(bufoff, gptr, kt, h, nx) do { if constexpr (GATHER) { _Pragma("unroll") for (int _i = 0; _i < 2; ++_i) \
        __builtin_amdgcn_global_load_lds((const unsigned*)(Abase + (size_t)(kt) * kstep + ((nx) ? vgn[h][_i] : vgc[h][_i])), (LAS unsigned*)(lds + (bufoff) + ldsw + _i * 8192), 16, 0, 0); } \
        else { PG8_STAGE(bufoff, gptr, voffA); } } while (0)
#define PG8_LDA(dst, b, h) do { _Pragma("unroll") for (int m = 0; m < 4; ++m) _Pragma("unroll") for (int k = 0; k < 2; ++k) dst[m][k] = *(const LAS bf16x8*)(lds + PG8_SA(b, h) + aoff + m * 2048 + k * 1024); } while (0)
#define PG8_LDB(dst, b, h) do { _Pragma("unroll") for (int n = 0; n < 2; ++n) _Pragma("unroll") for (int k = 0; k < 2; ++k) dst[n][k] = *(const LAS bf16x8*)(lds + PG8_SB(b, h) + boff + n * 2048 + k * 1024); } while (0)
#define PG8_MMA(ai, bj, At, Bt) do { __builtin_amdgcn_s_setprio(1); _Pragma("unroll") for (int m = 0; m < 4; ++m) _Pragma("unroll") for (int n = 0; n < 2; ++n) _Pragma("unroll") for (int k = 0; k < 2; ++k) \
        acc[ai][bj][m][n] = __builtin_amdgcn_mfma_f32_16x16x32_bf16(Bt[n][k], At[m][k], acc[ai][bj][m][n], 0, 0, 0); __builtin_amdgcn_s_setprio(0); } while (0)
#define PG8_WAIT_V(n) asm volatile("s_waitcnt vmcnt(" #n ")" ::: "memory")
#define PG8_WAIT_L(n) asm volatile("s_waitcnt lgkmcnt(" #n ")" ::: "memory")
#define PG8_BAR __builtin_amdgcn_s_barrier()
#define PG8_SCHED __builtin_amdgcn_sched_barrier(0)
    Unit cur, nxt; int ui = 0;
    if (!S.next(0, cur)) return;
    f32x4 acc[2][2][4][2];
#pragma unroll
    for (int a = 0; a < 2; ++a)
#pragma unroll
        for (int b = 0; b < 2; ++b)
#pragma unroll
            for (int m = 0; m < 4; ++m)
#pragma unroll
                for (int n = 0; n < 2; ++n) acc[a][b][m][n] = (f32x4){0.f, 0.f, 0.f, 0.f};
    bf16x8 At[4][2], B0[2][2], B1[2][2];
    const char* cA = cur.A; const char* cB = cur.B;
    if constexpr (GATHER) load_vg(vgc, 0);
    PG8_STAGE(PG8_SB(0, 0), cB, voffB); PG8_STAGE(PG8_SB(0, 1), cB + hsB, voffB); PG8_STAGE_A(PG8_SA(0, 0), cA, 0, 0, false); PG8_STAGE_A(PG8_SA(0, 1), cA + hsA, 0, 1, false);
    if (wr == 1) PG8_BAR;
    PG8_WAIT_V(2); PG8_BAR;
    PG8_STAGE(PG8_SB(1, 0), cB + kstep, voffB); PG8_STAGE_A(PG8_SA(1, 0), cA + kstep, 1, 0, false); PG8_STAGE(PG8_SB(1, 1), cB + hsB + kstep, voffB);
    PG8_WAIT_V(6); PG8_BAR;
    for (;;) {
        const bool has_next = S.next(ui + 1, nxt);
        const int nt = cur.nt;
        if constexpr (GATHER) { if (has_next) load_vg(vgn, ui + 1); else { vgn[0][0] = vgc[0][0]; vgn[0][1] = vgc[0][1]; vgn[1][0] = vgc[1][0]; vgn[1][1] = vgc[1][1]; } }
        const char* nA = has_next ? nxt.A : cA; const char* nB = has_next ? nxt.B : cB;
        for (int t = 0; t < nt; t += 2) {
            const bool last = (t == nt - 2);
            const char* a1 = cA + (size_t)(t + 1) * kstep;
            const char* a2 = last ? nA : cA + (size_t)(t + 2) * kstep; const char* b2 = last ? nB : cB + (size_t)(t + 2) * kstep;
            const char* a3 = a2 + kstep; const char* b3 = b2 + kstep;
            PG8_LDB(B0, 0, 0); PG8_LDB(B1, 0, 1); PG8_SCHED; PG8_LDA(At, 0, 0); PG8_STAGE_A(PG8_SA(1, 1), a1 + hsA, t + 1, 1, false);
            PG8_WAIT_V(8); PG8_WAIT_L(0); PG8_BAR; PG8_MMA(0, 0, At, B0); PG8_MMA(0, 1, At, B1); PG8_BAR; PG8_SCHED;
            PG8_LDA(At, 0, 1); PG8_STAGE(PG8_SB(0, 0), b2, voffB); PG8_STAGE(PG8_SB(0, 1), b2 + hsB, voffB); PG8_STAGE_A(PG8_SA(0, 0), a2, (last ? 0 : t + 2), 0, last);
            PG8_WAIT_V(8); PG8_WAIT_L(0); PG8_BAR; PG8_MMA(1, 0, At, B0); PG8_MMA(1, 1, At, B1); PG8_BAR; PG8_SCHED;
            PG8_LDB(B0, 1, 0); PG8_LDB(B1, 1, 1); PG8_SCHED; PG8_LDA(At, 1, 0); PG8_STAGE_A(PG8_SA(0, 1), a2 + hsA, (last ? 0 : t + 2), 1, last);
            PG8_WAIT_V(8); PG8_WAIT_L(0); PG8_BAR; PG8_MMA(0, 0, At, B0); PG8_MMA(0, 1, At, B1); PG8_BAR; PG8_SCHED;
            PG8_LDA(At, 1, 1); PG8_STAGE(PG8_SB(1, 0), b3, voffB); PG8_STAGE(PG8_SB(1, 1), b3 + hsB, voffB); PG8_STAGE_A(PG8_SA(1, 0), a3, (last ? 1 : t + 3), 0, last);
            PG8_WAIT_V(8); PG8_WAIT_L(0); PG8_BAR; PG8_MMA(1, 0, At, B0); PG8_MMA(1, 1, At, B1); PG8_BAR; PG8_SCHED;
        }
        if constexpr (ALIGN_EPI) { if (wr == 0) PG8_BAR; }
        E(acc, cur, wr, wc, fr, fq);
        if (!has_next) break;
#pragma unroll
        for (int a = 0; a < 2; ++a)
#pragma unroll
            for (int b = 0; b < 2; ++b)
#pragma unroll
                for (int m = 0; m < 4; ++m)
#pragma unroll
                    for (int n = 0; n < 2; ++n) acc[a][b][m][n] = (f32x4){0.f, 0.f, 0.f, 0.f};
        cur = nxt; cA = nA; cB = nB; ++ui;
        if constexpr (GATHER) { vgc[0][0] = vgn[0][0]; vgc[0][1] = vgn[0][1]; vgc[1][0] = vgn[1][0]; vgc[1][1] = vgn[1][1]; }
        if constexpr (ALIGN_EPI) { if (wr == 1) PG8_BAR; }
    }
    PG8_WAIT_V(0);
    if constexpr (!ALIGN_EPI) { if (wr == 0) PG8_BAR; }
    PG8_BAR;
#undef PG8_SA
#undef PG8_SB
#undef PG8_STAGE
#undef PG8_STAGE_A
#undef PG8_LDA
#undef PG8_LDB
#undef PG8_MMA
#undef PG8_WAIT_V
#undef PG8_WAIT_L
#undef PG8_BAR
#undef PG8_SCHED
}
}

struct Args {
    const float* in[26];
    float* out; unsigned char* ws;
    int ph_lo, ph_hi;
};
struct Frame {
    LAS unsigned char* lds;
    unsigned char* ws; float* out;
    int tid, lane, wave, vcu, G, bx;
};
__device__ __forceinline__ const float* inptr(int i) {
    const __attribute__((address_space(4))) unsigned char* kp = (const __attribute__((address_space(4))) unsigned char*)__builtin_amdgcn_kernarg_segment_ptr();
    asm volatile("" : "+s"(kp));
    return *(const float* const __attribute__((address_space(4)))*)(kp + 8 * i);
}
__device__ __forceinline__ Frame launder(const Frame& F) {
    Frame P = F; int t = F.tid; unsigned char* w = F.ws; float* o = F.out; int g = F.G, v = F.vcu, wv = F.wave, bx = F.bx;
    asm volatile("" : "+v"(t), "+s"(w), "+s"(o), "+s"(g), "+s"(v), "+s"(wv), "+s"(bx));
    P.tid = t; P.lane = t & 63; P.ws = w; P.out = o; P.G = g; P.vcu = v; P.wave = wv; P.bx = bx; return P;
}
enum { I_X = 0, I_C, I_CTX, I_CCTX, I_WMOD, I_BMOD, I_GMIX, I_GFFN, I_WIN, I_POOLW, I_POOLS, I_DLAM, I_DNG, I_RPB, I_QN, I_KN, I_WBR, I_WOUT, I_WRG, I_BRG, I_WRE, I_BRE, I_WEG, I_WEU, I_WED, I_GFIN };
#define WSF(off) ((float*)(F.ws + (off)))
#define WSB(off) ((bf16_t*)(F.ws + (off)))
#define WSU(off) ((unsigned*)(F.ws + (off)))

template <class RowMap>
__device__ __forceinline__ void transpose_item(const float* W, int K, int N, bf16_t* WT, int ldt, LAS float* scr, int item, int lane, const RowMap& rm) {
    const int nblk = N / 32, kb = item / nblk, nb = item % nblk, k0 = 64 * kb, n0 = 32 * nb;
#pragma unroll 8
    for (int i = 0; i < 32; ++i) { const int kk = 2 * i + (lane >> 5); scr[kk * 33 + (lane & 31)] = __builtin_nontemporal_load(W + (size_t)(k0 + kk) * N + n0 + (lane & 31)); }
    asm volatile("s_waitcnt lgkmcnt(0)" ::: "memory");
    const int c = lane & 7;
#pragma unroll
    for (int j = 0; j < 4; ++j) { const int n = (lane >> 3) + 8 * j; const LAS float* s = scr + (8 * c) * 33 + n;
        u32x4 o; o.x = pk2(s[0 * 33], s[1 * 33]); o.y = pk2(s[2 * 33], s[3 * 33]); o.z = pk2(s[4 * 33], s[5 * 33]); o.w = pk2(s[6 * 33], s[7 * 33]);
        *(u32x4*)(WT + (size_t)rm(n0 + n) * ldt + k0 + 8 * c) = o; }
    asm volatile("s_waitcnt lgkmcnt(0)" ::: "memory");
}
struct RowId { __device__ __forceinline__ int operator()(int n) const { return n; } };
struct RowGU { int up; __device__ __forceinline__ int operator()(int n) const { return 256 * (n >> 7) + 128 * up + (n & 127); } };

__device__ __forceinline__ void p0_prologue(Frame& F, int part) {
    LAS float* scr = (LAS float*)(F.lds + F.wave * 16384);
    const int gw = F.vcu * 8 + F.wave, NGW = F.G * 8;
    const float *w_in = inptr(I_WIN), *w_out = inptr(I_WOUT), *w_branch = inptr(I_WBR), *pool_w = inptr(I_POOLW), *pool_scale = inptr(I_POOLS);
    bf16_t *WIN = WSB(WS_WIN), *WOUT = WSB(WS_WOUT), *WBR = WSB(WS_WBR); float* MOD = WSF(WS_MOD);
    if (part == 1) {
    constexpr int I_IN = 16 * 200, I_OUT = 16 * 32, I_BR = 4 * 32;
    constexpr int PER_L = I_IN + I_OUT + 3 * I_BR, NITEMS = 2 * PER_L;
    for (int it = gw; it < NITEMS; it += NGW) {
        const int l = it / PER_L; int r = it % PER_L;
        if (r < I_IN) { transpose_item(w_in + (size_t)l * D * NIN, D, NIN, WIN + (size_t)l * NIN * D, D, scr, r, F.lane, RowId{}); continue; } r -= I_IN;
        if (r < I_OUT) { transpose_item(w_out + (size_t)l * D * D, D, D, WOUT + (size_t)l * D * D, D, scr, r, F.lane, RowId{}); continue; } r -= I_OUT;
        const int br = 1 + r / I_BR; r %= I_BR;
        transpose_item(w_branch + ((size_t)l * 4 + br) * 256 * D, 256, D, WBR + ((size_t)l * 4 + br) * D * D, D, scr, r, F.lane, RowId{});
    }
    for (int it = gw; it < 2 * 4 * 16 * 8; it += NGW) {
        const int l = it >> 9, g = (it >> 7) & 3, n = ((it >> 3) & 15) * 64 + F.lane, c8 = it & 7;
        const float* pw = pool_w + (size_t)(l * 4 + g) * 4096 + c8 * 8 * 64;
        const float* ps = pool_scale + l * 256 + 64 * g;
        const float* wb = w_branch + ((size_t)(l * 4 + 0) * 256 + 64 * g) * D + n;
        float o[8];
#pragma unroll
        for (int cc = 0; cc < 8; ++cc) o[cc] = 0.f;
#pragma unroll 4
        for (int cp = 0; cp < 64; ++cp) { const float w = ps[cp] * wb[(size_t)cp * D];
#pragma unroll
            for (int cc = 0; cc < 8; ++cc) o[cc] += pw[cc * 64 + cp] * w; }
        u32x4 w; w.x = pk2(o[0], o[1]); w.y = pk2(o[2], o[3]); w.z = pk2(o[4], o[5]); w.w = pk2(o[6], o[7]);
        *(u32x4*)(WBR + ((size_t)l * 4 + 0) * D * D + (size_t)n * D + 64 * g + c8 * 8) = w;
    }
    return; }
    if (F.vcu < 192) {
        const float *cvec = inptr(I_C), *c_ctx = inptr(I_CCTX), *w_mod = inptr(I_WMOD), *b_mod = inptr(I_BMOD);
        __syncthreads();
        LAS float* sv = (LAS float*)(F.lds);
        LAS float* part = (LAS float*)(F.lds + 65536);
        for (int i = F.tid; i < 9 * 1024; i += 512) { const int bb = i >> 10, k = i & 1023; const float v = bb < 8 ? cvec[bb * 1024 + k] : c_ctx[k]; sv[i] = v / (1.0f + __expf(-v)); }
        __syncthreads();
        const int l = F.vcu / 96, j = (F.vcu % 96) * 64 + F.lane;
        float acc[9];
#pragma unroll
        for (int bb = 0; bb < 9; ++bb) acc[bb] = 0.f;
        const float* wm = w_mod + (size_t)l * D * 6144 + j;
        for (int k0 = F.wave * 128; k0 < F.wave * 128 + 128; k0 += 16) { float w[16];
#pragma unroll
            for (int u = 0; u < 16; ++u) w[u] = __builtin_nontemporal_load(wm + (size_t)(k0 + u) * 6144);
#pragma unroll
            for (int u = 0; u < 16; ++u)
#pragma unroll
                for (int bb = 0; bb < 9; ++bb) acc[bb] += sv[bb * 1024 + k0 + u] * w[u]; }
#pragma unroll
        for (int bb = 0; bb < 9; ++bb) part[(F.wave * 9 + bb) * 64 + F.lane] = acc[bb];
        __syncthreads();
        for (int i = F.tid; i < 9 * 64; i += 512) { const int bb = i >> 6, jj = i & 63; float s = 0.f;
#pragma unroll
            for (int w = 0; w < 8; ++w) s += part[(w * 9 + bb) * 64 + jj];
            const int col = (F.vcu % 96) * 64 + jj;
            MOD[((size_t)l * 9 + bb) * 6144 + col] = s + b_mod[l * 6144 + col]; }
        __syncthreads();
    }
    if (F.vcu == 200 && F.tid < 2) {
        const float* diff_lambda = inptr(I_DLAM);
        const int l = F.tid; const float* lf = diff_lambda + l * 128; float s0 = 0.f, s1 = 0.f;
        for (int i = 0; i < 32; ++i) { s0 += lf[i] * lf[32 + i]; s1 += lf[64 + i] * lf[96 + i]; }
        const float lam_init = 0.8f - 0.6f * expf(-0.3f * (float)l);
        MOD[131072 + l] = expf(s0) - expf(s1) + lam_init;
    }
}

__device__ __forceinline__ void phase_modulate(Frame& F, int l, int part) {
    const int gw = F.vcu * 8 + F.wave, NGW = F.G * 8;
    const float *xin = inptr(I_X), *ctxin = inptr(I_CTX), *g_mix = inptr(I_GMIX), *g_final = inptr(I_GFIN);
    float *MOD = WSF(WS_MOD), *XCTX = WSF(WS_XCTX); unsigned* ROUTE = WSU(WS_ROUTE); bf16_t *Y = WSB(WS_Y), *PROJ = WSB(WS_PROJ);
    const bool comb = (l > 0) && (part != 2);
    for (int row0 = gw; row0 < T; row0 += 2 * NGW) {
        f32x4 v[2][4]; bool ok[2]; float* xr[2]; u32x2 pp[2]; u32x2 ya[2][4], yb[2][4];
#pragma unroll
        for (int q = 0; q < 2; ++q) {
            const int row = row0 + q * NGW; ok[q] = row < T; xr[q] = nullptr; pp[q] = (u32x2){0u, 0u};
            if (ok[q]) { const int b = row / TPB, t = row % TPB; const bool isctx = t >= SEQ;
                if (isctx && l == 2) { ok[q] = false; }
                else {
                    const float* src0 = (l == 0) ? (isctx ? ctxin + ((size_t)b * CTXL + (t - SEQ)) * D : xin + ((size_t)b * SEQ + t) * D)
                                                 : (isctx ? XCTX + ((size_t)b * CTXL + (t - SEQ)) * D : F.out + ((size_t)b * SEQ + t) * D);
                    xr[q] = const_cast<float*>(src0);
                    const f32x4* src = (const f32x4*)src0 + F.lane;
#pragma unroll
                    for (int j = 0; j < 4; ++j) v[q][j] = src[64 * j];
                    if (comb) pp[q] = *(const u32x2*)(ROUTE + (size_t)row * 8 + 6);
                } }
        }
        if (comb) {
#pragma unroll
            for (int q = 0; q < 2; ++q) if (ok[q]) {
                const u32x2* y0 = (const u32x2*)(Y + (size_t)pp[q].x * D) + F.lane; const u32x2* y1 = (const u32x2*)(Y + (size_t)pp[q].y * D) + F.lane;
#pragma unroll
                for (int j = 0; j < 4; ++j) { ya[q][j] = y0[64 * j]; yb[q][j] = y1[64 * j]; } }
        }
#pragma unroll
        for (int q = 0; q < 2; ++q) if (ok[q]) {
            const int row = row0 + q * NGW; const int b = row / TPB, t = row % TPB; const bool isctx = t >= SEQ; const int mb = isctx ? 8 : b;
            if (comb) {
                const f32x4* gt = (const f32x4*)(MOD + ((size_t)(l - 1) * 9 + mb) * 6144 + 5 * 1024) + F.lane;
#pragma unroll
                for (int j = 0; j < 4; ++j) { const u32x2 a = ya[q][j], c2 = yb[q][j]; const f32x4 g = gt[64 * j];
                    v[q][j].x += g.x * (bflo(a.x) + bflo(c2.x)); v[q][j].y += g.y * (bfhi(a.x) + bfhi(c2.x)); v[q][j].z += g.z * (bflo(a.y) + bflo(c2.y)); v[q][j].w += g.w * (bfhi(a.y) + bfhi(c2.y)); }
                if (l < 2) { f32x4* dst = (f32x4*)xr[q] + F.lane;
#pragma unroll
                    for (int j = 0; j < 4; ++j) dst[64 * j] = v[q][j]; }
            }
            if (part == 1) continue;
            float ss = 0.f;
#pragma unroll
            for (int j = 0; j < 4; ++j) ss += (v[q][j].x * v[q][j].x + v[q][j].y * v[q][j].y) + (v[q][j].z * v[q][j].z + v[q][j].w * v[q][j].w);
            const float r = rsqrtf(wave_sum(ss) * (1.0f / D) + RMS_EPS);
            if (l == 2) {
                f32x4* dst = (f32x4*)(F.out + ((size_t)b * SEQ + t) * D) + F.lane; const f32x4* g = (const f32x4*)g_final + F.lane;
#pragma unroll
                for (int j = 0; j < 4; ++j) dst[64 * j] = v[q][j] * r * g[64 * j];
            } else {
                const f32x4* g = (const f32x4*)(g_mix + l * D) + F.lane;
                const f32x4* sh = (const f32x4*)(MOD + ((size_t)l * 9 + mb) * 6144) + F.lane; const f32x4* sc = sh + 256;
                u32x2* dst = (u32x2*)(PROJ + (size_t)row * LDP + C_H) + F.lane;
#pragma unroll
                for (int j = 0; j < 4; ++j) { const f32x4 o = (v[q][j] * r * g[64 * j]) * (sc[64 * j] + 1.0f) + sh[64 * j]; u32x2 w; w.x = pk2(o.x, o.y); w.y = pk2(o.z, o.w); dst[64 * j] = w; }
            }
        }
    }
}

struct SchedIn {
    int G, c; const char* A; const char* B;
    __device__ __forceinline__ bool next(int i, pg8::Unit& u) const {
        int pm, pn; if (!pg8::tile_order(T / 256, 9, G, c, i, pm, pn)) return false;
        u.pm = pm; u.pn = pn; u.aux = 0; u.nt = D / 64; u.A = A + (size_t)pm * 256 * (LDP * 2); u.B = B + (size_t)pn * 256 * (D * 2); return true; }
};
struct EpiIn {
    bf16_t* PROJ;
    __device__ __forceinline__ void operator()(const f32x4 (&acc)[2][2][4][2], const pg8::Unit& u, int wr, int wc, int fr, int fq) const {
        const int row0 = u.pm * 256 + wr * 64 + fr;
        bf16_t* base = PROJ + (size_t)u.pn * 256 + wc * 32 + 8 * fq;
#pragma unroll
        for (int ai = 0; ai < 2; ++ai)
#pragma unroll
            for (int m = 0; m < 4; ++m) { bf16_t* rowp = base + (size_t)(row0 + ai * 128 + m * 16) * LDP;
#pragma unroll
                for (int bj = 0; bj < 2; ++bj) { const f32x4 v0 = acc[ai][bj][m][0], v1 = acc[ai][bj][m][1];
                    u32x4 w; w.x = cvt_pk_bf16(v0.x, v0.y); w.y = cvt_pk_bf16(v0.z, v0.w); w.z = cvt_pk_bf16(v1.x, v1.y); w.w = cvt_pk_bf16(v1.z, v1.w);
                    *(u32x4*)(rowp + bj * 128) = w; } }
    }
};
__device__ __forceinline__ int branch_col(int br) { return br == 0 ? C_POOL : (br == 1 ? C_DQ : (br == 2 ? C_NQ : C_GQ)); }
struct SchedMerge {
    int G, c, nM, skip, split; const char* PROJ; const char* WG; const char* WBR;
    __device__ __forceinline__ bool next(int i, pg8::Unit& u) const {
        int pm, pn, sub, aux;
        if (split && c < 128 && i < 2) { const int ct = c >> 2, br = c & 3; pm = (ct >> 2) * 17 + 16; pn = ct & 3; sub = 2 * br + i; aux = sub | 8; }
        else { const int ii = (split && c < 128) ? i - 2 : i;
            if (!pg8::tile_order(nM, 4, G, c, ii >> 3, pm, pn)) return false;
            if (skip) pm += pm >> 4;
            sub = ii & 7; aux = sub; }
        const int br = sub >> 1; u.pm = pm; u.pn = pn; u.aux = aux;
        if ((sub & 1) == 0) { u.nt = D / 64; u.A = PROJ + ((size_t)pm * 256 * LDP + C_H) * 2; u.B = WG + ((size_t)br * 1024 + (size_t)pn * 256) * (D * 2); }
        else { u.nt = 4; u.A = PROJ + ((size_t)pm * 256 * LDP + branch_col(br)) * 2; u.B = WBR + ((size_t)br * 1024 + (size_t)pn * 256) * (D * 2); }
        return true; }
};
struct EpiMerge {
    bf16_t* MERGED; bf16_t* SCR; bf16_t* SLAB;
    __device__ __forceinline__ void operator()(const f32x4 (&acc)[2][2][4][2], const pg8::Unit& u, int wr, int wc, int fr, int fq) const {
        const int sub = u.aux & 7, br = sub >> 1; const bool sjob = (u.aux & 8) != 0;
        int fr_ = fr, fq_ = fq; asm volatile("" : "+v"(fr_), "+v"(fq_));
        const int r0 = wr * 64 + fr_, c0 = wc * 32 + 8 * fq_;
        const int row0 = u.pm * 256 + r0, col0 = u.pn * 256 + c0;
        if ((sub & 1) == 0) {
#pragma unroll
            for (int ai = 0; ai < 2; ++ai)
#pragma unroll
                for (int m = 0; m < 4; ++m) { const int rl = r0 + ai * 128 + m * 16;
#pragma unroll
                    for (int bj = 0; bj < 2; ++bj) {
                        f32x4 v0 = acc[ai][bj][m][0], v1 = acc[ai][bj][m][1];
                        v0.x = sigmoidf_(v0.x); v0.y = sigmoidf_(v0.y); v0.z = sigmoidf_(v0.z); v0.w = sigmoidf_(v0.w); v1.x = sigmoidf_(v1.x); v1.y = sigmoidf_(v1.y); v1.z = sigmoidf_(v1.z); v1.w = sigmoidf_(v1.w);
                        u32x4 w; w.x = cvt_pk_bf16(v0.x, v0.y); w.y = cvt_pk_bf16(v0.z, v0.w); w.z = cvt_pk_bf16(v1.x, v1.y); w.w = cvt_pk_bf16(v1.z, v1.w);
                        *(u32x4*)(SCR + (size_t)rl * 256 + c0 + bj * 128) = w; } }
        } else {
            const bool rd = (br > 0) && !sjob;
#pragma unroll
            for (int ai = 0; ai < 2; ++ai) {
                u32x4 gq[4][2], oq[4][2];
#pragma unroll
                for (int m = 0; m < 4; ++m) { const int rl = r0 + ai * 128 + m * 16;
#pragma unroll
                    for (int bj = 0; bj < 2; ++bj) {
                        gq[m][bj] = *(const u32x4*)(SCR + (size_t)rl * 256 + c0 + bj * 128);
                        const u32x4* sp = sjob ? (const u32x4*)(SLAB + ((size_t)br * 2048 + (size_t)(u.pm / 17) * 256 + rl) * D + col0 + bj * 128)
                                               : (const u32x4*)(MERGED + (size_t)(row0 + ai * 128 + m * 16) * D + col0 + bj * 128);
                        oq[m][bj] = rd ? *sp : (u32x4){0u, 0u, 0u, 0u}; } }
#pragma unroll
                for (int m = 0; m < 4; ++m) { const int rl = r0 + ai * 128 + m * 16;
#pragma unroll
                    for (int bj = 0; bj < 2; ++bj) {
                        f32x4 v0 = acc[ai][bj][m][0], v1 = acc[ai][bj][m][1]; const u32x4 g4 = gq[m][bj], o = oq[m][bj];
                        v0.x = v0.x * bflo(g4.x) + bflo(o.x); v0.y = v0.y * bfhi(g4.x) + bfhi(o.x); v0.z = v0.z * bflo(g4.y) + bflo(o.y); v0.w = v0.w * bfhi(g4.y) + bfhi(o.y);
                        v1.x = v1.x * bflo(g4.z) + bflo(o.z); v1.y = v1.y * bfhi(g4.z) + bfhi(o.z); v1.z = v1.z * bflo(g4.w) + bflo(o.w); v1.w = v1.w * bfhi(g4.w) + bfhi(o.w);
                        u32x4 w; w.x = cvt_pk_bf16(v0.x, v0.y); w.y = cvt_pk_bf16(v0.z, v0.w); w.z = cvt_pk_bf16(v1.x, v1.y); w.w = cvt_pk_bf16(v1.z, v1.w);
                        u32x4* sp = sjob ? (u32x4*)(SLAB + ((size_t)br * 2048 + (size_t)(u.pm / 17) * 256 + rl) * D + col0 + bj * 128)
                                         : (u32x4*)(MERGED + (size_t)(row0 + ai * 128 + m * 16) * D + col0 + bj * 128);
                        *sp = w; } }
            }
        }
    }
};
struct SchedOut {
    int G, c, nM, skip; const char* A; const char* B; const char* PRIV;
    __device__ __forceinline__ bool next(int i, pg8::Unit& u) const {
        int pm, pn;
        if (PRIV != nullptr) {
            if (c < 32) { if (i == 0) { pm = (c >> 2) * 17 + 16; pn = c & 3; } else if (i == 1) { if (!pg8::tile_order(128, 4, G, c, 0, pm, pn)) return false; pm += pm >> 4; } else return false; }
            else if (c < 64 && i == 2) { if (!pg8::tile_order(128, 4, G, c - 32, 1, pm, pn)) return false; pm += pm >> 4; }
            else { if (i >= 2 || !pg8::tile_order(128, 4, G, c, i, pm, pn)) return false; pm += pm >> 4; }
        } else { if (!pg8::tile_order(nM, 4, G, c, i, pm, pn)) return false; if (skip) pm += pm >> 4; }
        u.pm = pm; u.pn = pn; u.aux = 0; u.nt = D / 64; u.B = B + (size_t)pn * 256 * (D * 2);
        u.A = (PRIV != nullptr && pm % 17 == 16) ? PRIV + (size_t)((pm / 17) * 4 + pn) * (256 * D * 2) : A + (size_t)pm * 256 * (D * 2);
        return true; }
};
__device__ __forceinline__ void sum_ctx_slabs(Frame& F, const SchedOut& S) {
    const bf16_t* SLAB = WSB(WS_SLAB); bf16_t* PRIV = WSB(WS_PRIV);
    for (int i = 0; i < 4; ++i) { pg8::Unit u; if (!S.next(i, u)) break;
        if (u.pm % 17 != 16) continue;
        const int b = u.pm / 17; bf16_t* dst = PRIV + (size_t)(b * 4 + u.pn) * 256 * D;
        for (int ch0 = F.tid; ch0 < 256 * 128; ch0 += 8 * 512) {
            u32x4 w[8][4];
#pragma unroll
            for (int q = 0; q < 8; ++q) { const int ch = ch0 + q * 512, r = ch >> 7, c8 = (ch & 127) * 8;
#pragma unroll
                for (int br = 0; br < 4; ++br) w[q][br] = *(const u32x4*)(SLAB + ((size_t)br * 2048 + (size_t)b * 256 + r) * D + c8); }
#pragma unroll
            for (int q = 0; q < 8; ++q) { const int ch = ch0 + q * 512, r = ch >> 7, c8 = (ch & 127) * 8; float s[8];
#pragma unroll
                for (int e = 0; e < 8; ++e) s[e] = 0.f;
#pragma unroll
                for (int br = 0; br < 4; ++br) { const u32x4 x = w[q][br];
                    s[0] += bflo(x.x); s[1] += bfhi(x.x); s[2] += bflo(x.y); s[3] += bfhi(x.y); s[4] += bflo(x.z); s[5] += bfhi(x.z); s[6] += bflo(x.w); s[7] += bfhi(x.w); }
                u32x4 o; o.x = pk2(s[0], s[1]); o.y = pk2(s[2], s[3]); o.z = pk2(s[4], s[5]); o.w = pk2(s[6], s[7]);
                *(u32x4*)(dst + (size_t)r * D + c8) = o; } } }
    asm volatile("s_waitcnt vmcnt(0)" ::: "memory");
    __syncthreads();
}
struct EpiOut {
    const float* xlat_src; const float* xctx_src; float* out; float* XCTX; const float* MODL;
    __device__ __forceinline__ void operator()(const f32x4 (&acc)[2][2][4][2], const pg8::Unit& u, int wr, int wc, int fr, int fq) const {
        const int b = u.pm / 17, j = u.pm % 17; const bool isctx = j == 16;
        const size_t rbase = isctx ? (size_t)b * CTXL : (size_t)b * SEQ + j * 256;
        const float* src = isctx ? xctx_src : xlat_src; float* dst = isctx ? XCTX : out;
        const float* gt = MODL + (size_t)(isctx ? 8 : b) * 6144 + 2 * 1024;
        const int r0 = wr * 64 + fr, col0 = u.pn * 256 + wc * 32 + 8 * fq;
        f32x4 g[2][2];
#pragma unroll
        for (int bj = 0; bj < 2; ++bj) { g[bj][0] = *(const f32x4*)(gt + col0 + bj * 128); g[bj][1] = *(const f32x4*)(gt + col0 + bj * 128 + 4); }
#pragma unroll
        for (int ai = 0; ai < 2; ++ai) {
            f32x4 xs[4][2][2];
#pragma unroll
            for (int m = 0; m < 4; ++m) { const size_t off = (rbase + r0 + ai * 128 + m * 16) * D + col0;
#pragma unroll
                for (int bj = 0; bj < 2; ++bj) { xs[m][bj][0] = *(const f32x4*)(src + off + bj * 128); xs[m][bj][1] = *(const f32x4*)(src + off + bj * 128 + 4); } }
#pragma unroll
            for (int m = 0; m < 4; ++m) { const size_t off = (rbase + r0 + ai * 128 + m * 16) * D + col0;
#pragma unroll
                for (int bj = 0; bj < 2; ++bj) {
                    *(f32x4*)(dst + off + bj * 128) = xs[m][bj][0] + g[bj][0] * acc[ai][bj][m][0];
                    *(f32x4*)(dst + off + bj * 128 + 4) = xs[m][bj][1] + g[bj][1] * acc[ai][bj][m][1]; } }
        }
    }
};
template <int KD>
struct SchedMoe {
    int G, c, ntiles; const LAS int* tile_e; const char* A; const char* B;
    __device__ __forceinline__ bool next(int i, pg8::Unit& u) const {
        const int L = i * G + c; if (L >= ntiles * 4) return false;
        const int k = L >> 2, j = L & 3, e = __builtin_amdgcn_readfirstlane(tile_e[k]);
        u.pm = k; u.pn = j; u.aux = e; u.nt = KD / 64; u.A = A + (size_t)k * (256 * KD * 2); u.B = B + ((size_t)e * 1024 + (size_t)j * 256) * (KD * 2); return true; }
};
struct EpiGU {
    bf16_t* HMID;
    __device__ __forceinline__ void operator()(const f32x4 (&acc)[2][2][4][2], const pg8::Unit& u, int wr, int wc, int fr, int fq) const {
        const int row0 = u.pm * 256 + wr * 64 + fr, col0 = u.pn * 128 + wc * 32 + 8 * fq;
#pragma unroll
        for (int ai = 0; ai < 2; ++ai)
#pragma unroll
            for (int m = 0; m < 4; ++m) {
                float h[8];
#pragma unroll
                for (int n = 0; n < 2; ++n)
#pragma unroll
                    for (int e = 0; e < 4; ++e) { const float gv = acc[ai][0][m][n][e], uv = acc[ai][1][m][n][e]; h[n * 4 + e] = gv * sigmoidf_(gv) * uv; }
                u32x4 w; w.x = cvt_pk_bf16(h[0], h[1]); w.y = cvt_pk_bf16(h[2], h[3]); w.z = cvt_pk_bf16(h[4], h[5]); w.w = cvt_pk_bf16(h[6], h[7]);
                *(u32x4*)(HMID + (size_t)(row0 + ai * 128 + m * 16) * DEXP + col0) = w; }
    }
};
struct EpiDown {
    bf16_t* Y; const float* ROWW;
    __device__ __forceinline__ void operator()(const f32x4 (&acc)[2][2][4][2], const pg8::Unit& u, int wr, int wc, int fr, int fq) const {
        const int row0 = u.pm * 256 + wr * 64 + fr, col0 = u.pn * 256 + wc * 32 + 8 * fq;
#pragma unroll
        for (int ai = 0; ai < 2; ++ai)
#pragma unroll
            for (int m = 0; m < 4; ++m) { const size_t row = (size_t)(row0 + ai * 128 + m * 16); const float w8 = ROWW[row];
#pragma unroll
                for (int bj = 0; bj < 2; ++bj) { const f32x4 v0 = acc[ai][bj][m][0] * w8, v1 = acc[ai][bj][m][1] * w8;
                    u32x4 w; w.x = cvt_pk_bf16(v0.x, v0.y); w.y = cvt_pk_bf16(v0.z, v0.w); w.z = cvt_pk_bf16(v1.x, v1.y); w.w = cvt_pk_bf16(v1.z, v1.w);
                    *(u32x4*)(Y + row * D + col0 + bj * 128) = w; } }
    }
};

constexpr int ROPE_T8 = 131072, ROPE_T16 = 131072 + 64 * 8 * 2 * 4;
template <int NF>
__device__ __forceinline__ void rope8(float (&v)[8], float (&o)[8], const LAS f32x2* tab, int pos, int i0, bool second) {
#pragma unroll
    for (int e = 0; e < 8; ++e) { const f32x2 cs = tab[pos * NF + i0 + e]; v[e] = second ? (o[e] * cs.y + v[e] * cs.x) : (v[e] * cs.x - o[e] * cs.y); }
}
__device__ __forceinline__ void phase_post(Frame& F, int l) {
    const int gw = F.vcu * 8 + F.wave, NGW = F.G * 8, lane = F.lane;
    const float *gqa_q_norm = inptr(I_QN), *gqa_k_norm = inptr(I_KN); bf16_t *PROJ = WSB(WS_PROJ), *VT = WSB(WS_VT);
    { LAS f32x2* t8 = (LAS f32x2*)(F.lds + ROPE_T8); LAS f32x2* t16 = (LAS f32x2*)(F.lds + ROPE_T16);
      for (int i = F.tid; i < 64 * 8; i += 512) { const int pos = i >> 3, f = i & 7; float sn, cs; sincosf((float)pos * exp2f(-(float)f * (13.287712379549449f / 8.0f)), &sn, &cs); t8[i] = (f32x2){cs, sn}; }
      for (int i = F.tid; i < 64 * 16; i += 512) { const int pos = i >> 4, f = i & 15; float sn, cs; sincosf((float)pos * exp2f(-(float)f * (13.287712379549449f / 16.0f)), &sn, &cs); t16[i] = (f32x2){cs, sn}; }
      __syncthreads(); }
    const LAS f32x2* t8 = (const LAS f32x2*)(F.lds + ROPE_T8); const LAS f32x2* t16 = (const LAS f32x2*)(F.lds + ROPE_T16);
    for (int row = gw; row < T; row += NGW) {
        const int b = row / TPB, t = row % TPB; const bool isctx = t >= SEQ; (void)b;
        bf16_t* pr = PROJ + (size_t)row * LDP;
        const int prow = t >> 6, pcol = t & 63;
        const bool gact = lane < 48; const int lc = gact ? lane : 0;
        const u32x4 wD = *(const u32x4*)(pr + C_DQ + lane * 8);
        const u32x4 wN = *(const u32x4*)(pr + C_NQ + (lane & 31) * 8);
        const u32x4 wG = *(const u32x4*)(pr + C_GQ + lc * 8);
        const int win = 2 << (lane >> 4), nseq = isctx ? CTXL : SEQ, ts = isctx ? t - SEQ : t;
        const int lo = max(ts - win / 2, 0), hi = min(ts + win / 2, nseq);
        const bf16_t* ub = PROJ + ((size_t)(row - ts)) * LDP + lane * 4;
        u32x2 wu[16];
#pragma unroll
        for (int i = 0; i < 16; ++i) { const int ii = ts - 8 + i; wu[i] = (ii >= lo && ii < hi) ? *(const u32x2*)(ub + (size_t)ii * LDP) : (u32x2){0u, 0u}; }
        const u32x2 wself = *(const u32x2*)(ub + (size_t)ts * LDP);
        {
            u32x4 w = wD;
            float v[8] = {bflo(w.x), bfhi(w.x), bflo(w.y), bfhi(w.y), bflo(w.z), bfhi(w.z), bflo(w.w), bfhi(w.w)};
            if (!isctx) {
                float o[8];
#pragma unroll
                for (int e = 0; e < 8; ++e) o[e] = swz_xor<1>(v[e]);
                rope8<8>(v, o, t8, (lane & 2) ? pcol : prow, 0, (lane & 1) != 0);
            }
            const float sc = lane < 32 ? 0.17677669529663687f * LOG2E : 1.0f;
#pragma unroll
            for (int e = 0; e < 8; ++e) v[e] *= sc;
            w.x = pk2(v[0], v[1]); w.y = pk2(v[2], v[3]); w.z = pk2(v[4], v[5]); w.w = pk2(v[6], v[7]);
            *(u32x4*)(pr + C_DQ + lane * 8) = w;
        }
        if (lane < 32) {
            u32x4 w = wN; const float sc = 0.125f * LOG2E;
            w.x = pk2(bflo(w.x) * sc, bfhi(w.x) * sc); w.y = pk2(bflo(w.y) * sc, bfhi(w.y) * sc); w.z = pk2(bflo(w.z) * sc, bfhi(w.z) * sc); w.w = pk2(bflo(w.w) * sc, bfhi(w.w) * sc);
            *(u32x4*)(pr + C_NQ + lane * 8) = w;
        }
        {
            u32x4 w = wG;
            float v[8] = {bflo(w.x), bfhi(w.x), bflo(w.y), bfhi(w.y), bflo(w.z), bfhi(w.z), bflo(w.w), bfhi(w.w)};
            float ss = 0.f;
#pragma unroll
            for (int e = 0; e < 8; ++e) ss += v[e] * v[e];
            ss = sum8(ss);
            const float r = rsqrtf(ss * (1.0f / 64.0f) + RMS_EPS);
            const float* gn = (lc < 32 ? gqa_q_norm : gqa_k_norm) + l * 64 + (lc & 7) * 8;
#pragma unroll
            for (int e = 0; e < 8; ++e) v[e] = v[e] * r * gn[e];
            float o[8];
#pragma unroll
            for (int e = 0; e < 8; ++e) o[e] = swz_xor<2>(v[e]);
            if (!isctx) rope8<16>(v, o, t16, (lc & 4) ? pcol : prow, (lc & 1) * 8, (lc & 2) != 0);
            const float sc = lc < 32 ? 0.125f * LOG2E : 1.0f;
#pragma unroll
            for (int e = 0; e < 8; ++e) v[e] *= sc;
            w.x = pk2(v[0], v[1]); w.y = pk2(v[2], v[3]); w.z = pk2(v[4], v[5]); w.w = pk2(v[6], v[7]);
            if (gact) *(u32x4*)(pr + C_GQ + lc * 8) = w;
        }
        {
            float s0 = 0.f, s1 = 0.f, s2 = 0.f, s3 = 0.f;
#pragma unroll
            for (int i = 0; i < 16; ++i) { s0 += bflo(wu[i].x); s1 += bfhi(wu[i].x); s2 += bflo(wu[i].y); s3 += bfhi(wu[i].y); }
            const float inv = 1.0f / (float)(hi - lo);
            u32x2 o; o.x = pk2(s0 * inv - bflo(wself.x), s1 * inv - bfhi(wself.x)); o.y = pk2(s2 * inv - bflo(wself.y), s3 * inv - bfhi(wself.y));
            *(u32x2*)(pr + C_POOL + lane * 4) = o;
        }
    }
    LAS bf16_t* scr = (LAS bf16_t*)(F.lds + F.wave * 16384);
    for (int it = gw; it < (T / 64) * 10; it += NGW) {
        const int tt = it / 10, vh = it % 10, b = tt / 68, key0 = (tt % 68) * 64;
        const int vcol = vh < 4 ? C_DV + 64 * vh : (vh < 8 ? C_NV + 64 * (vh - 4) : C_GV + 64 * (vh - 8));
        const int lt = lane >> 3, lch = lane & 7;
        u32x4 w[8];
#pragma unroll
        for (int g = 0; g < 8; ++g) w[g] = *(const u32x4*)(PROJ + ((size_t)tt * 64 + g * 8 + lt) * LDP + vcol + lch * 8);
#pragma unroll
        for (int g = 0; g < 8; ++g) { const int tok = g * 8 + lt; LAS bf16_t* s = scr + (lch * 8) * 66 + tok;
            s[0 * 66] = (bf16_t)(w[g].x & 0xffff); s[1 * 66] = (bf16_t)(w[g].x >> 16); s[2 * 66] = (bf16_t)(w[g].y & 0xffff); s[3 * 66] = (bf16_t)(w[g].y >> 16);
            s[4 * 66] = (bf16_t)(w[g].z & 0xffff); s[5 * 66] = (bf16_t)(w[g].z >> 16); s[6 * 66] = (bf16_t)(w[g].w & 0xffff); s[7 * 66] = (bf16_t)(w[g].w >> 16); }
        asm volatile("s_waitcnt lgkmcnt(0)" ::: "memory");
#pragma unroll
        for (int g = 0; g < 8; ++g) { const int d = g * 8 + lt; const LAS unsigned* rd = (const LAS unsigned*)(scr + d * 66) + lch * 4;
            u32x4 o; o.x = rd[0]; o.y = rd[1]; o.z = rd[2]; o.w = rd[3];
            *(u32x4*)(VT + (((size_t)b * 10 + vh) * 64 + d) * TPB + key0 + lch * 8) = o; }
        asm volatile("s_waitcnt lgkmcnt(0)" ::: "memory");
    }
}

constexpr int ATT_K = 0, ATT_V = 16384, ATT_BIAS = 32768, ATT_Q = 36864;
constexpr float ATT_THR = 6.0f;
template <int MODE>
__device__ __forceinline__ void attn_unit(Frame& F, int l, int b, int h, int qt) {
    LAS unsigned char* lds = F.lds;
    bf16_t* PROJ = WSB(WS_PROJ); const bf16_t* VT = WSB(WS_VT);
    int tid_ = F.tid; asm volatile("" : "+v"(tid_));
    const int tid = tid_, lane = tid & 63, wid = F.wave, r32 = lane & 31, hi = lane >> 5;
    const int qcol = MODE == 0 ? C_GQ + 64 * h : (MODE == 1 ? C_DQ + 64 * h : C_NQ + 64 * h);
    const int kcol = MODE == 0 ? C_GK + 64 * (h >> 1) : (MODE == 1 ? C_DK + 64 * h : C_NK + 64 * h);
    const int vh = MODE == 0 ? 8 + (h >> 1) : (MODE == 1 ? h : 4 + h);
    const size_t rowbase = (size_t)b * TPB;
    const size_t qrow = rowbase + (size_t)qt * 256 + wid * 32 + r32;
    int a0, nA, b0 = 0, nBt = 0;
    if (qt == 16) { a0 = 64; nA = 4; }
    else if (MODE == 2) { a0 = 64; nA = 4; b0 = min(max(4 * qt - 4, 0), 56); nBt = min(max(4 * qt - 1, 0), 56) + 8 - b0; }
    else { a0 = 0; nA = 68; }
    const int ntl = nA + nBt;
    bf16x8 qr[4];
    { const bf16_t* qp = PROJ + qrow * LDP + qcol + 8 * hi;
#pragma unroll
      for (int s = 0; s < 4; ++s) qr[s] = *(const bf16x8*)(qp + 16 * s); }
    const int srow = tid >> 3, sch = tid & 7;
    const bf16_t* kg = PROJ + (rowbase + srow) * LDP + kcol + sch * 8;
    const bf16_t* vg = VT + (((size_t)b * 10 + vh) * 64 + srow) * TPB + sch * 8;
    const int swz = (srow >> 1) & 7;
    const int kst = srow * 128 + ((sch ^ swz) << 4), vst = ATT_V + srow * 128 + ((sch ^ swz) << 4);
    const bool vswap = (srow & 16) != 0;
    const int rsw = (r32 >> 1) & 7;
    const int kfr = r32 * 128;
    const int vfr = ATT_V + r32 * 128 + 8 * (hi ^ ((r32 >> 4) & 1));
    int vfr1_ = vfr + 4096; asm volatile("" : "+v"(vfr1_)); const int vfr1 = vfr1_;
    if (MODE == 2 && qt < 16) { for (int i = tid; i < 465; i += 512) ((LAS float*)(lds + ATT_BIAS))[i] = inptr(I_RPB)[((size_t)l * 4 + h) * 465 + i] * LOG2E; }
    float m0 = 0.f, l0 = 0.f, m1 = 0.f, l1 = 0.f;
    f32x16 oA[2], oB[2];
#pragma unroll
    for (int i = 0; i < 2; ++i) { oA[i] = (f32x16){}; oB[i] = (f32x16){}; }
    const int qgr = 4 * qt + (wid >> 1), qj = 32 * (wid & 1) + r32;
    const int wstart = min(max(qgr - 4, 0), 56), cst = min(max(qj - 8, 0), 48);

    auto tile_key0 = [&](int i) -> int { return (i < nA ? a0 + i : b0 + (i - nA)) * 64; };
    if constexpr (MODE == 0) {
        constexpr int PV0 = 32768;
        int vq0 = PV0 - ATT_V + vfr, vq1 = PV0 - ATT_V + vfr + 4096, vq2 = PV0 - ATT_V + 8192 + vfr, vq3 = PV0 - ATT_V + 8192 + vfr + 4096;
        asm volatile("" : "+v"(vq0), "+v"(vq1), "+v"(vq2), "+v"(vq3));
        const int nst = ntl >> 1;
        u32x4 kr[2], vr[2];
#pragma unroll
        for (int u = 0; u < 2; ++u) { const int k0 = tile_key0(u); kr[u] = *(const u32x4*)(kg + (size_t)k0 * LDP); vr[u] = *(const u32x4*)(vg + k0); }
#pragma unroll
        for (int u = 0; u < 2; ++u) { *(LAS u32x4*)(lds + u * 8192 + kst) = kr[u]; u32x4 vv = vr[u]; if (vswap) vv = (u32x4){vr[u].z, vr[u].w, vr[u].x, vr[u].y}; *(LAS u32x4*)(lds + PV0 - ATT_V + u * 8192 + vst) = vv; }
        __syncthreads();
        for (int ip = 0; ip < nst; ++ip) {
            const int buf = (ip & 1) * 16384;
            if (ip + 1 < nst) {
#pragma unroll
                for (int u = 0; u < 2; ++u) { const int k0 = tile_key0(2 * ip + 2 + u); kr[u] = *(const u32x4*)(kg + (size_t)k0 * LDP); vr[u] = *(const u32x4*)(vg + k0); } }
            f32x16 p[2][2];
#pragma unroll
            for (int u = 0; u < 2; ++u) { p[u][0] = (f32x16){}; p[u][1] = (f32x16){};
#pragma unroll
                for (int s = 0; s < 4; ++s) {
                    const bf16x8 k0f = *(const LAS bf16x8*)(lds + buf + u * 8192 + kfr + (((2 * s + hi) ^ rsw) << 4));
                    const bf16x8 k1f = *(const LAS bf16x8*)(lds + buf + u * 8192 + kfr + 4096 + (((2 * s + hi) ^ rsw) << 4));
                    p[u][0] = __builtin_amdgcn_mfma_f32_32x32x16_bf16(k0f, qr[s], p[u][0], 0, 0, 0);
                    p[u][1] = __builtin_amdgcn_mfma_f32_32x32x16_bf16(k1f, qr[s], p[u][1], 0, 0, 0);
                } }
            float mxa = -3.0e38f, mxb = -3.0e38f;
#pragma unroll
            for (int u = 0; u < 2; ++u)
#pragma unroll
                for (int r = 0; r < 16; r += 2) { mxa = __builtin_fmaxf(__builtin_fmaxf(mxa, p[u][0][r]), p[u][0][r + 1]); mxb = __builtin_fmaxf(__builtin_fmaxf(mxb, p[u][1][r]), p[u][1][r + 1]); }
            const float mx = half_max(__builtin_fmaxf(mxa, mxb));
            const float dgrow = mx - m0;
            if (ip == 0 || __builtin_amdgcn_ballot_w64(dgrow > ATT_THR) != 0ull) {
                const float dn = (ip == 0) ? dgrow : __builtin_fmaxf(dgrow, 0.f);
                const float alpha = (ip == 0) ? 0.f : fast_exp2(-dn);
                m0 += dn; l0 *= alpha; oA[0] = oA[0] * alpha; oA[1] = oA[1] * alpha;
            }
            bf16x8 pk[2][4];
#pragma unroll
            for (int u = 0; u < 2; ++u) {
                p[u][0] = p[u][0] - m0; p[u][1] = p[u][1] - m0;
#pragma unroll
                for (int r = 0; r < 16; ++r) { p[u][0][r] = fast_exp2(p[u][0][r]); p[u][1][r] = fast_exp2(p[u][1][r]); }
                { const f32x16 sv = p[u][0] + p[u][1]; const f32x4 s4 = (f32x4){sv[0], sv[1], sv[2], sv[3]} + (f32x4){sv[4], sv[5], sv[6], sv[7]} + (f32x4){sv[8], sv[9], sv[10], sv[11]} + (f32x4){sv[12], sv[13], sv[14], sv[15]};
                  l0 += (s4.x + s4.y) + (s4.z + s4.w); }
#pragma unroll
                for (int s = 0; s < 4; ++s) { u32x4 w; const f32x16& pp = p[u][s >> 1]; const int q8 = 8 * (s & 1);
                    w.x = cvt_pk_bf16(pp[q8 + 0], pp[q8 + 1]); w.y = cvt_pk_bf16(pp[q8 + 2], pp[q8 + 3]); w.z = cvt_pk_bf16(pp[q8 + 4], pp[q8 + 5]); w.w = cvt_pk_bf16(pp[q8 + 6], pp[q8 + 7]);
                    pk[u][s] = __builtin_bit_cast(bf16x8, w); }
            }
            if (ip + 1 < nst) { const int nb = ((ip + 1) & 1) * 16384;
#pragma unroll
                for (int u = 0; u < 2; ++u) { *(LAS u32x4*)(lds + nb + u * 8192 + kst) = kr[u]; u32x4 vv = vr[u]; if (vswap) vv = (u32x4){vr[u].z, vr[u].w, vr[u].x, vr[u].y}; *(LAS u32x4*)(lds + PV0 - ATT_V + nb + u * 8192 + vst) = vv; } }
#pragma unroll
            for (int u = 0; u < 2; ++u)
#pragma unroll
                for (int db = 0; db < 2; ++db)
#pragma unroll
                    for (int s = 0; s < 4; ++s) {
                        const u32x2 lo = *(const LAS u32x2*)(lds + buf + (u ? (db ? vq3 : vq2) : (db ? vq1 : vq0)) + (((2 * s) ^ rsw) << 4));
                        const u32x2 hh = *(const LAS u32x2*)(lds + buf + (u ? (db ? vq3 : vq2) : (db ? vq1 : vq0)) + (((2 * s + 1) ^ rsw) << 4));
                        const bf16x8 vf = __builtin_bit_cast(bf16x8, (u32x4){lo.x, lo.y, hh.x, hh.y});
                        oA[db] = __builtin_amdgcn_mfma_f32_32x32x16_bf16(vf, pk[u][s], oA[db], 0, 0, 0);
                    }
            __syncthreads();
        }
    } else {
    u32x4 kreg, vreg;
    { const int k0 = tile_key0(0); kreg = *(const u32x4*)(kg + (size_t)k0 * LDP); vreg = *(const u32x4*)(vg + k0); }
    { *(LAS u32x4*)(lds + kst) = kreg; u32x4 vv = vreg; if (vswap) vv = (u32x4){vreg.z, vreg.w, vreg.x, vreg.y}; *(LAS u32x4*)(lds + vst) = vv; }
    __syncthreads();
    for (int i = 0; i < ntl; ++i) {
        const int buf = (i & 1) * 8192;
        if (i + 1 < ntl) { const int k0 = tile_key0(i + 1); kreg = *(const u32x4*)(kg + (size_t)k0 * LDP); vreg = *(const u32x4*)(vg + k0); }
        bool part = true; int dr = 0;
        if (MODE == 2 && i >= nA) { const int kr = b0 + (i - nA); part = (kr >= wstart) && (kr < wstart + 8); dr = kr - qgr + 7; }
        if (part) {
            bf16x8 pk[MODE == 1 ? 2 : 1][4];
#pragma unroll
            for (int c = 0; c < (MODE == 1 ? 2 : 1); ++c) {
                f32x16 p0 = (f32x16){}, p1 = (f32x16){};
#pragma unroll
                for (int s = (MODE == 1 ? 2 * c : 0); s < (MODE == 1 ? 2 * c + 2 : 4); ++s) {
                    const bf16x8 k0f = *(const LAS bf16x8*)(lds + buf + kfr + (((2 * s + hi) ^ rsw) << 4));
                    const bf16x8 k1f = *(const LAS bf16x8*)(lds + buf + kfr + 4096 + (((2 * s + hi) ^ rsw) << 4));
                    p0 = __builtin_amdgcn_mfma_f32_32x32x16_bf16(k0f, qr[s], p0, 0, 0, 0);
                    p1 = __builtin_amdgcn_mfma_f32_32x32x16_bf16(k1f, qr[s], p1, 0, 0, 0);
                }
                if (MODE == 2 && i >= nA) {
                    const LAS float* bt = (const LAS float*)(lds + ATT_BIAS) + dr * 31 + 15 - qj;
#pragma unroll
                    for (int r = 0; r < 16; ++r) { const int kj = (r & 3) + 8 * (r >> 2) + 4 * hi;
                        { const int ix = min(max(kj - qj, -15), 15) + qj; const bool ok = (kj >= cst) && (kj < cst + 16); p0[r] = ok ? p0[r] + bt[ix] : -1e30f; }
                        { const int k2 = kj + 32; const int ix = min(max(k2 - qj, -15), 15) + qj; const bool ok = (k2 >= cst) && (k2 < cst + 16); p1[r] = ok ? p1[r] + bt[ix] : -1e30f; } }
                }
                float& mm = (c == 0) ? m0 : m1; float& ll = (c == 0) ? l0 : l1; f32x16* oo = (c == 0) ? oA : oB;
                float mxa = __builtin_fmaxf(__builtin_fmaxf(p0[0], p0[1]), p1[0]), mxb = __builtin_fmaxf(__builtin_fmaxf(p0[2], p0[3]), p1[1]);
                mxa = __builtin_fmaxf(__builtin_fmaxf(mxa, p1[2]), p1[3]);
#pragma unroll
                for (int r = 4; r < 16; r += 4) { mxa = __builtin_fmaxf(__builtin_fmaxf(mxa, p0[r]), p0[r + 1]); mxb = __builtin_fmaxf(__builtin_fmaxf(mxb, p0[r + 2]), p0[r + 3]);
                    mxa = __builtin_fmaxf(__builtin_fmaxf(mxa, p1[r]), p1[r + 1]); mxb = __builtin_fmaxf(__builtin_fmaxf(mxb, p1[r + 2]), p1[r + 3]); }
                const float mx = half_max(__builtin_fmaxf(mxa, mxb));
                const float dgrow = mx - mm;
                if (i == 0 || __builtin_amdgcn_ballot_w64(dgrow > ATT_THR) != 0ull) {
                    const float dn = (i == 0) ? dgrow : __builtin_fmaxf(dgrow, 0.f);
                    const float alpha = (i == 0) ? 0.f : fast_exp2(-dn);
                    mm += dn; ll *= alpha; oo[0] = oo[0] * alpha; oo[1] = oo[1] * alpha;
                }
                p0 = p0 - mm; p1 = p1 - mm;
#pragma unroll
                for (int r = 0; r < 16; ++r) { p0[r] = fast_exp2(p0[r]); p1[r] = fast_exp2(p1[r]); }
                { const f32x16 sv = p0 + p1; const f32x4 s4 = (f32x4){sv[0], sv[1], sv[2], sv[3]} + (f32x4){sv[4], sv[5], sv[6], sv[7]} + (f32x4){sv[8], sv[9], sv[10], sv[11]} + (f32x4){sv[12], sv[13], sv[14], sv[15]};
                  ll += (s4.x + s4.y) + (s4.z + s4.w); }
#pragma unroll
                for (int s = 0; s < 4; ++s) { u32x4 w;
                    if (s < 2) { w.x = cvt_pk_bf16(p0[8 * s + 0], p0[8 * s + 1]); w.y = cvt_pk_bf16(p0[8 * s + 2], p0[8 * s + 3]); w.z = cvt_pk_bf16(p0[8 * s + 4], p0[8 * s + 5]); w.w = cvt_pk_bf16(p0[8 * s + 6], p0[8 * s + 7]); }
                    else { const int q8 = 8 * (s - 2); w.x = cvt_pk_bf16(p1[q8 + 0], p1[q8 + 1]); w.y = cvt_pk_bf16(p1[q8 + 2], p1[q8 + 3]); w.z = cvt_pk_bf16(p1[q8 + 4], p1[q8 + 5]); w.w = cvt_pk_bf16(p1[q8 + 6], p1[q8 + 7]); }
                    pk[c][s] = __builtin_bit_cast(bf16x8, w); }
            }
            if (MODE == 1 && i + 1 < ntl) { const int nb = ((i + 1) & 1) * 8192; *(LAS u32x4*)(lds + nb + kst) = kreg; u32x4 vv = vreg; if (vswap) vv = (u32x4){vreg.z, vreg.w, vreg.x, vreg.y}; *(LAS u32x4*)(lds + nb + vst) = vv; }
#pragma unroll
            for (int db = 0; db < 2; ++db)
#pragma unroll
                for (int s = 0; s < 4; ++s) {
                    const u32x2 lo = *(const LAS u32x2*)(lds + buf + (db ? vfr1 : vfr) + (((2 * s) ^ rsw) << 4));
                    const u32x2 hh = *(const LAS u32x2*)(lds + buf + (db ? vfr1 : vfr) + (((2 * s + 1) ^ rsw) << 4));
                    const bf16x8 vf = __builtin_bit_cast(bf16x8, (u32x4){lo.x, lo.y, hh.x, hh.y});
                    oA[db] = __builtin_amdgcn_mfma_f32_32x32x16_bf16(vf, pk[0][s], oA[db], 0, 0, 0);
                    if (MODE == 1) oB[db] = __builtin_amdgcn_mfma_f32_32x32x16_bf16(vf, pk[MODE == 1 ? 1 : 0][s], oB[db], 0, 0, 0);
                }
        }
        if (MODE != 1 && i + 1 < ntl) { const int nb = ((i + 1) & 1) * 8192; *(LAS u32x4*)(lds + nb + kst) = kreg; u32x4 vv = vreg; if (vswap) vv = (u32x4){vreg.z, vreg.w, vreg.x, vreg.y}; *(LAS u32x4*)(lds + nb + vst) = vv; }
        __syncthreads();
    }
    }
    bf16_t* op = PROJ + qrow * LDP + qcol + 4 * hi;
    if (MODE == 1) {
        const float lam = WSF(WS_MOD)[131072 + l], lam_init = 0.8f - 0.6f * expf(-0.3f * (float)l);
        const float i0 = 1.0f / half_sum(l0), i1 = lam / half_sum(l1);
        float ss = 0.f;
#pragma unroll
        for (int db = 0; db < 2; ++db)
#pragma unroll
            for (int r = 0; r < 16; ++r) { const float v = oA[db][r] * i0 - oB[db][r] * i1; oA[db][r] = v; ss += v * v; }
        ss = half_sum(ss);
        const float rn = rsqrtf(ss * (1.0f / 64.0f) + RMS_EPS) * (1.0f - lam_init);
        const float* gn = inptr(I_DNG) + l * 64 + 4 * hi;
#pragma unroll
        for (int db = 0; db < 2; ++db)
#pragma unroll
            for (int g4 = 0; g4 < 4; ++g4) { const f32x4 g = *(const f32x4*)(gn + 32 * db + 8 * g4);
                u32x2 w; w.x = pk2(oA[db][4 * g4 + 0] * rn * g.x, oA[db][4 * g4 + 1] * rn * g.y); w.y = pk2(oA[db][4 * g4 + 2] * rn * g.z, oA[db][4 * g4 + 3] * rn * g.w);
                *(u32x2*)(op + 32 * db + 8 * g4) = w; }
    } else {
        const float i0 = 1.0f / half_sum(l0);
#pragma unroll
        for (int db = 0; db < 2; ++db)
#pragma unroll
            for (int g4 = 0; g4 < 4; ++g4) { u32x2 w; w.x = pk2(oA[db][4 * g4 + 0] * i0, oA[db][4 * g4 + 1] * i0); w.y = pk2(oA[db][4 * g4 + 2] * i0, oA[db][4 * g4 + 3] * i0);
                *(u32x2*)(op + 32 * db + 8 * g4) = w; }
    }
}
template <int MODE>
__device__ __forceinline__ void attn_queue(Frame& F, int l, unsigned* qbase, int nq) {
    const int per = 4 * nq;
    volatile LAS int* slot = (volatile LAS int*)(F.lds + LDS_MISC + 64);
    const int x0 = (int)(xb_xcc_id() & 7u);
    for (int dx = 0; dx < 8; ++dx) {
        const int x = (x0 + dx) & 7;
        unsigned* qctr = qbase + x * 64;
        for (;;) {
            if (F.tid == 0) slot[0] = (int)__hip_atomic_fetch_add(qctr, 1u, RLX_AGENT);
            __syncthreads();
            const int id = slot[0];
            __syncthreads();
            if (id >= per) break;
            const int qt = id % nq, bh = (id / nq) * 8 + x;
            attn_unit<MODE>(F, l, bh >> 2, bh & 3, qt);
        }
    }
}

__device__ __forceinline__ void convert_experts_queue(Frame& F, int l, int max_chunks = 1 << 30) {
    const float *w_eg = inptr(I_WEG), *w_eu = inptr(I_WEU), *w_ed = inptr(I_WED);
    bf16_t *GUT = WSB(WS_GUT), *DT = WSB(WS_DT);
    LAS float* scr = (LAS float*)(F.lds + F.wave * 16384);
    volatile LAS int* slot = (volatile LAS int*)(F.lds + LDS_MISC + 64);
    unsigned* qctr = WSU(WS_CTL) + CW_XQ + l * 64;
    constexpr int I_G = 16 * 16, I_D = 8 * 32, PER_E = 2 * I_G + I_D, NCH = NEXP * PER_E / 64;
    for (int done = 0; done < max_chunks; ++done) {
        if (F.tid == 0) slot[0] = (int)__hip_atomic_fetch_add(qctr, 1u, RLX_AGENT);
        __syncthreads();
        const int ch = slot[0];
        __syncthreads();
        if (ch >= NCH) break;
        for (int j = 0; j < 8; ++j) {
            const int it = ch * 64 + F.wave * 8 + j;
            const int e = it / PER_E; int r = it % PER_E;
            const size_t eo = ((size_t)l * NEXP + e);
            if (r < I_G) { transpose_item(w_eg + eo * D * DEXP, D, DEXP, GUT + (size_t)e * 1024 * 1024, 1024, scr, r, F.lane, RowGU{0}); continue; } r -= I_G;
            if (r < I_G) { transpose_item(w_eu + eo * D * DEXP, D, DEXP, GUT + (size_t)e * 1024 * 1024, 1024, scr, r, F.lane, RowGU{1}); continue; } r -= I_G;
            transpose_item(w_ed + eo * DEXP * D, DEXP, D, DT + (size_t)e * 1024 * 512, 512, scr, r, F.lane, RowId{});
        }
    }
}
__device__ __forceinline__ void phase_router(Frame& F, int l) {
    const float *w_rg = inptr(I_WRG), *w_re = inptr(I_WRE), *b_rg = inptr(I_BRG), *b_re = inptr(I_BRE), *g_ffn = inptr(I_GFFN);
    bf16_t *H = WSB(WS_H); float *XCTX = WSF(WS_XCTX), *MOD = WSF(WS_MOD); unsigned *ROUTE = WSU(WS_ROUTE), *ctl = WSU(WS_CTL);
    __syncthreads();
    LAS float* wt = (LAS float*)F.lds;
    LAS int* lcnt = (LAS int*)(F.lds + 147456);
    LAS unsigned* rinfo = (LAS unsigned*)(F.lds + 147456 + 256);
#pragma unroll 4
    for (int c = F.tid; c < 1024 * 8; c += 512) { const int k = c >> 3, o4 = c & 7, rk = ((k & 255) >> 2) + 64 * (4 * (k >> 8) + (k & 3)); *(LAS f32x4*)(wt + rk * 36 + 4 + o4 * 4) = *(const f32x4*)(w_re + ((size_t)l * D + k) * 32 + o4 * 4); }
#pragma unroll
    for (int k = F.tid; k < 1024; k += 512) { const int rk = ((k & 255) >> 2) + 64 * (4 * (k >> 8) + (k & 3)); *(LAS f32x4*)(wt + rk * 36) = *(const f32x4*)(w_rg + ((size_t)l * D + k) * 4); }
    if (F.tid < 64) lcnt[F.tid] = 0;
    __syncthreads();
    const int row_base = F.vcu * 136;
    const float* gf = g_ffn + l * D;
    LAS float* bias = (LAS float*)(F.lds + 150976 + 8 * 256);
    if (F.tid < 4) bias[F.tid] = b_rg[l * 4 + F.tid]; else if (F.tid < 36) bias[F.tid] = b_re[l * 32 + F.tid - 4];
    __syncthreads();
    for (int rp = 0; rp < 17; rp += 2) {
        bool ok[2]; int rls[2]; const float* shp[2]; const float* xrp[2]; float rr[2];
#pragma unroll
        for (int q = 0; q < 2; ++q) {
            const int rl = F.wave + 8 * (rp + q); rls[q] = rl; ok[q] = (rp + q) < 17;
            const int row = row_base + (ok[q] ? rl : 0); const int b = row / TPB, t = row % TPB; const bool isctx = t >= SEQ;
            if (ok[q] && isctx && l == 1) { if (F.lane == 0) rinfo[rl * 6] = 0xffffffffu; ok[q] = false; }
            const int mb = isctx ? 8 : b;
            xrp[q] = isctx ? XCTX + ((size_t)b * CTXL + (t - SEQ)) * D : F.out + ((size_t)b * SEQ + t) * D;
            shp[q] = MOD + ((size_t)l * 9 + mb) * 6144 + 3 * 1024;
        }
#pragma unroll
        for (int q = 0; q < 2; ++q) { float ss = 0.f; const f32x4* xp = (const f32x4*)xrp[q] + F.lane;
#pragma unroll
            for (int j = 0; j < 4; ++j) { const f32x4 x4 = xp[64 * j]; ss += (x4.x * x4.x + x4.y * x4.y) + (x4.z * x4.z + x4.w * x4.w); }
            rr[q] = rsqrtf(wave_sum(ss) * (1.0f / D) + RMS_EPS); }
        float hv[2][16];
#pragma unroll
        for (int j = 0; j < 4; ++j) {
            const f32x4 g4 = ((const f32x4*)gf)[F.lane + 64 * j];
#pragma unroll
            for (int q = 0; q < 2; ++q) { const f32x4 x4 = ((const f32x4*)xrp[q])[F.lane + 64 * j], s4 = ((const f32x4*)shp[q])[F.lane + 64 * j], c4 = ((const f32x4*)(shp[q] + 1024))[F.lane + 64 * j];
                const f32x4 h = (x4 * rr[q] * g4) * (c4 + 1.0f) + s4;
                hv[q][4 * j + 0] = h.x; hv[q][4 * j + 1] = h.y; hv[q][4 * j + 2] = h.z; hv[q][4 * j + 3] = h.w;
                if (ok[q]) { u32x2 w; w.x = pk2(h.x, h.y); w.y = pk2(h.z, h.w); ((u32x2*)(H + (size_t)(row_base + rls[q]) * D))[F.lane + 64 * j] = w; } }
        }
        float ag[2][4];
#pragma unroll
        for (int q = 0; q < 2; ++q)
#pragma unroll
            for (int o = 0; o < 4; ++o) ag[q][o] = 0.f;
#pragma unroll
        for (int je = 0; je < 16; ++je) { const f32x4 w = *(const LAS f32x4*)(wt + (F.lane + 64 * je) * 36);
#pragma unroll
            for (int q = 0; q < 2; ++q) { ag[q][0] += hv[q][je] * w.x; ag[q][1] += hv[q][je] * w.y; ag[q][2] += hv[q][je] * w.z; ag[q][3] += hv[q][je] * w.w; } }
        int grp[2]; float wgrp[2];
#pragma unroll
        for (int q = 0; q < 2; ++q) {
#pragma unroll
            for (int o = 0; o < 4; ++o) ag[q][o] = wave_sum(ag[q][o]) + bias[o];
            int g0 = 0; float gm = ag[q][0];
#pragma unroll
            for (int g = 1; g < 4; ++g) if (ag[q][g] > gm) { gm = ag[q][g]; g0 = g; }
            float gs = 0.f;
#pragma unroll
            for (int g = 0; g < 4; ++g) gs += __expf(ag[q][g] - gm);
            grp[q] = __builtin_amdgcn_readfirstlane(g0); wgrp[q] = 1.0f / gs;
        }
        float ae[2][8];
#pragma unroll
        for (int q = 0; q < 2; ++q)
#pragma unroll
            for (int o = 0; o < 8; ++o) ae[q][o] = 0.f;
#pragma unroll
        for (int je = 0; je < 16; ++je) {
#pragma unroll
            for (int q = 0; q < 2; ++q) { const LAS f32x4* wp = (const LAS f32x4*)(wt + (F.lane + 64 * je) * 36 + 4 + 8 * grp[q]); const f32x4 w0 = wp[0], w1 = wp[1];
                ae[q][0] += hv[q][je] * w0.x; ae[q][1] += hv[q][je] * w0.y; ae[q][2] += hv[q][je] * w0.z; ae[q][3] += hv[q][je] * w0.w;
                ae[q][4] += hv[q][je] * w1.x; ae[q][5] += hv[q][je] * w1.y; ae[q][6] += hv[q][je] * w1.z; ae[q][7] += hv[q][je] * w1.w; } }
#pragma unroll
        for (int q = 0; q < 2; ++q) {
#pragma unroll
            for (int o = 0; o < 8; ++o) ae[q][o] = wave_sum(ae[q][o]) + bias[4 + 8 * grp[q] + o];
            int i1 = 0; float v1 = ae[q][0];
#pragma unroll
            for (int j = 1; j < 8; ++j) if (ae[q][j] > v1) { v1 = ae[q][j]; i1 = j; }
            int i2 = -1; float v2 = -3.0e38f;
#pragma unroll
            for (int j = 0; j < 8; ++j) if (j != i1 && ae[q][j] > v2) { v2 = ae[q][j]; i2 = j; }
            const float e2 = __expf(v2 - v1), w1 = wgrp[q] / (1.0f + e2), w2 = wgrp[q] * e2 / (1.0f + e2);
            if (ok[q] && F.lane == 0) {
                const int rl = rls[q];
                const int ea = grp[q] * 8 + i1, eb = grp[q] * 8 + i2;
                const int sa = __hip_atomic_fetch_add(lcnt + ea, 1, __ATOMIC_RELAXED, __HIP_MEMORY_SCOPE_WORKGROUP);
                const int sb = __hip_atomic_fetch_add(lcnt + eb, 1, __ATOMIC_RELAXED, __HIP_MEMORY_SCOPE_WORKGROUP);
                rinfo[rl * 6 + 0] = (unsigned)ea; rinfo[rl * 6 + 1] = (unsigned)eb; rinfo[rl * 6 + 2] = (unsigned)sa; rinfo[rl * 6 + 3] = (unsigned)sb;
                rinfo[rl * 6 + 4] = __builtin_bit_cast(unsigned, w1); rinfo[rl * 6 + 5] = __builtin_bit_cast(unsigned, w2);
            }
        }
    }
    __syncthreads();
    if (F.tid < 32) lcnt[32 + F.tid] = (int)__hip_atomic_fetch_add(ctl + CW_CNT + l * 32 + F.tid, (unsigned)lcnt[F.tid], RLX_AGENT);
    __syncthreads();
    if (F.tid < 136) { const int rl = F.tid; const unsigned ea = rinfo[rl * 6];
        if (ea != 0xffffffffu) { const unsigned eb = rinfo[rl * 6 + 1]; unsigned* ro = ROUTE + (size_t)(row_base + rl) * 8;
            ro[0] = ea; ro[1] = eb; ro[2] = rinfo[rl * 6 + 2] + (unsigned)lcnt[32 + ea]; ro[3] = rinfo[rl * 6 + 3] + (unsigned)lcnt[32 + eb]; ro[4] = rinfo[rl * 6 + 4]; ro[5] = rinfo[rl * 6 + 5]; } }
    __syncthreads();
}
__device__ __forceinline__ int build_tiles(Frame& F, int l) {
    LAS int* offs = (LAS int*)(F.lds + LDS_MISC + 128);
    LAS int* cnts = (LAS int*)(F.lds + LDS_MISC + 320);
    LAS int* tile_e = (LAS int*)(F.lds + LDS_TILE_E);
    __syncthreads();
    if (F.tid < NEXP) cnts[F.tid] = (int)__hip_atomic_load(WSU(WS_CTL) + CW_CNT + l * 32 + F.tid, RLX_AGENT);
    __syncthreads();
    if (F.tid == 0) { int o = 0, k = 0;
        for (int e = 0; e < NEXP; ++e) { const int c = cnts[e]; offs[e] = o; const int nt = (c + 255) >> 8;
            for (int j = 0; j < nt && k < MPAD / 256; ++j) tile_e[k++] = e; o += nt << 8; }
        offs[32] = k; }
    __syncthreads();
    return __builtin_amdgcn_readfirstlane(offs[32]);
}
constexpr size_t WS_ROWMAP = WS_ROWW + 512 * 1024;
__device__ __forceinline__ void phase_scatter(Frame& F, int l) {
    (void)build_tiles(F, l);
    const LAS int* offs = (const LAS int*)(F.lds + LDS_MISC + 128);
    const LAS int* cnts = (const LAS int*)(F.lds + LDS_MISC + 320);
    const int gw = F.vcu * 8 + F.wave, NGW = F.G * 8;
    unsigned* ROUTE = WSU(WS_ROUTE); float* ROWW = WSF(WS_ROWW); int* ROWMAP = (int*)(F.ws + WS_ROWMAP);
    for (int r0 = gw * 64 + F.lane; r0 < T; r0 += NGW * 64) {
        const int row = r0;
        if (l == 1 && (row % TPB) >= SEQ) continue;
        unsigned* ro = ROUTE + (size_t)row * 8;
        const u32x4 r4 = *(const u32x4*)ro;
        const unsigned pa = (unsigned)offs[r4.x] + r4.z, pb = (unsigned)offs[r4.y] + r4.w;
        if (pa < (unsigned)MPAD && pb < (unsigned)MPAD) {
            ROWW[pa] = __builtin_bit_cast(float, ro[4]); ROWW[pb] = __builtin_bit_cast(float, ro[5]); ro[6] = pa; ro[7] = pb; ROWMAP[pa] = row; ROWMAP[pb] = row; }
    }
    if (F.vcu < NEXP) { const int e = F.vcu, c = cnts[e], o = offs[e], end = o + (((c + 255) >> 8) << 8);
        for (int p = o + c + F.tid; p < end && p < MPAD; p += 512) { ROWMAP[p] = 0; ROWW[p] = 0.f; } }
}

#define IN(k) (lo <= (k) && (k) < hi)
#define SEAM(k) do { if (IN(k) && IN((k) + 1)) { XcdBarrier b2 = bar; asm volatile("" : "+s"(b2.bar)); xcd_barrier(b2); } } while (0)
#if MK_STAMP
#define STAMP(k) do { if (blockIdx.x == 0 && threadIdx.x == 0) ((unsigned long long*)(F0.ws + 262144))[k] = __builtin_amdgcn_s_memrealtime(); } while (0)
#else
#define STAMP(k) do { } while (0)
#endif
template <int l>
__device__ __forceinline__ void run_layer(const Frame& F0, const XcdBarrier& bar, int lo, int hi) {
    constexpr int P = 1 + 11 * l;
        STAMP(P + 0);
        STAMP(P + 1);
    if (IN(P + 1)) { Frame F = launder(F0); if (l == 0) p0_prologue(F, 1); phase_modulate(F, l, 0); } SEAM(P + 1);
        STAMP(P + 2);
    if (IN(P + 2)) { Frame F = launder(F0);
            pg8::Gemm g{LDP * 2, D * 2}; SchedIn S{F.G, F.bx, (const char*)(WSB(WS_PROJ) + C_H), (const char*)(WSB(WS_WIN) + (size_t)l * NIN * D)}; EpiIn E{WSB(WS_PROJ)};
            pg8::gemm_phase<EpiIn, SchedIn, true>(F.lds, g, S, E);
        } SEAM(P + 2);
        STAMP(P + 3);
    if (IN(P + 3)) { Frame F = launder(F0); phase_post(F, l); } SEAM(P + 3);
        STAMP(P + 4);
    if (IN(P + 4)) { Frame F = launder(F0);
            const int nq = l == 0 ? 17 : 16;
            const int cslot = (l == 1) ? (F.vcu & 3) : -1;
            if (cslot == 0) convert_experts_queue(F, l, 2);
            attn_queue<1>(F, l, WSU(WS_CTL) + CW_Q + ((l * 4 + 0) * 8) * 64, nq);
            if (cslot == 1) convert_experts_queue(F, l, 2);
            attn_queue<0>(F, l, WSU(WS_CTL) + CW_Q + ((l * 4 + 1) * 8) * 64, nq);
            if (cslot == 2) convert_experts_queue(F, l, 2);
            attn_queue<2>(F, l, WSU(WS_CTL) + CW_Q + ((l * 4 + 2) * 8) * 64, nq);
            if (cslot == 3) convert_experts_queue(F, l, 2);
        } SEAM(P + 4);
        STAMP(P + 5);
    if (IN(P + 5)) { Frame F = launder(F0);
            pg8::Gemm g{LDP * 2, D * 2}; SchedMerge S{F.G, F.bx, 128, 1, l == 0 ? 1 : 0, (const char*)WSB(WS_PROJ), (const char*)(WSB(WS_WIN) + ((size_t)l * NIN + 2304) * D), (const char*)(WSB(WS_WBR) + (size_t)l * 4 * D * D)};
            EpiMerge E{WSB(WS_H), WSB(WS_VT) + (size_t)F.bx * 65536, WSB(WS_SLAB)};
            pg8::gemm_phase<EpiMerge, SchedMerge, true>(F.lds, g, S, E);
            convert_experts_queue(F, l);
        } SEAM(P + 5);
        STAMP(P + 6);
    if (IN(P + 6)) { Frame F = launder(F0);
            pg8::Gemm g{D * 2, D * 2}; SchedOut S{F.G, F.bx, l == 0 ? 136 : 128, l, (const char*)WSB(WS_H), (const char*)(WSB(WS_WOUT) + (size_t)l * D * D), l == 0 ? (const char*)WSB(WS_PRIV) : nullptr};
            if (l == 0) sum_ctx_slabs(F, S);
            EpiOut E{l == 0 ? inptr(I_X) : (const float*)F.out, l == 0 ? inptr(I_CTX) : (const float*)WSF(WS_XCTX), F.out, WSF(WS_XCTX), WSF(WS_MOD) + (size_t)l * 9 * 6144};
            pg8::gemm_phase<EpiOut, SchedOut, true>(F.lds, g, S, E);
        } SEAM(P + 6);
        STAMP(P + 7);
    if (IN(P + 7)) { Frame F = launder(F0); phase_router(F, l); } SEAM(P + 7);
        STAMP(P + 8);
    if (IN(P + 8)) { Frame F = launder(F0); phase_scatter(F, l); } SEAM(P + 8);
        STAMP(P + 9);
    if (IN(P + 9)) { Frame F = launder(F0);
            const int ntiles = build_tiles(F, l);
            LAS int* rmt = (LAS int*)(F.lds + 131072);
            { const int* ROWMAP = (const int*)(F.ws + WS_ROWMAP);
              for (int i = 0; i < 8; ++i) { const int L = i * F.G + F.vcu; if (L < ntiles * 4 && F.tid < 256) rmt[i * 256 + F.tid] = ROWMAP[(size_t)(L >> 2) * 256 + F.tid]; }
              __syncthreads(); }
            pg8::Gemm g{D * 2, D * 2}; SchedMoe<1024> S{F.G, F.vcu, ntiles, (const LAS int*)(F.lds + LDS_TILE_E), (const char*)WSB(WS_H), (const char*)WSB(WS_GUT)}; EpiGU E{WSB(WS_HMID)};
            pg8::gemm_phase<EpiGU, SchedMoe<1024>, true, true>(F.lds, g, S, E, (const char*)WSB(WS_H), rmt);
        } SEAM(P + 9);
        STAMP(P + 10);
    if (IN(P + 10)) { Frame F = launder(F0);
            const int ntiles = build_tiles(F, l);
            pg8::Gemm g{DEXP * 2, DEXP * 2}; SchedMoe<512> S{F.G, F.vcu, ntiles, (const LAS int*)(F.lds + LDS_TILE_E), (const char*)WSB(WS_HMID), (const char*)WSB(WS_DT)}; EpiDown E{WSB(WS_Y), WSF(WS_ROWW)};
            pg8::gemm_phase<EpiDown, SchedMoe<512>, true>(F.lds, g, S, E);
        } SEAM(P + 10);
    }
constexpr int N_PHASES = 24;
__global__ void __launch_bounds__(512, 2) fwd_kernel(Args args) {
    extern __shared__ __attribute__((aligned(16))) unsigned char lds_raw[];
    Frame F0;
    F0.lds = (LAS unsigned char*)lds_raw;
    F0.tid = threadIdx.x; F0.lane = F0.tid & 63; F0.wave = __builtin_amdgcn_readfirstlane(F0.tid >> 6);
    F0.G = gridDim.x; F0.bx = blockIdx.x; { const int bx = blockIdx.x; F0.vcu = (F0.G % 8 == 0) ? (bx % 8) * (F0.G / 8) + bx / 8 : bx; }
    F0.ws = args.ws; F0.out = args.out;
    for (int u = F0.tid; u < (LDS_BYTES - LDS_MISC) / 4; u += 512) ((LAS unsigned*)(F0.lds + LDS_MISC))[u] = 0u;
    __syncthreads();
    const int lo = args.ph_lo, hi = args.ph_hi;
    XcdBarrier bar; bar.bar = ((unsigned*)(F0.ws + WS_CTL)) + CW_BAR; bar.x = 0; bar.st = nullptr;
    if (hi - lo > 1) bar = xcd_barrier_post(((unsigned*)(F0.ws + WS_CTL)) + CW_BAR, (volatile LAS unsigned*)(F0.lds + LDS_MISC + 32));

    STAMP(0);
    if (IN(0)) { Frame F = launder(F0); p0_prologue(F, 0); } SEAM(0);
    run_layer<0>(F0, bar, lo, hi);
    run_layer<1>(F0, bar, lo, hi);
    STAMP(23);
    if (IN(23)) { Frame F = launder(F0); phase_modulate(F, 2, 0); }
    STAMP(24);
#if MK_STAMP
    if (blockIdx.x == 0 && threadIdx.x == 0) {
        const unsigned long long* ts = (const unsigned long long*)(F0.ws + 262144);
        const unsigned long long wait = 4ull * (ts[MK_STAMP_A % 100] - ts[MK_STAMP_A / 100]), t0 = __builtin_amdgcn_s_memrealtime();
        while (__builtin_amdgcn_s_memrealtime() - t0 < wait) __builtin_amdgcn_s_sleep(32);
    }
#endif
#undef IN
#undef SEAM
}


#if MK_CHECK
constexpr size_t WS_CHK = 512 * 1024;
constexpr size_t WS_CHKBUF = WS_END;
__device__ __forceinline__ unsigned hsh(unsigned x) { x ^= x >> 16; x *= 0x7feb352du; x ^= x >> 15; x *= 0x846ca68bu; x ^= x >> 16; return x; }
__device__ __forceinline__ void chk_put(unsigned* CHK, int id, float err) { if (!(err >= 0.f)) err = 1e30f; atomicMax(CHK + id, __builtin_bit_cast(unsigned, err)); }
__device__ __forceinline__ float ref_rope_elem(const float* v, int nd, int idx, int t) {
    if (idx >= nd) return 0.f;
    const int h = nd / 2, half = h / 2; const int sec = idx / h, ii = idx % h; const float pos = sec == 0 ? (float)(t / 64) : (float)(t % 64);
    const int i = ii % half; const float inv = powf(10000.0f, -(float)i / (float)half); const float ang = pos * inv, cs = cosf(ang), sn = sinf(ang);
    const float x1 = v[sec * h + i], x2 = v[sec * h + half + i];
    return ii < half ? x1 * cs - x2 * sn : x1 * sn + x2 * cs;
}
__global__ void chk_kernel(Args args, int which, int l) {
    unsigned char* ws = args.ws; unsigned* CHK = (unsigned*)(ws + WS_CHK);
    const float* const* in = args.in;
    const bf16_t* H = (const bf16_t*)(ws + WS_H); const bf16_t* PROJ = (const bf16_t*)(ws + WS_PROJ); const bf16_t* VT = (const bf16_t*)(ws + WS_VT);
    const float* MOD = (const float*)(ws + WS_MOD); const float* XCTX = (const float*)(ws + WS_XCTX); const unsigned* ROUTE = (const unsigned*)(ws + WS_ROUTE); const float* ROWW = (const float*)(ws + WS_ROWW);
    float* CB = (float*)(ws + WS_CHKBUF);
    const int s = blockIdx.x, tid = threadIdx.x; const unsigned h1 = hsh(s * 2654435761u + 12345u + (which == 5 ? 4 : which) * 977u), h2 = hsh(h1 + 0x9e3779b9u), h3 = hsh(h2 + 77u);
    const int id = l * 16 + which;
    __shared__ float sh[4608]; __shared__ float red[64];
    if (which == 0) {
        if (tid != 0) return; const int ll = s & 1, bb = (s >> 1) % 9, j = h1 % 6144; float acc = 0.f;
        for (int k = 0; k < 1024; ++k) { const float v = bb < 8 ? in[I_C][bb * 1024 + k] : in[I_CCTX][k]; acc += v / (1.f + expf(-v)) * in[I_WMOD][((size_t)ll * 1024 + k) * 6144 + j]; }
        acc += in[I_BMOD][ll * 6144 + j]; chk_put(CHK, id, fabsf(acc - MOD[((size_t)ll * 9 + bb) * 6144 + j]));
    } else if (which == 1) {
        if (tid != 0) return; const int row = h1 % T, col = h2 % 1024, b = row / TPB, t = row % TPB; const bool ic = t >= SEQ;
        const float* x = ic ? in[I_CTX] + ((size_t)b * CTXL + t - SEQ) * D : in[I_X] + ((size_t)b * SEQ + t) * D; float ss = 0.f;
        for (int k = 0; k < 1024; ++k) ss += x[k] * x[k];
        const float r = 1.0f / sqrtf(ss / 1024.f + 1e-6f); const float* m = MOD + (size_t)(ic ? 8 : b) * 6144;
        const float e = x[col] * r * in[I_GMIX][col] * (1.f + m[1024 + col]) + m[col]; chk_put(CHK, id, fabsf(e - bf2f(PROJ[(size_t)row * LDP + C_H + col])));
    } else if (which == 2) {
        if (tid != 0) return; const int row = h1 % T, col = h2 % 2304; float acc = 0.f;
        for (int k = 0; k < 1024; ++k) acc += bf2f(PROJ[(size_t)row * LDP + C_H + k]) * in[I_WIN][((size_t)l * 1024 + k) * NIN + col];
        chk_put(CHK, id, fabsf(acc - bf2f(PROJ[(size_t)row * LDP + col])));
    } else if (which == 3) {
        const int kind = s % 7, row = h1 % T, b = row / TPB, t = row % TPB; const bool ic = t >= SEQ;
        int c0 = 0, nd = 64; const int hh = h2 & 3;
        if (kind == 0) { c0 = C_DQ + 32 * (h2 & 7); nd = 32; } else if (kind == 1) { c0 = C_DK + 32 * (h2 & 7); nd = 32; } else if (kind == 2) c0 = C_GQ + 64 * hh; else if (kind == 3) c0 = C_GK + 64 * (hh & 1);
        else if (kind == 4) c0 = C_NQ + 64 * hh; else if (kind == 5) c0 = 64 * hh; else c0 = (h3 % 10 < 4 ? C_DV + 64 * (h3 % 10) : (h3 % 10 < 8 ? C_NV + 64 * (h3 % 10 - 4) : C_GV + 64 * (h3 % 10 - 8)));
        if (kind == 5) {
            const int ch = c0 + tid, win = 2 << (ch / 64), n = ic ? CTXL : SEQ, ts = ic ? t - SEQ : t, lo = max(ts - win / 2, 0), hi = min(ts + win / 2, n); float sum = 0.f, self = 0.f;
            for (int i = lo; i < hi; ++i) { const size_t r2 = (size_t)(row - ts + i); float acc = 0.f; for (int k = 0; k < 1024; ++k) acc += bf2f(PROJ[r2 * LDP + C_H + k]) * in[I_WIN][((size_t)l * 1024 + k) * NIN + ch]; sum += acc; if (i == ts) self = acc; }
            chk_put(CHK, id, fabsf(sum / (float)(hi - lo) - self - bf2f(PROJ[(size_t)row * LDP + C_POOL + ch]))); return; }
        float acc = 0.f; if (tid < nd) for (int k = 0; k < 1024; ++k) acc += bf2f(PROJ[(size_t)row * LDP + C_H + k]) * in[I_WIN][((size_t)l * 1024 + k) * NIN + c0 + tid];
        sh[tid] = acc; __syncthreads();
        if (kind == 6) { const int vh = h3 % 10; chk_put(CHK, id, fabsf(acc - bf2f(VT[(((size_t)b * 10 + vh) * 64 + tid) * TPB + t]))); return; }
        float* v = sh + 64;
        if (kind == 2 || kind == 3) { float ss = 0.f; for (int i = 0; i < 64; ++i) ss += sh[i] * sh[i]; const float r = 1.f / sqrtf(ss / 64.f + 1e-6f); const float* g = (kind == 2 ? in[I_QN] : in[I_KN]) + l * 64; v[tid] = sh[tid] * r * g[tid]; }
        else v[tid] = sh[tid];
        __syncthreads();
        float e = v[tid]; if (!ic && kind <= 3) e = ref_rope_elem(v, nd, tid, t);
        if (kind == 0) e *= 0.17677669529663687f * LOG2E; if (kind == 2 || kind == 4) e *= 0.125f * LOG2E;
        if (tid < nd) chk_put(CHK, id, fabsf(e - bf2f(PROJ[(size_t)row * LDP + c0 + tid])));
    } else if (which == 4 || which == 5) {
        const int mode = s % 3, nq = l == 0 ? 17 : 16, b = h1 % NB, h = h2 & 3, qt = h3 % nq, q = qt * 256 + (hsh(h3) & 255); const size_t rowb = (size_t)b * TPB;
        const int qcol = mode == 0 ? C_GQ + 64 * h : (mode == 1 ? C_DQ + 64 * h : C_NQ + 64 * h), kcol = mode == 0 ? C_GK + 64 * (h >> 1) : (mode == 1 ? C_DK + 64 * h : C_NK + 64 * h), vcol = mode == 0 ? C_GV + 64 * (h >> 1) : (mode == 1 ? C_DV + 64 * h : C_NV + 64 * h);
        if (which == 5) { const float er = fabsf(CB[s * 64 + tid] - bf2f(PROJ[(rowb + q) * LDP + qcol + tid])); chk_put(CHK, l * 16 + (mode == 0 ? 5 : 11 + mode), er);
            if (l == 0 && mode == MK_CHK_MODE) { const float ex = CB[s * 64 + tid], gt = bf2f(PROJ[(rowb + q) * LDP + qcol + tid]);
                atomicAdd((float*)(CHK + 60), ex * gt); atomicAdd((float*)(CHK + 61), ex * ex); atomicAdd((float*)(CHK + 62), gt * gt); } return; }
        const bool ic = q >= SEQ; const int k_lo = ic ? SEQ : 0, k_hi = TPB;
        float outv = 0.f, out2 = 0.f;
        for (int map = 0; map < (mode == 1 ? 2 : 1); ++map) {
            float mx = -3e38f;
            for (int k = k_lo + tid; k < k_hi; k += 64) { float sc = 0.f; const int d0 = mode == 1 ? 32 * map : 0, dn = mode == 1 ? 32 : 64;
                for (int d = 0; d < dn; ++d) sc += bf2f(PROJ[(rowb + q) * LDP + qcol + d0 + d]) * bf2f(PROJ[(rowb + k) * LDP + kcol + d0 + d]);
                if (mode == 2 && !ic) { if (k < SEQ) { const int r = q / 64, j = q % 64, kr = k / 64, kj = k % 64, ws_ = min(max(r - 4, 0), 56), cs = min(max(j - 8, 0), 48);
                        if (kr >= ws_ && kr < ws_ + 8 && kj >= cs && kj < cs + 16) sc += in[I_RPB][(((size_t)l * 4 + h) * 15 + (kr - r + 7)) * 31 + min(max(kj - j, -15), 15) + 15] * LOG2E; else sc = -1e30f; } }
                sh[k] = sc; mx = fmaxf(mx, sc); }
            red[tid] = mx; __syncthreads(); mx = -3e38f; for (int i = 0; i < 64; ++i) mx = fmaxf(mx, red[i]); __syncthreads();
            float sum = 0.f, o = 0.f;
            for (int k = k_lo; k < k_hi; ++k) { const float p = exp2f(sh[k] - mx); sum += p; o += p * bf2f(PROJ[(rowb + k) * LDP + vcol + tid]); }
            __syncthreads();
            if (map == 0) outv = o / sum; else out2 = o / sum;
        }
        if (mode == 1) { const float lam = MOD[131072 + l], li = 0.8f - 0.6f * expf(-0.3f * (float)l); const float v = outv - lam * out2; red[tid] = v * v; __syncthreads(); float ss = 0.f; for (int i = 0; i < 64; ++i) ss += red[i];
            outv = v / sqrtf(ss / 64.f + 1e-6f) * in[I_DNG][l * 64 + tid] * (1.f - li); }
        CB[s * 64 + tid] = outv;
    } else if (which == 12) {
        const unsigned hh = hsh(h1 + tid * 7919u); const int b = hh % NB, vh = (hh >> 4) % 10, d = (hh >> 8) & 63; int key = (hh >> 14) % TPB; if (tid & 1) key = SEQ + (key & 255);
        const int vcol = vh < 4 ? C_DV + 64 * vh : (vh < 8 ? C_NV + 64 * (vh - 4) : C_GV + 64 * (vh - 8));
        if (VT[(((size_t)b * 10 + vh) * 64 + d) * TPB + key] != PROJ[((size_t)b * TPB + key) * LDP + vcol + d]) { atomicAdd(CHK + 58, 1u); atomicOr(CHK + 59, (1u << vh) | (key >= SEQ ? 1024u : 2048u)); }
    } else if (which == 6) {
        if (tid != 0) return; const int nM = l == 0 ? T : NB * SEQ; int row = h1 % nM; if (l == 1) row = (row / SEQ) * TPB + row % SEQ; const int n = h2 % 1024; float tot = 0.f;
        for (int br = 0; br < 4; ++br) { float acc = 0.f;
            if (br == 0) { for (int g = 0; g < 4; ++g) for (int dp = 0; dp < 64; ++dp) { float y = 0.f; for (int c = 0; c < 64; ++c) y += bf2f(PROJ[(size_t)row * LDP + C_POOL + 64 * g + c]) * in[I_POOLW][(((size_t)l * 4 + g) * 64 + c) * 64 + dp];
                    acc += y * in[I_POOLS][l * 256 + 64 * g + dp] * in[I_WBR][(((size_t)l * 4 + 0) * 256 + 64 * g + dp) * D + n]; } }
            else { const int c0 = branch_col(br); for (int k = 0; k < 256; ++k) acc += bf2f(PROJ[(size_t)row * LDP + c0 + k]) * in[I_WBR][(((size_t)l * 4 + br) * 256 + k) * D + n]; }
            float gl = 0.f; for (int k = 0; k < 1024; ++k) gl += bf2f(PROJ[(size_t)row * LDP + C_H + k]) * in[I_WIN][((size_t)l * 1024 + k) * NIN + 2304 + br * 1024 + n];
            tot += acc / (1.f + expf(-gl)); }
        chk_put(CHK, id, fabsf(tot - bf2f(H[(size_t)row * D + n])));
    } else if (which == 7) {
        if (tid != 0 || l != 0) return; const int row = h1 % T, n = h2 % 1024, b = row / TPB, t = row % TPB; const bool ic = t >= SEQ; float acc = 0.f;
        for (int k = 0; k < 1024; ++k) acc += bf2f(H[(size_t)row * D + k]) * in[I_WOUT][((size_t)l * 1024 + k) * D + n];
        const size_t xo = ic ? ((size_t)b * CTXL + t - SEQ) * D + n : ((size_t)b * SEQ + t) * D + n;
        const float e = (ic ? in[I_CTX] : in[I_X])[xo] + MOD[((size_t)l * 9 + (ic ? 8 : b)) * 6144 + 2048 + n] * acc; chk_put(CHK, id, fabsf(e - (ic ? XCTX : args.out)[xo]));
    } else if (which == 8) {
        if (tid != 0) return; int row = h1 % T; if (l == 1) { row = h1 % (NB * SEQ); row = (row / SEQ) * TPB + row % SEQ; } const int b = row / TPB, t = row % TPB; const bool ic = t >= SEQ;
        const float* x = ic ? XCTX + ((size_t)b * CTXL + t - SEQ) * D : args.out + ((size_t)b * SEQ + t) * D; float ss = 0.f; for (int k = 0; k < 1024; ++k) ss += x[k] * x[k];
        const float r = 1.f / sqrtf(ss / 1024.f + 1e-6f); const float* m = MOD + ((size_t)l * 9 + (ic ? 8 : b)) * 6144; float* lg = red; for (int o = 0; o < 36; ++o) lg[o] = 0.f; float herr = 0.f;
        for (int k = 0; k < 1024; ++k) { const float hv = x[k] * r * in[I_GFFN][l * 1024 + k] * (1.f + m[4096 + k]) + m[3072 + k]; herr = fmaxf(herr, fabsf(hv - bf2f(H[(size_t)row * D + k])));
            for (int o = 0; o < 4; ++o) lg[o] += hv * in[I_WRG][((size_t)l * 1024 + k) * 4 + o]; for (int o = 0; o < 32; ++o) lg[4 + o] += hv * in[I_WRE][((size_t)l * 1024 + k) * 32 + o]; }
        for (int o = 0; o < 4; ++o) lg[o] += in[I_BRG][l * 4 + o]; for (int o = 0; o < 32; ++o) lg[4 + o] += in[I_BRE][l * 32 + o];
        int g = 0; for (int o = 1; o < 4; ++o) if (lg[o] > lg[g]) g = o; float gs = 0.f; for (int o = 0; o < 4; ++o) gs += expf(lg[o] - lg[g]);
        int i1 = 0; for (int j = 1; j < 8; ++j) if (lg[4 + g * 8 + j] > lg[4 + g * 8 + i1]) i1 = j; int i2 = -1; for (int j = 0; j < 8; ++j) if (j != i1 && (i2 < 0 || lg[4 + g * 8 + j] > lg[4 + g * 8 + i2])) i2 = j;
        const float v1 = lg[4 + g * 8 + i1], v2 = lg[4 + g * 8 + i2], e2 = expf(v2 - v1), w1 = 1.f / gs / (1.f + e2), w2 = 1.f / gs * e2 / (1.f + e2);
        const unsigned* ro = ROUTE + (size_t)row * 8; float err = herr;
        if (ro[0] != (unsigned)(g * 8 + i1) || ro[1] != (unsigned)(g * 8 + i2)) err = 10.f; else err = fmaxf(err, fmaxf(fabsf(w1 - __builtin_bit_cast(float, ro[4])), fabsf(w2 - __builtin_bit_cast(float, ro[5]))));
        chk_put(CHK, id, err);
    } else if (which == 9) {
        if (tid != 0) return; int row = h1 % T; if (l == 1) { row = h1 % (NB * SEQ); row = (row / SEQ) * TPB + row % SEQ; } const unsigned* ro = ROUTE + (size_t)row * 8; const unsigned* ctl = (const unsigned*)(ws + WS_CTL);
        int off = 0, ofa = 0, ofb = 0; for (int e = 0; e < 32; ++e) { const int c = (int)ctl[CW_CNT + l * 32 + e]; if (e == (int)ro[0]) ofa = off; if (e == (int)ro[1]) ofb = off; off += ((c + 255) >> 8) << 8; }
        float err = 0.f; if (ro[6] != ofa + ro[2] || ro[7] != ofb + ro[3] || ro[2] >= ctl[CW_CNT + l * 32 + ro[0]] || ro[3] >= ctl[CW_CNT + l * 32 + ro[1]]) err = 10.f;
        const bf16_t* S0 = PROJ; for (int k = 0; k < 1024; ++k) { if (S0[(size_t)ro[6] * D + k] != H[(size_t)row * D + k] || S0[(size_t)ro[7] * D + k] != H[(size_t)row * D + k]) err = 5.f; }
        if (ROWW[ro[6]] != __builtin_bit_cast(float, ro[4]) || ROWW[ro[7]] != __builtin_bit_cast(float, ro[5])) err = 3.f; chk_put(CHK, id, err);
    } else if (which == 10 || which == 11) {
        if (tid != 0) return; int row = h1 % T; if (l == 1) { row = h1 % (NB * SEQ); row = (row / SEQ) * TPB + row % SEQ; } const unsigned* ro = ROUTE + (size_t)row * 8; const int sl = h2 & 1; const int e = ro[sl], pos = ro[6 + sl];
        const bf16_t* HM = (const bf16_t*)(ws + WS_HMID);
        if (which == 10) { const int col = h3 % 512; float g = 0.f, u = 0.f; for (int k = 0; k < 1024; ++k) { const float a = bf2f(PROJ[(size_t)pos * D + k]); g += a * in[I_WEG][(((size_t)l * 32 + e) * 1024 + k) * 512 + col]; u += a * in[I_WEU][(((size_t)l * 32 + e) * 1024 + k) * 512 + col]; }
            chk_put(CHK, id, fabsf(g / (1.f + expf(-g)) * u - bf2f(HM[(size_t)pos * 512 + col]))); }
        else { const int n = h3 % 1024; float acc = 0.f; for (int k = 0; k < 512; ++k) acc += bf2f(HM[(size_t)pos * 512 + k]) * in[I_WED][(((size_t)l * 32 + e) * 512 + k) * 1024 + n];
            chk_put(CHK, id, fabsf(acc * __builtin_bit_cast(float, ro[4 + sl]) - bf2f(PROJ[(size_t)pos * D + n]))); }
    }
}
__global__ void chk_encode(Args args) {
    const unsigned* CHK = (const unsigned*)(args.ws + WS_CHK);
    const int order[24] = {0, 1, 2, 3, 12, 13, 5, 6, 7, 8, 9, 10, 11, 16 + 2, 16 + 3, 16 + 5, 16 + 12, 16 + 13, 16 + 6, 16 + 8, 16 + 9, 16 + 10, 16 + 11, -1};
    const float tol[14] = {1e-3f, 0.03f, 0.04f, 0.04f, 0.f, 0.03f, 0.04f, 0.02f, 0.02f, 0.5f, 0.04f, 0.04f, 0.03f, 0.03f};
    float k = 0.f;
    for (int r = 0; r < 24 && order[r] >= 0; ++r) { const float e = __builtin_bit_cast(float, CHK[order[r]]); if (e > tol[order[r] & 15]) { float dg = floorf(log10f(e) + 5.f); dg = fminf(fmaxf(dg, 1.f), 9.f); k = sqrtf(dg * powf(10.f, (float)(r + 2))); break; } }
    float k2 = 0.f;
    if (k == 0.f) return;
    for (size_t i = (size_t)blockIdx.x * blockDim.x + threadIdx.x; i < (size_t)NB * SEQ * D; i += (size_t)gridDim.x * blockDim.x) args.out[i] = (i == 12345 && k2 > 0.f) ? k2 : k;
}
#endif


extern "C" void kernel_launch(void* const* d_in, const int* in_sizes, int n_in, void* d_out, int out_size, void* d_ws, size_t ws_size, hipStream_t stream) {
    static int grid = 0;
    if (grid == 0) {
        if (n_in != 26 || ws_size < WS_END) { fprintf(stderr, "kernel_launch: need 26 inputs and %zu bytes of workspace (got %d, %zu)\n", (size_t)WS_END, n_in, ws_size); grid = -1; return; }
        int dev = 0, cus = 0, per_cu = 0;
        if (hipGetDevice(&dev) != hipSuccess || hipDeviceGetAttribute(&cus, hipDeviceAttributeMultiprocessorCount, dev) != hipSuccess) { grid = -1; return; }
        if (hipFuncSetAttribute((const void*)fwd_kernel, hipFuncAttributeMaxDynamicSharedMemorySize, LDS_BYTES) != hipSuccess) { fprintf(stderr, "kernel_launch: hipFuncSetAttribute failed\n"); grid = -1; return; }
        if (hipOccupancyMaxActiveBlocksPerMultiprocessor(&per_cu, (const void*)fwd_kernel, 512, LDS_BYTES) != hipSuccess || per_cu < 1) { fprintf(stderr, "kernel_launch: occupancy query says %d\n", per_cu); }
        (void)hipGetLastError();
        grid = cus;
    }
    if (grid < 0) return;
    (void)hipMemsetAsync((char*)d_ws + WS_CTL, 0, CTL_ZERO_BYTES, stream);
    Args a{};
    for (int i = 0; i < 26; ++i) a.in[i] = (const float*)d_in[i];
    a.out = (float*)d_out; a.ws = (unsigned char*)d_ws;
#if MK_MULTI
    for (int p = 0; p < N_PHASES; ++p) {
#if MK_CHECK
        const int lq = p == 0 ? 0 : (p - 1) / 11, ph = p == 0 ? -2 : (p - 1) % 11 - 1;
        if (p < 23 && ph == 3) hipLaunchKernelGGL(chk_kernel, dim3(192), dim3(64), 0, stream, a, 4, lq);
#endif
        a.ph_lo = p; a.ph_hi = p + 1; hipLaunchKernelGGL(fwd_kernel, dim3(grid), dim3(512), LDS_BYTES, stream, a);
#if MK_CHECK
        if (p == 0) hipLaunchKernelGGL(chk_kernel, dim3(256), dim3(64), 0, stream, a, 0, 0);
        if (p == 2) hipLaunchKernelGGL(chk_kernel, dim3(256), dim3(64), 0, stream, a, 1, 0);
        if (p < 23 && ph == 1) hipLaunchKernelGGL(chk_kernel, dim3(512), dim3(64), 0, stream, a, 2, lq);
        if (p < 23 && ph == 2) hipLaunchKernelGGL(chk_kernel, dim3(448), dim3(64), 0, stream, a, 3, lq);
        if (p < 23 && ph == 3) hipLaunchKernelGGL(chk_kernel, dim3(192), dim3(64), 0, stream, a, 5, lq);
        if (p == 5) hipLaunchKernelGGL(chk_kernel, dim3(1024), dim3(64), 0, stream, a, 12, 0);
        if (p < 23 && ph == 4) hipLaunchKernelGGL(chk_kernel, dim3(256), dim3(64), 0, stream, a, 6, lq);
        if (p < 23 && ph == 5) hipLaunchKernelGGL(chk_kernel, dim3(256), dim3(64), 0, stream, a, 7, lq);
        if (p < 23 && ph == 6) hipLaunchKernelGGL(chk_kernel, dim3(256), dim3(64), 0, stream, a, 8, lq);
        if (p < 23 && ph == 7) hipLaunchKernelGGL(chk_kernel, dim3(128), dim3(64), 0, stream, a, 9, lq);
        if (p < 23 && ph == 8) hipLaunchKernelGGL(chk_kernel, dim3(256), dim3(64), 0, stream, a, 10, lq);
        if (p < 23 && ph == 9) hipLaunchKernelGGL(chk_kernel, dim3(256), dim3(64), 0, stream, a, 11, lq);
#endif
    }
#if MK_CHECK
    hipLaunchKernelGGL(chk_encode, dim3(1024), dim3(256), 0, stream, a);
#endif
#else
    a.ph_lo = 0; a.ph_hi = N_PHASES;
    hipLaunchKernelGGL(fwd_kernel, dim3(grid), dim3(512), LDS_BYTES, stream, a);
#endif
}
```

```cpp
#include <hip/hip_runtime.h>
#include <cstdint>
#include <cstdio>

#ifndef MK_CHECK
#define MK_CHECK 0
#endif
#ifndef MK_CHK_MODE
#define MK_CHK_MODE 0
#endif
#ifndef MK_STAMP
#define MK_STAMP 0
#endif
#ifndef MK_STAMP_A
#define MK_STAMP_A 0
#define MK_STAMP_B 0
#endif
#ifndef MK_MULTI
#define MK_MULTI 0
#endif

#define GAS __attribute__((address_space(1)))
#define LAS __attribute__((address_space(3)))
typedef unsigned short bf16_t;
typedef short bf16x8 __attribute__((ext_vector_type(8)));
typedef float f32x4 __attribute__((ext_vector_type(4)));
typedef float f32x2 __attribute__((ext_vector_type(2)));
typedef float f32x16 __attribute__((ext_vector_type(16)));
typedef unsigned u32x4 __attribute__((ext_vector_type(4)));
typedef unsigned u32x2 __attribute__((ext_vector_type(2)));

constexpr int D = 1024, NB = 8, SEQ = 4096, CTXL = 256, TPB = SEQ + CTXL  , T = NB * TPB  ;
constexpr int LDP = 3584;
constexpr int NGATE = 4096, NIN = 6400;
constexpr int C_DQ = 256, C_DK = 512, C_DV = 768, C_NQ = 1024, C_NK = 1280, C_NV = 1536, C_GQ = 1792, C_GK = 2048, C_GV = 2176, C_POOL = 2304, C_H = 2560;
constexpr int NEXP = 32, DEXP = 512;
constexpr int MPAD = 77824;
constexpr float RMS_EPS = 1e-6f;
constexpr float LOG2E = 1.4426950408889634f;

constexpr size_t MiB = 1u << 20;
constexpr size_t WS_CTL = 0, CTL_ZERO_BYTES = 1 * MiB;
constexpr size_t WS_MOD = 1 * MiB;
constexpr size_t WS_ROUTE = 2 * MiB;
constexpr size_t WS_ROWW = 4 * MiB;
constexpr size_t WS_XCTX = 5 * MiB;
constexpr size_t WS_WIN = 13 * MiB;
constexpr size_t WS_WOUT = 38 * MiB;
constexpr size_t WS_WBR = 42 * MiB;
constexpr size_t WS_H = 58 * MiB;
constexpr size_t WS_PROJ = 126 * MiB;
constexpr size_t WS_X2 = 364 * MiB;
constexpr size_t WS_VT = 536 * MiB;
constexpr size_t WS_END = 624 * MiB;
constexpr size_t WS_DT = WS_X2, WS_HMID = WS_X2 + 32 * MiB, WS_GUT = WS_X2 + 108 * MiB;
constexpr size_t WS_SLAB = WS_VT + 43 * MiB;
constexpr size_t WS_PRIV = WS_SLAB + 16 * MiB;
constexpr size_t WS_Y = WS_GUT;
static_assert((size_t)T * LDP * 2 <= WS_X2 - WS_PROJ && (size_t)MPAD * 1024 * 2 <= WS_X2 - WS_PROJ, "proj region");
static_assert(108 * MiB + 64 * MiB == WS_VT - WS_X2 && WS_Y + (size_t)MPAD * 1024 * 2 <= WS_END, "x2 / y region");
static_assert((size_t)NB * 10 * 64 * TPB * 2 <= WS_END - WS_VT, "vt region");
constexpr int CW_BAR = 1024;
constexpr int CW_CNT = 8192;
constexpr int CW_Q = 8448;
constexpr int CW_XQ = 16384;

constexpr int RING_BYTES = 131072;
constexpr int LDS_MISC = 155648;
constexpr int LDS_BYTES = 159744;
constexpr int LDS_TILE_E = LDS_MISC + 512;
static_assert(LDS_TILE_E + 320 * 4 <= LDS_BYTES, "lds map");

#define RLX_AGENT __ATOMIC_RELAXED, __HIP_MEMORY_SCOPE_AGENT
__device__ __forceinline__ unsigned f2bf(float f) { unsigned u = __builtin_bit_cast(unsigned, f); return (u + 0x7fffu + ((u >> 16) & 1u)) >> 16; }
__device__ __forceinline__ unsigned pk2(float lo, float hi) { return f2bf(lo) | (f2bf(hi) << 16); }
__device__ __forceinline__ float bflo(unsigned w) { return __builtin_bit_cast(float, w << 16); }
__device__ __forceinline__ float bfhi(unsigned w) { return __builtin_bit_cast(float, w & 0xffff0000u); }
__device__ __forceinline__ float bf2f(bf16_t h) { return __builtin_bit_cast(float, (unsigned)h << 16); }
typedef __bf16 bf16x2_t __attribute__((ext_vector_type(2)));
__device__ __forceinline__ unsigned cvt_pk_bf16(float lo, float hi) { f32x2 v = {lo, hi}; bf16x2_t b = __builtin_convertvector(v, bf16x2_t); return __builtin_bit_cast(unsigned, b); }
template <int CTRL, int ROWM = 0xf> __device__ __forceinline__ float dpp_f(float v) { return __builtin_bit_cast(float, __builtin_amdgcn_update_dpp(0, __builtin_bit_cast(int, v), CTRL, ROWM, 0xf, false)); }
template <int M> __device__ __forceinline__ float swz_xor(float v) {
    static_assert(M == 1 || M == 2, "quad permutes only");
    return M == 1 ? dpp_f<0xB1>(v) : dpp_f<0x4E>(v);
}
__device__ __forceinline__ float sum8(float v) { v += dpp_f<0xB1>(v); v += dpp_f<0x4E>(v); v += dpp_f<0x141>(v); return v; }
__device__ __forceinline__ void plswap32(float& a, float& b) { asm volatile("s_nop 1\n\tv_permlane32_swap_b32 %0, %1\n\ts_nop 1" : "+v"(a), "+v"(b)); }
__device__ __forceinline__ float half_sum(float v) { float a = v, b = v; plswap32(a, b); return a + b; }
__device__ __forceinline__ float half_max(float v) { float a = v, b = v; plswap32(a, b); return fmaxf(a, b); }
__device__ __forceinline__ float wave_sum(float v) {
    v = sum8(v); v += dpp_f<0x140>(v);
    v += __builtin_bit_cast(float, __builtin_amdgcn_update_dpp(0, __builtin_bit_cast(int, v), 0x142, 0xa, 0xf, true));
    v += __builtin_bit_cast(float, __builtin_amdgcn_update_dpp(0, __builtin_bit_cast(int, v), 0x143, 0xc, 0xf, true));
    return __builtin_bit_cast(float, __builtin_amdgcn_readlane(__builtin_bit_cast(int, v), 63));
}
__device__ __forceinline__ float fast_exp2(float x) { return __builtin_amdgcn_exp2f(x); }
__device__ __forceinline__ float fast_rcp(float x) { return __builtin_amdgcn_rcpf(x); }
__device__ __forceinline__ float sigmoidf_(float x) { return fast_rcp(1.0f + fast_exp2(-x * LOG2E)); }

#define XB_TMO      128
#define XB_XCNT(j)  (256  + 64 * (j))
#define XB_XSUB(j)  (1280 + 64 * (j))
#define XB_XGEN(j)  (2304 + 64 * (j))
#define XB_TOP      3328
#define XB_TOPGEN   3392
#define XCD_BAR_WORDS 3456
#define XB_SPIN_CAP (1u << 20)
__device__ __forceinline__ unsigned xb_ld(unsigned* p)              { return __hip_atomic_load(p, __ATOMIC_RELAXED, __HIP_MEMORY_SCOPE_AGENT); }
__device__ __forceinline__ unsigned xb_add(unsigned* p, unsigned v) { return __hip_atomic_fetch_add(p, v, __ATOMIC_RELAXED, __HIP_MEMORY_SCOPE_AGENT); }
__device__ __forceinline__ unsigned xb_xcc_id() { return (unsigned)__builtin_amdgcn_s_getreg((3 << 11) | 20) & 0xFu; }
#define XB_SPIN(cond, bar) do { unsigned _sp = 0; while (cond) { __builtin_amdgcn_s_sleep(1); \
    if ((++_sp & 255u) == 0u) { if (xb_ld(&(bar)[XB_TMO])) break; if (_sp > XB_SPIN_CAP) { atomicAdd(&(bar)[XB_TMO], 1u); break; } } } } while (0)
struct XcdBarrier { unsigned* bar; unsigned x; volatile LAS unsigned* st; };
__device__ __forceinline__ XcdBarrier xcd_barrier_post(unsigned* bar, volatile LAS unsigned* st) {
    XcdBarrier b; b.bar = bar; b.x = xb_xcc_id(); b.st = st;
    if (threadIdx.x == 0) (void)xb_add(&bar[XB_XCNT(b.x)], 1u);
    return b;
}
__device__ __forceinline__ void xcd_barrier_complete(unsigned* bar, unsigned x, unsigned& nloc, unsigned& nx) {
    const unsigned G = gridDim.x * gridDim.y * gridDim.z;
    unsigned sum, cnt, mine, sp = 0u;
    for (;;) {
        sum = 0u; cnt = 0u; mine = 0u;
#pragma unroll
        for (unsigned j = 0; j < 16; ++j) { const unsigned c = xb_ld(&bar[XB_XCNT(j)]); sum += c; cnt += (c > 0u) ? 1u : 0u; mine = (j == x) ? c : mine; }
        if (sum == G) break;
        __builtin_amdgcn_s_sleep(1);
        if ((++sp & 255u) == 0u) { if (xb_ld(&bar[XB_TMO])) break; if (sp > XB_SPIN_CAP) { atomicAdd(&bar[XB_TMO], 1u); break; } }
    }
    nloc = mine > 0u ? mine : 1u; nx = cnt > 0u ? cnt : 1u;
}
__device__ __forceinline__ void xcd_barrier(const XcdBarrier& b) {
    asm volatile("s_waitcnt vmcnt(0)" ::: "memory");
    __syncthreads();
    if (threadIdx.x == 0) {
        unsigned* bar = b.bar;
        __builtin_amdgcn_s_waitcnt(0);
        unsigned nloc = b.st[0], nx = b.st[1];
        if (nloc == 0u) { xcd_barrier_complete(bar, b.x, nloc, nx); b.st[0] = nloc; b.st[1] = nx; }
        const unsigned old = xb_add(&bar[XB_XSUB(b.x)], 1u);
        const unsigned gen = old / nloc;
        if (old + 1u == (gen + 1u) * nloc) {
            __builtin_amdgcn_fence(__ATOMIC_RELEASE, "agent");
            asm volatile("s_waitcnt vmcnt(0)" ::: "memory");
            const unsigned og = xb_add(&bar[XB_TOP], 1u);
            const unsigned tg = og / nx;
            if (og + 1u == (tg + 1u) * nx) xb_add(&bar[XB_TOPGEN], 1u);
            else XB_SPIN(xb_ld(&bar[XB_TOPGEN]) == tg, bar);
            __builtin_amdgcn_fence(__ATOMIC_ACQUIRE, "agent");
            xb_add(&bar[XB_XGEN(b.x)], 1u);
            asm volatile("s_waitcnt vmcnt(0)" ::: "memory");
        } else {
            XB_SPIN(xb_ld(&bar[XB_XGEN(b.x)]) == gen, bar);
            __builtin_amdgcn_fence(__ATOMIC_ACQUIRE, "agent");
            asm volatile("s_waitcnt vmcnt(0)" ::: "memory");
        }
    }
    __syncthreads();
}

namespace pg8 {
constexpr int BM = 256, BK = 64, HALF = 128, HTB = HALF * BK * 2, STAGE_BYTES = 8 * HTB, NXCD = 8, WGM = 8;
__host__ __device__ __forceinline__ int lds_byte(int r, int c) { const int st = (r >> 4) * 2 + (c >> 5), rr = r & 15, cc = c & 31, ob = rr * 64 + cc * 2; return st * 1024 + (ob ^ (((ob >> 9) & 1) << 5)); }
__host__ __device__ __forceinline__ void stage_rc(int b, int& R, int& C) { const int st = b / 1024, sb = b % 1024, swz = sb ^ (((sb >> 9) & 1) << 5); R = (st >> 1) * 16 + swz / 64; C = (st & 1) * 32 + (swz % 64) / 2; }
__host__ __device__ __forceinline__ int perm32(int rho) { const int n = rho >> 4, i = rho & 15; return 8 * (i >> 2) + 4 * n + (i & 3); }

struct Unit { int pm, pn, aux, nt; const char* A; const char* B; };
struct Gemm { int lda, ldb; };

__device__ __forceinline__ bool tile_order(int nM, int nN, int G, int c, int i, int& pm, int& pn) {
    const int nwg = nM * nN; const long L = (long)i * G + c; if (L >= nwg) return false;
    int wgid = (int)L; { const int q = nwg / NXCD, r = nwg % NXCD, xcd = wgid % NXCD, off = wgid / NXCD; wgid = (xcd < r ? xcd * (q + 1) : r * (q + 1) + (xcd - r) * q) + off; }
    const int nig = WGM * nN, gid = wgid / nig, fm = gid * WGM, gsz = (nM - fm) < WGM ? (nM - fm) : WGM;
    pm = fm + ((wgid % nig) % gsz); pn = (wgid % nig) / gsz; return true;
}

template <class Epi, class Sched, bool ALIGN_EPI, bool GATHER = false>
__device__ __forceinline__ void gemm_phase(LAS unsigned char* lds, const Gemm g, const Sched& S, const Epi& E, const char* Abase = nullptr, const LAS int* rm = nullptr) {
    int tid_ = threadIdx.x; asm volatile("" : "+v"(tid_));
    const int tid = tid_, wid = __builtin_amdgcn_readfirstlane(tid >> 6), lane = tid & 63, wr = wid >> 2, wc = wid & 3, fr = lane & 15, fq = lane >> 4;
    unsigned voffA[2], voffB[2];
#pragma unroll
    for (int i = 0; i < 2; ++i) { int R, C; stage_rc(tid * 16 + i * 8192, R, C); const int Rb = (R & ~31) + perm32(R & 31);
        voffA[i] = (unsigned)(R * g.lda + C * 2); voffB[i] = (unsigned)(Rb * g.ldb + C * 2); }
    const size_t kstep = (size_t)(BK * 2);
    const size_t hsA = (size_t)HALF * g.lda, hsB = (size_t)HALF * g.ldb;
    int rIdx[2], cOff[2];
#pragma unroll
    for (int i = 0; i < 2; ++i) { int R, C; stage_rc(tid * 16 + i * 8192, R, C); rIdx[i] = R; cOff[i] = C * 2; }
    unsigned vgc[2][2], vgn[2][2];
    auto load_vg = [&](unsigned (&v)[2][2], int unit_i) {
#pragma unroll
        for (int h = 0; h < 2; ++h)
#pragma unroll
            for (int i = 0; i < 2; ++i) v[h][i] = (unsigned)rm[unit_i * 256 + h * 128 + rIdx[i]] * (unsigned)g.lda + (unsigned)cOff[i]; };
    const unsigned ldsw = (unsigned)wid * 1024u;
    const int aoff = lds_byte(wr * 64 + fr, fq * 8), boff = lds_byte(wc * 32 + fr, fq * 8);
#define PG8_SA(b, h) (((b) * 2 + (h)) * HTB)
#define PG8_SB(b, h) ((4 + (b) * 2 + (h)) * HTB)
#define PG8_STAGE(bufoff, gbase, voff) do { _Pragma("unroll") for (int _i = 0; _i < 2; ++_i) \
        __builtin_amdgcn_global_load_lds((const unsigned*)((const char*)(gbase) + (voff)[_i]), (LAS unsigned*)(lds + (bufoff) + ldsw + _i * 8192), 16, 0, 0); } while (0)
#define PG8_STAGE_A(bufoff, gptr, kt, h, nx) do { if constexpr (GATHER) { _Pragma("unroll") for (int _i = 0; _i < 2; ++_i) \
        __builtin_amdgcn_global_load_lds((const unsigned*)(Abase + (size_t)(kt) * kstep + ((nx) ? vgn[h][_i] : vgc[h][_i])), (LAS unsigned*)(lds + (bufoff) + ldsw + _i * 8192), 16, 0, 0); } \
        else { PG8_STAGE(bufoff, gptr, voffA); } } while (0)
#define PG8_LDA(dst, b, h) do { _Pragma("unroll") for (int m = 0; m < 4; ++m) _Pragma("unroll") for (int k = 0; k < 2; ++k) dst[m][k] = *(const LAS bf16x8*)(lds + PG8_SA(b, h) + aoff + m * 2048 + k * 1024); } while (0)
#define PG8_LDB(dst, b, h) do { _Pragma("unroll") for (int n = 0; n < 2; ++n) _Pragma("unroll") for (int k = 0; k < 2; ++k) dst[n][k] = *(const LAS bf16x8*)(lds + PG8_SB(b, h) + boff + n * 2048 + k * 1024); } while (0)
#define PG8_MMA(ai, bj, At, Bt) do { __builtin_amdgcn_s_setprio(1); _Pragma("unroll") for (int m = 0; m < 4; ++m) _Pragma("unroll") for (int n = 0; n < 2; ++n) _Pragma("unroll") for (int k = 0; k < 2; ++k) \
        acc[ai][bj][m][n] = __builtin_amdgcn_mfma_f32_16x16x32_bf16(Bt[n][k], At[m][k], acc[ai][bj][m][n], 0, 0, 0); __builtin_amdgcn_s_setprio(0); } while (0)
#define PG8_WAIT_V(n) asm volatile("s_waitcnt vmcnt(" #n ")" ::: "memory")
#define PG8_WAIT_L(n) asm volatile("s_waitcnt lgkmcnt(" #n ")" ::: "memory")
#define PG8_BAR __builtin_amdgcn_s_barrier()
#define PG8_SCHED __builtin_amdgcn_sched_barrier(0)
    Unit cur, nxt; int ui = 0;
    if (!S.next(0, cur)) return;
    f32x4 acc[2][2][4][2];
#pragma unroll
    for (int a = 0; a < 2; ++a)
#pragma unroll
        for (int b = 0; b < 2; ++b)
#pragma unroll
            for (int m = 0; m < 4; ++m)
#pragma unroll
                for (int n = 0; n < 2; ++n) acc[a][b][m][n] = (f32x4){0.f, 0.f, 0.f, 0.f};
    bf16x8 At[4][2], B0[2][2], B1[2][2];
    const char* cA = cur.A; const char* cB = cur.B;
    if constexpr (GATHER) load_vg(vgc, 0);
    PG8_STAGE(PG8_SB(0, 0), cB, voffB); PG8_STAGE(PG8_SB(0, 1), cB + hsB, voffB); PG8_STAGE_A(PG8_SA(0, 0), cA, 0, 0, false); PG8_STAGE_A(PG8_SA(0, 1), cA + hsA, 0, 1, false);
    if (wr == 1) PG8_BAR;
    PG8_WAIT_V(2); PG8_BAR;
    PG8_STAGE(PG8_SB(1, 0), cB + kstep, voffB); PG8_STAGE_A(PG8_SA(1, 0), cA + kstep, 1, 0, false); PG8_STAGE(PG8_SB(1, 1), cB + hsB + kstep, voffB);
    PG8_WAIT_V(6); PG8_BAR;
    for (;;) {
        const bool has_next = S.next(ui + 1, nxt);
        const int nt = cur.nt;
        if constexpr (GATHER) { if (has_next) load_vg(vgn, ui + 1); else { vgn[0][0] = vgc[0][0]; vgn[0][1] = vgc[0][1]; vgn[1][0] = vgc[1][0]; vgn[1][1] = vgc[1][1]; } }
        const char* nA = has_next ? nxt.A : cA; const char* nB = has_next ? nxt.B : cB;
        for (int t = 0; t < nt; t += 2) {
            const bool last = (t == nt - 2);
            const char* a1 = cA + (size_t)(t + 1) * kstep;
            const char* a2 = last ? nA : cA + (size_t)(t + 2) * kstep; const char* b2 = last ? nB : cB + (size_t)(t + 2) * kstep;
            const char* a3 = a2 + kstep; const char* b3 = b2 + kstep;
            PG8_LDB(B0, 0, 0); PG8_LDB(B1, 0, 1); PG8_SCHED; PG8_LDA(At, 0, 0); PG8_STAGE_A(PG8_SA(1, 1), a1 + hsA, t + 1, 1, false);
            PG8_WAIT_V(8); PG8_WAIT_L(0); PG8_BAR; PG8_MMA(0, 0, At, B0); PG8_MMA(0, 1, At, B1); PG8_BAR; PG8_SCHED;
            PG8_LDA(At, 0, 1); PG8_STAGE(PG8_SB(0, 0), b2, voffB); PG8_STAGE(PG8_SB(0, 1), b2 + hsB, voffB); PG8_STAGE_A(PG8_SA(0, 0), a2, (last ? 0 : t + 2), 0, last);
            PG8_WAIT_V(8); PG8_WAIT_L(0); PG8_BAR; PG8_MMA(1, 0, At, B0); PG8_MMA(1, 1, At, B1); PG8_BAR; PG8_SCHED;
            PG8_LDB(B0, 1, 0); PG8_LDB(B1, 1, 1); PG8_SCHED; PG8_LDA(At, 1, 0); PG8_STAGE_A(PG8_SA(0, 1), a2 + hsA, (last ? 0 : t + 2), 1, last);
            PG8_WAIT_V(8); PG8_WAIT_L(0); PG8_BAR; PG8_MMA(0, 0, At, B0); PG8_MMA(0, 1, At, B1); PG8_BAR; PG8_SCHED;
            PG8_LDA(At, 1, 1); PG8_STAGE(PG8_SB(1, 0), b3, voffB); PG8_STAGE(PG8_SB(1, 1), b3 + hsB, voffB); PG8_STAGE_A(PG8_SA(1, 0), a3, (last ? 1 : t + 3), 0, last);
            PG8_WAIT_V(8); PG8_WAIT_L(0); PG8_BAR; PG8_MMA(1, 0, At, B0); PG8_MMA(1, 1, At, B1); PG8_BAR; PG8_SCHED;
        }
        if constexpr (ALIGN_EPI) { if (wr == 0) PG8_BAR; }
        E(acc, cur, wr, wc, fr, fq);
        if (!has_next) break;
#pragma unroll
        for (int a = 0; a < 2; ++a)
#pragma unroll
            for (int b = 0; b < 2; ++b)
#pragma unroll
                for (int m = 0; m < 4; ++m)
#pragma unroll
                    for (int n = 0; n < 2; ++n) acc[a][b][m][n] = (f32x4){0.f, 0.f, 0.f, 0.f};
        cur = nxt; cA = nA; cB = nB; ++ui;
        if constexpr (GATHER) { vgc[0][0] = vgn[0][0]; vgc[0][1] = vgn[0][1]; vgc[1][0] = vgn[1][0]; vgc[1][1] = vgn[1][1]; }
        if constexpr (ALIGN_EPI) { if (wr == 1) PG8_BAR; }
    }
    PG8_WAIT_V(0);
    if constexpr (!ALIGN_EPI) { if (wr == 0) PG8_BAR; }
    PG8_BAR;
#undef PG8_SA
#undef PG8_SB
#undef PG8_STAGE
#undef PG8_STAGE_A
#undef PG8_LDA
#undef PG8_LDB
#undef PG8_MMA
#undef PG8_WAIT_V
#undef PG8_WAIT_L
#undef PG8_BAR
#undef PG8_SCHED
}
}

struct Args {
    const float* in[26];
    float* out; unsigned char* ws;
    int ph_lo, ph_hi;
};
struct Frame {
    LAS unsigned char* lds;
    unsigned char* ws; float* out;
    int tid, lane, wave, vcu, G, bx;
};
__device__ __forceinline__ const float* inptr(int i) {
    const __attribute__((address_space(4))) unsigned char* kp = (const __attribute__((address_space(4))) unsigned char*)__builtin_amdgcn_kernarg_segment_ptr();
    asm volatile("" : "+s"(kp));
    return *(const float* const __attribute__((address_space(4)))*)(kp + 8 * i);
}
__device__ __forceinline__ Frame launder(const Frame& F) {
    Frame P = F; int t = F.tid; unsigned char* w = F.ws; float* o = F.out; int g = F.G, v = F.vcu, wv = F.wave, bx = F.bx;
    asm volatile("" : "+v"(t), "+s"(w), "+s"(o), "+s"(g), "+s"(v), "+s"(wv), "+s"(bx));
    P.tid = t; P.lane = t & 63; P.ws = w; P.out = o; P.G = g; P.vcu = v; P.wave = wv; P.bx = bx; return P;
}
enum { I_X = 0, I_C, I_CTX, I_CCTX, I_WMOD, I_BMOD, I_GMIX, I_GFFN, I_WIN, I_POOLW, I_POOLS, I_DLAM, I_DNG, I_RPB, I_QN, I_KN, I_WBR, I_WOUT, I_WRG, I_BRG, I_WRE, I_BRE, I_WEG, I_WEU, I_WED, I_GFIN };
#define WSF(off) ((float*)(F.ws + (off)))
#define WSB(off) ((bf16_t*)(F.ws + (off)))
#define WSU(off) ((unsigned*)(F.ws + (off)))

template <class RowMap>
__device__ __forceinline__ void transpose_item(const float* W, int K, int N, bf16_t* WT, int ldt, LAS float* scr, int item, int lane, const RowMap& rm) {
    const int nblk = N / 32, kb = item / nblk, nb = item % nblk, k0 = 64 * kb, n0 = 32 * nb;
#pragma unroll 8
    for (int i = 0; i < 32; ++i) { const int kk = 2 * i + (lane >> 5); scr[kk * 33 + (lane & 31)] = __builtin_nontemporal_load(W + (size_t)(k0 + kk) * N + n0 + (lane & 31)); }
    asm volatile("s_waitcnt lgkmcnt(0)" ::: "memory");
    const int c = lane & 7;
#pragma unroll
    for (int j = 0; j < 4; ++j) { const int n = (lane >> 3) + 8 * j; const LAS float* s = scr + (8 * c) * 33 + n;
        u32x4 o; o.x = pk2(s[0 * 33], s[1 * 33]); o.y = pk2(s[2 * 33], s[3 * 33]); o.z = pk2(s[4 * 33], s[5 * 33]); o.w = pk2(s[6 * 33], s[7 * 33]);
        *(u32x4*)(WT + (size_t)rm(n0 + n) * ldt + k0 + 8 * c) = o; }
    asm volatile("s_waitcnt lgkmcnt(0)" ::: "memory");
}
struct RowId { __device__ __forceinline__ int operator()(int n) const { return n; } };
struct RowGU { int up; __device__ __forceinline__ int operator()(int n) const { return 256 * (n >> 7) + 128 * up + (n & 127); } };

__device__ __forceinline__ void p0_prologue(Frame& F, int part) {
    LAS float* scr = (LAS float*)(F.lds + F.wave * 16384);
    const int gw = F.vcu * 8 + F.wave, NGW = F.G * 8;
    const float *w_in = inptr(I_WIN), *w_out = inptr(I_WOUT), *w_branch = inptr(I_WBR), *pool_w = inptr(I_POOLW), *pool_scale = inptr(I_POOLS);
    bf16_t *WIN = WSB(WS_WIN), *WOUT = WSB(WS_WOUT), *WBR = WSB(WS_WBR); float* MOD = WSF(WS_MOD);
    if (part == 1) {
    constexpr int I_IN = 16 * 200, I_OUT = 16 * 32, I_BR = 4 * 32;
    constexpr int PER_L = I_IN + I_OUT + 3 * I_BR, NITEMS = 2 * PER_L;
    for (int it = gw; it < NITEMS; it += NGW) {
        const int l = it / PER_L; int r = it % PER_L;
        if (r < I_IN) { transpose_item(w_in + (size_t)l * D * NIN, D, NIN, WIN + (size_t)l * NIN * D, D, scr, r, F.lane, RowId{}); continue; } r -= I_IN;
        if (r < I_OUT) { transpose_item(w_out + (size_t)l * D * D, D, D, WOUT + (size_t)l * D * D, D, scr, r, F.lane, RowId{}); continue; } r -= I_OUT;
        const int br = 1 + r / I_BR; r %= I_BR;
        transpose_item(w_branch + ((size_t)l * 4 + br) * 256 * D, 256, D, WBR + ((size_t)l * 4 + br) * D * D, D, scr, r, F.lane, RowId{});
    }
    for (int it = gw; it < 2 * 4 * 16 * 8; it += NGW) {
        const int l = it >> 9, g = (it >> 7) & 3, n = ((it >> 3) & 15) * 64 + F.lane, c8 = it & 7;
        const float* pw = pool_w + (size_t)(l * 4 + g) * 4096 + c8 * 8 * 64;
        const float* ps = pool_scale + l * 256 + 64 * g;
        const float* wb = w_branch + ((size_t)(l * 4 + 0) * 256 + 64 * g) * D + n;
        float o[8];
#pragma unroll
        for (int cc = 0; cc < 8; ++cc) o[cc] = 0.f;
#pragma unroll 4
        for (int cp = 0; cp < 64; ++cp) { const float w = ps[cp] * wb[(size_t)cp * D];
#pragma unroll
            for (int cc = 0; cc < 8; ++cc) o[cc] += pw[cc * 64 + cp] * w; }
        u32x4 w; w.x = pk2(o[0], o[1]); w.y = pk2(o[2], o[3]); w.z = pk2(o[4], o[5]); w.w = pk2(o[6], o[7]);
        *(u32x4*)(WBR + ((size_t)l * 4 + 0) * D * D + (size_t)n * D + 64 * g + c8 * 8) = w;
    }
    return; }
    if (F.vcu < 192) {
        const float *cvec = inptr(I_C), *c_ctx = inptr(I_CCTX), *w_mod = inptr(I_WMOD), *b_mod = inptr(I_BMOD);
        __syncthreads();
        LAS float* sv = (LAS float*)(F.lds);
        LAS float* part = (LAS float*)(F.lds + 65536);
        for (int i = F.tid; i < 9 * 1024; i += 512) { const int bb = i >> 10, k = i & 1023; const float v = bb < 8 ? cvec[bb * 1024 + k] : c_ctx[k]; sv[i] = v / (1.0f + __expf(-v)); }
        __syncthreads();
        const int l = F.vcu / 96, j = (F.vcu % 96) * 64 + F.lane;
        float acc[9];
#pragma unroll
        for (int bb = 0; bb < 9; ++bb) acc[bb] = 0.f;
        const float* wm = w_mod + (size_t)l * D * 6144 + j;
        for (int k0 = F.wave * 128; k0 < F.wave * 128 + 128; k0 += 16) { float w[16];
#pragma unroll
            for (int u = 0; u < 16; ++u) w[u] = __builtin_nontemporal_load(wm + (size_t)(k0 + u) * 6144);
#pragma unroll
            for (int u = 0; u < 16; ++u)
#pragma unroll
                for (int bb = 0; bb < 9; ++bb) acc[bb] += sv[bb * 1024 + k0 + u] * w[u]; }
#pragma unroll
        for (int bb = 0; bb < 9; ++bb) part[(F.wave * 9 + bb) * 64 + F.lane] = acc[bb];
        __syncthreads();
        for (int i = F.tid; i < 9 * 64; i += 512) { const int bb = i >> 6, jj = i & 63; float s = 0.f;
#pragma unroll
            for (int w = 0; w < 8; ++w) s += part[(w * 9 + bb) * 64 + jj];
            const int col = (F.vcu % 96) * 64 + jj;
            MOD[((size_t)l * 9 + bb) * 6144 + col] = s + b_mod[l * 6144 + col]; }
        __syncthreads();
    }
    if (F.vcu == 200 && F.tid < 2) {
        const float* diff_lambda = inptr(I_DLAM);
        const int l = F.tid; const float* lf = diff_lambda + l * 128; float s0 = 0.f, s1 = 0.f;
        for (int i = 0; i < 32; ++i) { s0 += lf[i] * lf[32 + i]; s1 += lf[64 + i] * lf[96 + i]; }
        const float lam_init = 0.8f - 0.6f * expf(-0.3f * (float)l);
        MOD[131072 + l] = expf(s0) - expf(s1) + lam_init;
    }
}

__device__ __forceinline__ void phase_modulate(Frame& F, int l, int part) {
    const int gw = F.vcu * 8 + F.wave, NGW = F.G * 8;
    const float *xin = inptr(I_X), *ctxin = inptr(I_CTX), *g_mix = inptr(I_GMIX), *g_final = inptr(I_GFIN);
    float *MOD = WSF(WS_MOD), *XCTX = WSF(WS_XCTX); unsigned* ROUTE = WSU(WS_ROUTE); bf16_t *Y = WSB(WS_Y), *PROJ = WSB(WS_PROJ);
    const bool comb = (l > 0) && (part != 2);
    for (int row0 = gw; row0 < T; row0 += 2 * NGW) {
        f32x4 v[2][4]; bool ok[2]; float* xr[2]; u32x2 pp[2]; u32x2 ya[2][4], yb[2][4];
#pragma unroll
        for (int q = 0; q < 2; ++q) {
            const int row = row0 + q * NGW; ok[q] = row < T; xr[q] = nullptr; pp[q] = (u32x2){0u, 0u};
            if (ok[q]) { const int b = row / TPB, t = row % TPB; const bool isctx = t >= SEQ;
                if (isctx && l == 2) { ok[q] = false; }
                else {
                    const float* src0 = (l == 0) ? (isctx ? ctxin + ((size_t)b * CTXL + (t - SEQ)) * D : xin + ((size_t)b * SEQ + t) * D)
                                                 : (isctx ? XCTX + ((size_t)b * CTXL + (t - SEQ)) * D : F.out + ((size_t)b * SEQ + t) * D);
                    xr[q] = const_cast<float*>(src0);
                    const f32x4* src = (const f32x4*)src0 + F.lane;
#pragma unroll
                    for (int j = 0; j < 4; ++j) v[q][j] = src[64 * j];
                    if (comb) pp[q] = *(const u32x2*)(ROUTE + (size_t)row * 8 + 6);
                } }
        }
        if (comb) {
#pragma unroll
            for (int q = 0; q < 2; ++q) if (ok[q]) {
                const u32x2* y0 = (const u32x2*)(Y + (size_t)pp[q].x * D) + F.lane; const u32x2* y1 = (const u32x2*)(Y + (size_t)pp[q].y * D) + F.lane;
#pragma unroll
                for (int j = 0; j < 4; ++j) { ya[q][j] = y0[64 * j]; yb[q][j] = y1[64 * j]; } }
        }
#pragma unroll
        for (int q = 0; q < 2; ++q) if (ok[q]) {
            const int row = row0 + q * NGW; const int b = row / TPB, t = row % TPB; const bool isctx = t >= SEQ; const int mb = isctx ? 8 : b;
            if (comb) {
                const f32x4* gt = (const f32x4*)(MOD + ((size_t)(l - 1) * 9 + mb) * 6144 + 5 * 1024) + F.lane;
#pragma unroll
                for (int j = 0; j < 4; ++j) { const u32x2 a = ya[q][j], c2 = yb[q][j]; const f32x4 g = gt[64 * j];
                    v[q][j].x += g.x * (bflo(a.x) + bflo(c2.x)); v[q][j].y += g.y * (bfhi(a.x) + bfhi(c2.x)); v[q][j].z += g.z * (bflo(a.y) + bflo(c2.y)); v[q][j].w += g.w * (bfhi(a.y) + bfhi(c2.y)); }
                if (l < 2) { f32x4* dst = (f32x4*)xr[q] + F.lane;
#pragma unroll
                    for (int j = 0; j < 4; ++j) dst[64 * j] = v[q][j]; }
            }
            if (part == 1) continue;
            float ss = 0.f;
#pragma unroll
            for (int j = 0; j < 4; ++j) ss += (v[q][j].x * v[q][j].x + v[q][j].y * v[q][j].y) + (v[q][j].z * v[q][j].z + v[q][j].w * v[q][j].w);
            const float r = rsqrtf(wave_sum(ss) * (1.0f / D) + RMS_EPS);
            if (l == 2) {
                f32x4* dst = (f32x4*)(F.out + ((size_t)b * SEQ + t) * D) + F.lane; const f32x4* g = (const f32x4*)g_final + F.lane;
#pragma unroll
                for (int j = 0; j < 4; ++j) dst[64 * j] = v[q][j] * r * g[64 * j];
            } else {
                const f32x4* g = (const f32x4*)(g_mix + l * D) + F.lane;
                const f32x4* sh = (const f32x4*)(MOD + ((size_t)l * 9 + mb) * 6144) + F.lane; const f32x4* sc = sh + 256;
                u32x2* dst = (u32x2*)(PROJ + (size_t)row * LDP + C_H) + F.lane;
#pragma unroll
                for (int j = 0; j < 4; ++j) { const f32x4 o = (v[q][j] * r * g[64 * j]) * (sc[64 * j] + 1.0f) + sh[64 * j]; u32x2 w; w.x = pk2(o.x, o.y); w.y = pk2(o.z, o.w); dst[64 * j] = w; }
            }
        }
    }
}

struct SchedIn {
    int G, c; const char* A; const char* B;
    __device__ __forceinline__ bool next(int i, pg8::Unit& u) const {
        int pm, pn; if (!pg8::tile_order(T / 256, 9, G, c, i, pm, pn)) return false;
        u.pm = pm; u.pn = pn; u.aux = 0; u.nt = D / 64; u.A = A + (size_t)pm * 256 * (LDP * 2); u.B = B + (size_t)pn * 256 * (D * 2); return true; }
};
struct EpiIn {
    bf16_t* PROJ;
    __device__ __forceinline__ void operator()(const f32x4 (&acc)[2][2][4][2], const pg8::Unit& u, int wr, int wc, int fr, int fq) const {
        const int row0 = u.pm * 256 + wr * 64 + fr;
        bf16_t* base = PROJ + (size_t)u.pn * 256 + wc * 32 + 8 * fq;
#pragma unroll
        for (int ai = 0; ai < 2; ++ai)
#pragma unroll
            for (int m = 0; m < 4; ++m) { bf16_t* rowp = base + (size_t)(row0 + ai * 128 + m * 16) * LDP;
#pragma unroll
                for (int bj = 0; bj < 2; ++bj) { const f32x4 v0 = acc[ai][bj][m][0], v1 = acc[ai][bj][m][1];
                    u32x4 w; w.x = cvt_pk_bf16(v0.x, v0.y); w.y = cvt_pk_bf16(v0.z, v0.w); w.z = cvt_pk_bf16(v1.x, v1.y); w.w = cvt_pk_bf16(v1.z, v1.w);
                    *(u32x4*)(rowp + bj * 128) = w; } }
    }
};
__device__ __forceinline__ int branch_col(int br) { return br == 0 ? C_POOL : (br == 1 ? C_DQ : (br == 2 ? C_NQ : C_GQ)); }
struct SchedMerge {
    int G, c, nM, skip, split; const char* PROJ; const char* WG; const char* WBR;
    __device__ __forceinline__ bool next(int i, pg8::Unit& u) const {
        int pm, pn, sub, aux;
        if (split && c < 128 && i < 2) { const int ct = c >> 2, br = c & 3; pm = (ct >> 2) * 17 + 16; pn = ct & 3; sub = 2 * br + i; aux = sub | 8; }
        else { const int ii = (split && c < 128) ? i - 2 : i;
            if (!pg8::tile_order(nM, 4, G, c, ii >> 3, pm, pn)) return false;
            if (skip) pm += pm >> 4;
            sub = ii & 7; aux = sub; }
        const int br = sub >> 1; u.pm = pm; u.pn = pn; u.aux = aux;
        if ((sub & 1) == 0) { u.nt = D / 64; u.A = PROJ + ((size_t)pm * 256 * LDP + C_H) * 2; u.B = WG + ((size_t)br * 1024 + (size_t)pn * 256) * (D * 2); }
        else { u.nt = 4; u.A = PROJ + ((size_t)pm * 256 * LDP + branch_col(br)) * 2; u.B = WBR + ((size_t)br * 1024 + (size_t)pn * 256) * (D * 2); }
        return true; }
};
struct EpiMerge {
    bf16_t* MERGED; bf16_t* SCR; bf16_t* SLAB;
    __device__ __forceinline__ void operator()(const f32x4 (&acc)[2][2][4][2], const pg8::Unit& u, int wr, int wc, int fr, int fq) const {
        const int sub = u.aux & 7, br = sub >> 1; const bool sjob = (u.aux & 8) != 0;
        int fr_ = fr, fq_ = fq; asm volatile("" : "+v"(fr_), "+v"(fq_));
        const int r0 = wr * 64 + fr_, c0 = wc * 32 + 8 * fq_;
        const int row0 = u.pm * 256 + r0, col0 = u.pn * 256 + c0;
        if ((sub & 1) == 0) {
#pragma unroll
            for (int ai = 0; ai < 2; ++ai)
#pragma unroll
                for (int m = 0; m < 4; ++m) { const int rl = r0 + ai * 128 + m * 16;
#pragma unroll
                    for (int bj = 0; bj < 2; ++bj) {
                        f32x4 v0 = acc[ai][bj][m][0], v1 = acc[ai][bj][m][1];
                        v0.x = sigmoidf_(v0.x); v0.y = sigmoidf_(v0.y); v0.z = sigmoidf_(v0.z); v0.w = sigmoidf_(v0.w); v1.x = sigmoidf_(v1.x); v1.y = sigmoidf_(v1.y); v1.z = sigmoidf_(v1.z); v1.w = sigmoidf_(v1.w);
                        u32x4 w; w.x = cvt_pk_bf16(v0.x, v0.y); w.y = cvt_pk_bf16(v0.z, v0.w); w.z = cvt_pk_bf16(v1.x, v1.y); w.w = cvt_pk_bf16(v1.z, v1.w);
                        *(u32x4*)(SCR + (size_t)rl * 256 + c0 + bj * 128) = w; } }
        } else {
            const bool rd = (br > 0) && !sjob;
#pragma unroll
            for (int ai = 0; ai < 2; ++ai) {
                u32x4 gq[4][2], oq[4][2];
#pragma unroll
                for (int m = 0; m < 4; ++m) { const int rl = r0 + ai * 128 + m * 16;
#pragma unroll
                    for (int bj = 0; bj < 2; ++bj) {
                        gq[m][bj] = *(const u32x4*)(SCR + (size_t)rl * 256 + c0 + bj * 128);
                        const u32x4* sp = sjob ? (const u32x4*)(SLAB + ((size_t)br * 2048 + (size_t)(u.pm / 17) * 256 + rl) * D + col0 + bj * 128)
                                               : (const u32x4*)(MERGED + (size_t)(row0 + ai * 128 + m * 16) * D + col0 + bj * 128);
                        oq[m][bj] = rd ? *sp : (u32x4){0u, 0u, 0u, 0u}; } }
#pragma unroll
                for (int m = 0; m < 4; ++m) { const int rl = r0 + ai * 128 + m * 16;
#pragma unroll
                    for (int bj = 0; bj < 2; ++bj) {
                        f32x4 v0 = acc[ai][bj][m][0], v1 = acc[ai][bj][m][1]; const u32x4 g4 = gq[m][bj], o = oq[m][bj];
                        v0.x = v0.x * bflo(g4.x) + bflo(o.x); v0.y = v0.y * bfhi(g4.x) + bfhi(o.x); v0.z = v0.z * bflo(g4.y) + bflo(o.y); v0.w = v0.w * bfhi(g4.y) + bfhi(o.y);
                        v1.x = v1.x * bflo(g4.z) + bflo(o.z); v1.y = v1.y * bfhi(g4.z) + bfhi(o.z); v1.z = v1.z * bflo(g4.w) + bflo(o.w); v1.w = v1.w * bfhi(g4.w) + bfhi(o.w);
                        u32x4 w; w.x = cvt_pk_bf16(v0.x, v0.y); w.y = cvt_pk_bf16(v0.z, v0.w); w.z = cvt_pk_bf16(v1.x, v1.y); w.w = cvt_pk_bf16(v1.z, v1.w);
                        u32x4* sp = sjob ? (u32x4*)(SLAB + ((size_t)br * 2048 + (size_t)(u.pm / 17) * 256 + rl) * D + col0 + bj * 128)
                                         : (u32x4*)(MERGED + (size_t)(row0 + ai * 128 + m * 16) * D + col0 + bj * 128);
                        *sp = w; } }
            }
        }
    }
};
struct SchedOut {
    int G, c, nM, skip; const char* A; const char* B; const char* PRIV;
    __device__ __forceinline__ bool next(int i, pg8::Unit& u) const {
        int pm, pn;
        if (PRIV != nullptr) {
            if (c < 32) { if (i == 0) { pm = (c >> 2) * 17 + 16; pn = c & 3; } else if (i == 1) { if (!pg8::tile_order(128, 4, G, c, 0, pm, pn)) return false; pm += pm >> 4; } else return false; }
            else if (c < 64 && i == 2) { if (!pg8::tile_order(128, 4, G, c - 32, 1, pm, pn)) return false; pm += pm >> 4; }
            else { if (i >= 2 || !pg8::tile_order(128, 4, G, c, i, pm, pn)) return false; pm += pm >> 4; }
        } else { if (!pg8::tile_order(nM, 4, G, c, i, pm, pn)) return false; if (skip) pm += pm >> 4; }
        u.pm = pm; u.pn = pn; u.aux = 0; u.nt = D / 64; u.B = B + (size_t)pn * 256 * (D * 2);
        u.A = (PRIV != nullptr && pm % 17 == 16) ? PRIV + (size_t)((pm / 17) * 4 + pn) * (256 * D * 2) : A + (size_t)pm * 256 * (D * 2);
        return true; }
};
__device__ __forceinline__ void sum_ctx_slabs(Frame& F, const SchedOut& S) {
    const bf16_t* SLAB = WSB(WS_SLAB); bf16_t* PRIV = WSB(WS_PRIV);
    for (int i = 0; i < 4; ++i) { pg8::Unit u; if (!S.next(i, u)) break;
        if (u.pm % 17 != 16) continue;
        const int b = u.pm / 17; bf16_t* dst = PRIV + (size_t)(b * 4 + u.pn) * 256 * D;
        for (int ch0 = F.tid; ch0 < 256 * 128; ch0 += 8 * 512) {
            u32x4 w[8][4];
#pragma unroll
            for (int q = 0; q < 8; ++q) { const int ch = ch0 + q * 512, r = ch >> 7, c8 = (ch & 127) * 8;
#pragma unroll
                for (int br = 0; br < 4; ++br) w[q][br] = *(const u32x4*)(SLAB + ((size_t)br * 2048 + (size_t)b * 256 + r) * D + c8); }
#pragma unroll
            for (int q = 0; q < 8; ++q) { const int ch = ch0 + q * 512, r = ch >> 7, c8 = (ch & 127) * 8; float s[8];
#pragma unroll
                for (int e = 0; e < 8; ++e) s[e] = 0.f;
#pragma unroll
                for (int br = 0; br < 4; ++br) { const u32x4 x = w[q][br];
                    s[0] += bflo(x.x); s[1] += bfhi(x.x); s[2] += bflo(x.y); s[3] += bfhi(x.y); s[4] += bflo(x.z); s[5] += bfhi(x.z); s[6] += bflo(x.w); s[7] += bfhi(x.w); }
                u32x4 o; o.x = pk2(s[0], s[1]); o.y = pk2(s[2], s[3]); o.z = pk2(s[4], s[5]); o.w = pk2(s[6], s[7]);
                *(u32x4*)(dst + (size_t)r * D + c8) = o; } } }
    asm volatile("s_waitcnt vmcnt(0)" ::: "memory");
    __syncthreads();
}
struct EpiOut {
    const float* xlat_src; const float* xctx_src; float* out; float* XCTX; const float* MODL;
    __device__ __forceinline__ void operator()(const f32x4 (&acc)[2][2][4][2], const pg8::Unit& u, int wr, int wc, int fr, int fq) const {
        const int b = u.pm / 17, j = u.pm % 17; const bool isctx = j == 16;
        const size_t rbase = isctx ? (size_t)b * CTXL : (size_t)b * SEQ + j * 256;
        const float* src = isctx ? xctx_src : xlat_src; float* dst = isctx ? XCTX : out;
        const float* gt = MODL + (size_t)(isctx ? 8 : b) * 6144 + 2 * 1024;
        const int r0 = wr * 64 + fr, col0 = u.pn * 256 + wc * 32 + 8 * fq;
        f32x4 g[2][2];
#pragma unroll
        for (int bj = 0; bj < 2; ++bj) { g[bj][0] = *(const f32x4*)(gt + col0 + bj * 128); g[bj][1] = *(const f32x4*)(gt + col0 + bj * 128 + 4); }
#pragma unroll
        for (int ai = 0; ai < 2; ++ai) {
            f32x4 xs[4][2][2];
#pragma unroll
            for (int m = 0; m < 4; ++m) { const size_t off = (rbase + r0 + ai * 128 + m * 16) * D + col0;
#pragma unroll
                for (int bj = 0; bj < 2; ++bj) { xs[m][bj][0] = *(const f32x4*)(src + off + bj * 128); xs[m][bj][1] = *(const f32x4*)(src + off + bj * 128 + 4); } }
#pragma unroll
            for (int m = 0; m < 4; ++m) { const size_t off = (rbase + r0 + ai * 128 + m * 16) * D + col0;
#pragma unroll
                for (int bj = 0; bj < 2; ++bj) {
                    *(f32x4*)(dst + off + bj * 128) = xs[m][bj][0] + g[bj][0] * acc[ai][bj][m][0];
                    *(f32x4*)(dst + off + bj * 128 + 4) = xs[m][bj][1] + g[bj][1] * acc[ai][bj][m][1]; } }
        }
    }
};
template <int KD>
struct SchedMoe {
    int G, c, ntiles; const LAS int* tile_e; const char* A; const char* B;
    __device__ __forceinline__ bool next(int i, pg8::Unit& u) const {
        const int L = i * G + c; if (L >= ntiles * 4) return false;
        const int k = L >> 2, j = L & 3, e = __builtin_amdgcn_readfirstlane(tile_e[k]);
        u.pm = k; u.pn = j; u.aux = e; u.nt = KD / 64; u.A = A + (size_t)k * (256 * KD * 2); u.B = B + ((size_t)e * 1024 + (size_t)j * 256) * (KD * 2); return true; }
};
struct EpiGU {
    bf16_t* HMID;
    __device__ __forceinline__ void operator()(const f32x4 (&acc)[2][2][4][2], const pg8::Unit& u, int wr, int wc, int fr, int fq) const {
        const int row0 = u.pm * 256 + wr * 64 + fr, col0 = u.pn * 128 + wc * 32 + 8 * fq;
#pragma unroll
        for (int ai = 0; ai < 2; ++ai)
#pragma unroll
            for (int m = 0; m < 4; ++m) {
                float h[8];
#pragma unroll
                for (int n = 0; n < 2; ++n)
#pragma unroll
                    for (int e = 0; e < 4; ++e) { const float gv = acc[ai][0][m][n][e], uv = acc[ai][1][m][n][e]; h[n * 4 + e] = gv * sigmoidf_(gv) * uv; }
                u32x4 w; w.x = cvt_pk_bf16(h[0], h[1]); w.y = cvt_pk_bf16(h[2], h[3]); w.z = cvt_pk_bf16(h[4], h[5]); w.w = cvt_pk_bf16(h[6], h[7]);
                *(u32x4*)(HMID + (size_t)(row0 + ai * 128 + m * 16) * DEXP + col0) = w; }
    }
};
struct EpiDown {
    bf16_t* Y; const float* ROWW;
    __device__ __forceinline__ void operator()(const f32x4 (&acc)[2][2][4][2], const pg8::Unit& u, int wr, int wc, int fr, int fq) const {
        const int row0 = u.pm * 256 + wr * 64 + fr, col0 = u.pn * 256 + wc * 32 + 8 * fq;
#pragma unroll
        for (int ai = 0; ai < 2; ++ai)
#pragma unroll
            for (int m = 0; m < 4; ++m) { const size_t row = (size_t)(row0 + ai * 128 + m * 16); const float w8 = ROWW[row];
#pragma unroll
                for (int bj = 0; bj < 2; ++bj) { const f32x4 v0 = acc[ai][bj][m][0] * w8, v1 = acc[ai][bj][m][1] * w8;
                    u32x4 w; w.x = cvt_pk_bf16(v0.x, v0.y); w.y = cvt_pk_bf16(v0.z, v0.w); w.z = cvt_pk_bf16(v1.x, v1.y); w.w = cvt_pk_bf16(v1.z, v1.w);
                    *(u32x4*)(Y + row * D + col0 + bj * 128) = w; } }
    }
};

constexpr int ROPE_T8 = 131072, ROPE_T16 = 131072 + 64 * 8 * 2 * 4;
template <int NF>
__device__ __forceinline__ void rope8(float (&v)[8], float (&o)[8], const LAS f32x2* tab, int pos, int i0, bool second) {
#pragma unroll
    for (int e = 0; e < 8; ++e) { const f32x2 cs = tab[pos * NF + i0 + e]; v[e] = second ? (o[e] * cs.y + v[e] * cs.x) : (v[e] * cs.x - o[e] * cs.y); }
}
__device__ __forceinline__ void phase_post(Frame& F, int l) {
    const int gw = F.vcu * 8 + F.wave, NGW = F.G * 8, lane = F.lane;
    const float *gqa_q_norm = inptr(I_QN), *gqa_k_norm = inptr(I_KN); bf16_t *PROJ = WSB(WS_PROJ), *VT = WSB(WS_VT);
    { LAS f32x2* t8 = (LAS f32x2*)(F.lds + ROPE_T8); LAS f32x2* t16 = (LAS f32x2*)(F.lds + ROPE_T16);
      for (int i = F.tid; i < 64 * 8; i += 512) { const int pos = i >> 3, f = i & 7; float sn, cs; sincosf((float)pos * exp2f(-(float)f * (13.287712379549449f / 8.0f)), &sn, &cs); t8[i] = (f32x2){cs, sn}; }
      for (int i = F.tid; i < 64 * 16; i += 512) { const int pos = i >> 4, f = i & 15; float sn, cs; sincosf((float)pos * exp2f(-(float)f * (13.287712379549449f / 16.0f)), &sn, &cs); t16[i] = (f32x2){cs, sn}; }
      __syncthreads(); }
    const LAS f32x2* t8 = (const LAS f32x2*)(F.lds + ROPE_T8); const LAS f32x2* t16 = (const LAS f32x2*)(F.lds + ROPE_T16);
    for (int row = gw; row < T; row += NGW) {
        const int b = row / TPB, t = row % TPB; const bool isctx = t >= SEQ; (void)b;
        bf16_t* pr = PROJ + (size_t)row * LDP;
        const int prow = t >> 6, pcol = t & 63;
        const bool gact = lane < 48; const int lc = gact ? lane : 0;
        const u32x4 wD = *(const u32x4*)(pr + C_DQ + lane * 8);
        const u32x4 wN = *(const u32x4*)(pr + C_NQ + (lane & 31) * 8);
        const u32x4 wG = *(const u32x4*)(pr + C_GQ + lc * 8);
        const int win = 2 << (lane >> 4), nseq = isctx ? CTXL : SEQ, ts = isctx ? t - SEQ : t;
        const int lo = max(ts - win / 2, 0), hi = min(ts + win / 2, nseq);
        const bf16_t* ub = PROJ + ((size_t)(row - ts)) * LDP + lane * 4;
        u32x2 wu[16];
#pragma unroll
        for (int i = 0; i < 16; ++i) { const int ii = ts - 8 + i; wu[i] = (ii >= lo && ii < hi) ? *(const u32x2*)(ub + (size_t)ii * LDP) : (u32x2){0u, 0u}; }
        const u32x2 wself = *(const u32x2*)(ub + (size_t)ts * LDP);
        {
            u32x4 w = wD;
            float v[8] = {bflo(w.x), bfhi(w.x), bflo(w.y), bfhi(w.y), bflo(w.z), bfhi(w.z), bflo(w.w), bfhi(w.w)};
            if (!isctx) {
                float o[8];
#pragma unroll
                for (int e = 0; e < 8; ++e) o[e] = swz_xor<1>(v[e]);
                rope8<8>(v, o, t8, (lane & 2) ? pcol : prow, 0, (lane & 1) != 0);
            }
            const float sc = lane < 32 ? 0.17677669529663687f * LOG2E : 1.0f;
#pragma unroll
            for (int e = 0; e < 8; ++e) v[e] *= sc;
            w.x = pk2(v[0], v[1]); w.y = pk2(v[2], v[3]); w.z = pk2(v[4], v[5]); w.w = pk2(v[6], v[7]);
            *(u32x4*)(pr + C_DQ + lane * 8) = w;
        }
        if (lane < 32) {
            u32x4 w = wN; const float sc = 0.125f * LOG2E;
            w.x = pk2(bflo(w.x) * sc, bfhi(w.x) * sc); w.y = pk2(bflo(w.y) * sc, bfhi(w.y) * sc); w.z = pk2(bflo(w.z) * sc, bfhi(w.z) * sc); w.w = pk2(bflo(w.w) * sc, bfhi(w.w) * sc);
            *(u32x4*)(pr + C_NQ + lane * 8) = w;
        }
        {
            u32x4 w = wG;
            float v[8] = {bflo(w.x), bfhi(w.x), bflo(w.y), bfhi(w.y), bflo(w.z), bfhi(w.z), bflo(w.w), bfhi(w.w)};
            float ss = 0.f;
#pragma unroll
            for (int e = 0; e < 8; ++e) ss += v[e] * v[e];
            ss = sum8(ss);
            const float r = rsqrtf(ss * (1.0f / 64.0f) + RMS_EPS);
            const float* gn = (lc < 32 ? gqa_q_norm : gqa_k_norm) + l * 64 + (lc & 7) * 8;
#pragma unroll
            for (int e = 0; e < 8; ++e) v[e] = v[e] * r * gn[e];
            float o[8];
#pragma unroll
            for (int e = 0; e < 8; ++e) o[e] = swz_xor<2>(v[e]);
            if (!isctx) rope8<16>(v, o, t16, (lc & 4) ? pcol : prow, (lc & 1) * 8, (lc & 2) != 0);
            const float sc = lc < 32 ? 0.125f * LOG2E : 1.0f;
#pragma unroll
            for (int e = 0; e < 8; ++e) v[e] *= sc;
            w.x = pk2(v[0], v[1]); w.y = pk2(v[2], v[3]); w.z = pk2(v[4], v[5]); w.w = pk2(v[6], v[7]);
            if (gact) *(u32x4*)(pr + C_GQ + lc * 8) = w;
        }
        {
            float s0 = 0.f, s1 = 0.f, s2 = 0.f, s3 = 0.f;
#pragma unroll
            for (int i = 0; i < 16; ++i) { s0 += bflo(wu[i].x); s1 += bfhi(wu[i].x); s2 += bflo(wu[i].y); s3 += bfhi(wu[i].y); }
            const float inv = 1.0f / (float)(hi - lo);
            u32x2 o; o.x = pk2(s0 * inv - bflo(wself.x), s1 * inv - bfhi(wself.x)); o.y = pk2(s2 * inv - bflo(wself.y), s3 * inv - bfhi(wself.y));
            *(u32x2*)(pr + C_POOL + lane * 4) = o;
        }
    }
    LAS bf16_t* scr = (LAS bf16_t*)(F.lds + F.wave * 16384);
    for (int it = gw; it < (T / 64) * 10; it += NGW) {
        const int tt = it / 10, vh = it % 10, b = tt / 68, key0 = (tt % 68) * 64;
        const int vcol = vh < 4 ? C_DV + 64 * vh : (vh < 8 ? C_NV + 64 * (vh - 4) : C_GV + 64 * (vh - 8));
        const int lt = lane >> 3, lch = lane & 7;
        u32x4 w[8];
#pragma unroll
        for (int g = 0; g < 8; ++g) w[g] = *(const u32x4*)(PROJ + ((size_t)tt * 64 + g * 8 + lt) * LDP + vcol + lch * 8);
#pragma unroll
        for (int g = 0; g < 8; ++g) { const int tok = g * 8 + lt; LAS bf16_t* s = scr + (lch * 8) * 66 + tok;
            s[0 * 66] = (bf16_t)(w[g].x & 0xffff); s[1 * 66] = (bf16_t)(w[g].x >> 16); s[2 * 66] = (bf16_t)(w[g].y & 0xffff); s[3 * 66] = (bf16_t)(w[g].y >> 16);
            s[4 * 66] = (bf16_t)(w[g].z & 0xffff); s[5 * 66] = (bf16_t)(w[g].z >> 16); s[6 * 66] = (bf16_t)(w[g].w & 0xffff); s[7 * 66] = (bf16_t)(w[g].w >> 16); }
        asm volatile("s_waitcnt lgkmcnt(0)" ::: "memory");
#pragma unroll
        for (int g = 0; g < 8; ++g) { const int d = g * 8 + lt; const LAS unsigned* rd = (const LAS unsigned*)(scr + d * 66) + lch * 4;
            u32x4 o; o.x = rd[0]; o.y = rd[1]; o.z = rd[2]; o.w = rd[3];
            *(u32x4*)(VT + (((size_t)b * 10 + vh) * 64 + d) * TPB + key0 + lch * 8) = o; }
        asm volatile("s_waitcnt lgkmcnt(0)" ::: "memory");
    }
}

constexpr int ATT_K = 0, ATT_V = 16384, ATT_BIAS = 32768, ATT_Q = 36864;
constexpr float ATT_THR = 6.0f;
template <int MODE>
__device__ __forceinline__ void attn_unit(Frame& F, int l, int b, int h, int qt) {
    LAS unsigned char* lds = F.lds;
    bf16_t* PROJ = WSB(WS_PROJ); const bf16_t* VT = WSB(WS_VT);
    int tid_ = F.tid; asm volatile("" : "+v"(tid_));
    const int tid = tid_, lane = tid & 63, wid = F.wave, r32 = lane & 31, hi = lane >> 5;
    const int qcol = MODE == 0 ? C_GQ + 64 * h : (MODE == 1 ? C_DQ + 64 * h : C_NQ + 64 * h);
    const int kcol = MODE == 0 ? C_GK + 64 * (h >> 1) : (MODE == 1 ? C_DK + 64 * h : C_NK + 64 * h);
    const int vh = MODE == 0 ? 8 + (h >> 1) : (MODE == 1 ? h : 4 + h);
    const size_t rowbase = (size_t)b * TPB;
    const size_t qrow = rowbase + (size_t)qt * 256 + wid * 32 + r32;
    int a0, nA, b0 = 0, nBt = 0;
    if (qt == 16) { a0 = 64; nA = 4; }
    else if (MODE == 2) { a0 = 64; nA = 4; b0 = min(max(4 * qt - 4, 0), 56); nBt = min(max(4 * qt - 1, 0), 56) + 8 - b0; }
    else { a0 = 0; nA = 68; }
    const int ntl = nA + nBt;
    bf16x8 qr[4];
    { const bf16_t* qp = PROJ + qrow * LDP + qcol + 8 * hi;
#pragma unroll
      for (int s = 0; s < 4; ++s) qr[s] = *(const bf16x8*)(qp + 16 * s); }
    const int srow = tid >> 3, sch = tid & 7;
    const bf16_t* kg = PROJ + (rowbase + srow) * LDP + kcol + sch * 8;
    const bf16_t* vg = VT + (((size_t)b * 10 + vh) * 64 + srow) * TPB + sch * 8;
    const int swz = (srow >> 1) & 7;
    const int kst = srow * 128 + ((sch ^ swz) << 4), vst = ATT_V + srow * 128 + ((sch ^ swz) << 4);
    const bool vswap = (srow & 16) != 0;
    const int rsw = (r32 >> 1) & 7;
    const int kfr = r32 * 128;
    const int vfr = ATT_V + r32 * 128 + 8 * (hi ^ ((r32 >> 4) & 1));
    if (MODE == 2 && qt < 16) { for (int i = tid; i < 465; i += 512) ((LAS float*)(lds + ATT_BIAS))[i] = inptr(I_RPB)[((size_t)l * 4 + h) * 465 + i] * LOG2E; }
    float m0 = 0.f, l0 = 0.f, m1 = 0.f, l1 = 0.f;
    f32x16 oA[2], oB[2];
#pragma unroll
    for (int i = 0; i < 2; ++i) { oA[i] = (f32x16){}; oB[i] = (f32x16){}; }
    f32x16 ngm0 = (f32x16){}, ngm1 = (f32x16){};
    const int qgr = 4 * qt + (wid >> 1), qj = 32 * (wid & 1) + r32;
    const int wstart = min(max(qgr - 4, 0), 56), cst = min(max(qj - 8, 0), 48);

    auto tile_key0 = [&](int i) -> int { return (i < nA ? a0 + i : b0 + (i - nA)) * 64; };
    if constexpr (MODE == 0) {
        constexpr int PV0 = 32768;
        const int nst = ntl >> 1;
        u32x4 kr[2], vr[2];
#pragma unroll
        for (int u = 0; u < 2; ++u) { const int k0 = tile_key0(u); kr[u] = *(const u32x4*)(kg + (size_t)k0 * LDP); vr[u] = *(const u32x4*)(vg + k0); }
#pragma unroll
        for (int u = 0; u < 2; ++u) { *(LAS u32x4*)(lds + u * 8192 + kst) = kr[u]; u32x4 vv = vr[u]; if (vswap) vv = (u32x4){vr[u].z, vr[u].w, vr[u].x, vr[u].y}; *(LAS u32x4*)(lds + PV0 - ATT_V + u * 8192 + vst) = vv; }
        __syncthreads();
        for (int ip = 0; ip < nst; ++ip) {
            const int buf = (ip & 1) * 16384;
            if (ip + 1 < nst) {
#pragma unroll
                for (int u = 0; u < 2; ++u) { const int k0 = tile_key0(2 * ip + 2 + u); kr[u] = *(const u32x4*)(kg + (size_t)k0 * LDP); vr[u] = *(const u32x4*)(vg + k0); } }
            f32x16 p[2][2];
#pragma unroll
            for (int u = 0; u < 2; ++u) { p[u][0] = ngm0; p[u][1] = ngm0;
#pragma unroll
                for (int s = 0; s < 4; ++s) {
                    const bf16x8 k0f = *(const LAS bf16x8*)(lds + buf + u * 8192 + kfr + (((2 * s + hi) ^ rsw) << 4));
                    const bf16x8 k1f = *(const LAS bf16x8*)(lds + buf + u * 8192 + kfr + 4096 + (((2 * s + hi) ^ rsw) << 4));
                    p[u][0] = __builtin_amdgcn_mfma_f32_32x32x16_bf16(k0f, qr[s], p[u][0], 0, 0, 0);
                    p[u][1] = __builtin_amdgcn_mfma_f32_32x32x16_bf16(k1f, qr[s], p[u][1], 0, 0, 0);
                } }
            float mxa = -3.0e38f, mxb = -3.0e38f;
#pragma unroll
            for (int u = 0; u < 2; ++u)
#pragma unroll
                for (int r = 0; r < 16; r += 2) { mxa = __builtin_fmaxf(__builtin_fmaxf(mxa, p[u][0][r]), p[u][0][r + 1]); mxb = __builtin_fmaxf(__builtin_fmaxf(mxb, p[u][1][r]), p[u][1][r + 1]); }
            const float dgrow = half_max(__builtin_fmaxf(mxa, mxb));
            if (ip == 0 || __builtin_amdgcn_ballot_w64(dgrow > ATT_THR) != 0ull) {
                const float dn = (ip == 0) ? dgrow : __builtin_fmaxf(dgrow, 0.f);
                const float alpha = (ip == 0) ? 0.f : fast_exp2(-dn);
                m0 += dn; l0 *= alpha; oA[0] = oA[0] * alpha; oA[1] = oA[1] * alpha; ngm0 = ngm0 - dn;
#pragma unroll
                for (int u = 0; u < 2; ++u) { p[u][0] = p[u][0] - dn; p[u][1] = p[u][1] - dn; }
            }
            bf16x8 pk[2][4];
#pragma unroll
            for (int u = 0; u < 2; ++u) {
#pragma unroll
                for (int r = 0; r < 16; ++r) { p[u][0][r] = fast_exp2(p[u][0][r]); p[u][1][r] = fast_exp2(p[u][1][r]); }
                { const f32x16 sv = p[u][0] + p[u][1]; const f32x4 s4 = (f32x4){sv[0], sv[1], sv[2], sv[3]} + (f32x4){sv[4], sv[5], sv[6], sv[7]} + (f32x4){sv[8], sv[9], sv[10], sv[11]} + (f32x4){sv[12], sv[13], sv[14], sv[15]};
                  l0 += (s4.x + s4.y) + (s4.z + s4.w); }
#pragma unroll
                for (int s = 0; s < 4; ++s) { u32x4 w; const f32x16& pp = p[u][s >> 1]; const int q8 = 8 * (s & 1);
                    w.x = cvt_pk_bf16(pp[q8 + 0], pp[q8 + 1]); w.y = cvt_pk_bf16(pp[q8 + 2], pp[q8 + 3]); w.z = cvt_pk_bf16(pp[q8 + 4], pp[q8 + 5]); w.w = cvt_pk_bf16(pp[q8 + 6], pp[q8 + 7]);
                    pk[u][s] = __builtin_bit_cast(bf16x8, w); }
            }
            if (ip + 1 < nst) { const int nb = ((ip + 1) & 1) * 16384;
#pragma unroll
                for (int u = 0; u < 2; ++u) { *(LAS u32x4*)(lds + nb + u * 8192 + kst) = kr[u]; u32x4 vv = vr[u]; if (vswap) vv = (u32x4){vr[u].z, vr[u].w, vr[u].x, vr[u].y}; *(LAS u32x4*)(lds + PV0 - ATT_V + nb + u * 8192 + vst) = vv; } }
#pragma unroll
            for (int u = 0; u < 2; ++u)
#pragma unroll
                for (int db = 0; db < 2; ++db)
#pragma unroll
                    for (int s = 0; s < 4; ++s) {
                        const u32x2 lo = *(const LAS u32x2*)(lds + PV0 - ATT_V + buf + u * 8192 + vfr + 4096 * db + (((2 * s) ^ rsw) << 4));
                        const u32x2 hh = *(const LAS u32x2*)(lds + PV0 - ATT_V + buf + u * 8192 + vfr + 4096 * db + (((2 * s + 1) ^ rsw) << 4));
                        const bf16x8 vf = __builtin_bit_cast(bf16x8, (u32x4){lo.x, lo.y, hh.x, hh.y});
                        oA[db] = __builtin_amdgcn_mfma_f32_32x32x16_bf16(vf, pk[u][s], oA[db], 0, 0, 0);
                    }
            __syncthreads();
        }
    } else {
    u32x4 kreg, vreg;
    { const int k0 = tile_key0(0); kreg = *(const u32x4*)(kg + (size_t)k0 * LDP); vreg = *(const u32x4*)(vg + k0); }
    { *(LAS u32x4*)(lds + kst) = kreg; u32x4 vv = vreg; if (vswap) vv = (u32x4){vreg.z, vreg.w, vreg.x, vreg.y}; *(LAS u32x4*)(lds + vst) = vv; }
    __syncthreads();
    for (int i = 0; i < ntl; ++i) {
        const int buf = (i & 1) * 8192;
        if (i + 1 < ntl) { const int k0 = tile_key0(i + 1); kreg = *(const u32x4*)(kg + (size_t)k0 * LDP); vreg = *(const u32x4*)(vg + k0); }
        bool part = true; int dr = 0;
        if (MODE == 2 && i >= nA) { const int kr = b0 + (i - nA); part = (kr >= wstart) && (kr < wstart + 8); dr = kr - qgr + 7; }
        if (part) {
            bf16x8 pk[MODE == 1 ? 2 : 1][4];
#pragma unroll
            for (int c = 0; c < (MODE == 1 ? 2 : 1); ++c) {
                f32x16& ngm = (c == 0) ? ngm0 : ngm1;
                f32x16 p0 = ngm, p1 = ngm;
#pragma unroll
                for (int s = (MODE == 1 ? 2 * c : 0); s < (MODE == 1 ? 2 * c + 2 : 4); ++s) {
                    const bf16x8 k0f = *(const LAS bf16x8*)(lds + buf + kfr + (((2 * s + hi) ^ rsw) << 4));
                    const bf16x8 k1f = *(const LAS bf16x8*)(lds + buf + kfr + 4096 + (((2 * s + hi) ^ rsw) << 4));
                    p0 = __builtin_amdgcn_mfma_f32_32x32x16_bf16(k0f, qr[s], p0, 0, 0, 0);
                    p1 = __builtin_amdgcn_mfma_f32_32x32x16_bf16(k1f, qr[s], p1, 0, 0, 0);
                }
                if (MODE == 2 && i >= nA) {
                    const LAS float* bt = (const LAS float*)(lds + ATT_BIAS) + dr * 31 + 15 - qj;
#pragma unroll
                    for (int r = 0; r < 16; ++r) { const int kj = (r & 3) + 8 * (r >> 2) + 4 * hi;
                        { const int ix = min(max(kj - qj, -15), 15) + qj; const bool ok = (kj >= cst) && (kj < cst + 16); p0[r] = ok ? p0[r] + bt[ix] : -1e30f; }
                        { const int k2 = kj + 32; const int ix = min(max(k2 - qj, -15), 15) + qj; const bool ok = (k2 >= cst) && (k2 < cst + 16); p1[r] = ok ? p1[r] + bt[ix] : -1e30f; } }
                }
                float& mm = (c == 0) ? m0 : m1; float& ll = (c == 0) ? l0 : l1; f32x16* oo = (c == 0) ? oA : oB;
                float mxa = __builtin_fmaxf(__builtin_fmaxf(p0[0], p0[1]), p1[0]), mxb = __builtin_fmaxf(__builtin_fmaxf(p0[2], p0[3]), p1[1]);
                mxa = __builtin_fmaxf(__builtin_fmaxf(mxa, p1[2]), p1[3]);
#pragma unroll
                for (int r = 4; r < 16; r += 4) { mxa = __builtin_fmaxf(__builtin_fmaxf(mxa, p0[r]), p0[r + 1]); mxb = __builtin_fmaxf(__builtin_fmaxf(mxb, p0[r + 2]), p0[r + 3]);
                    mxa = __builtin_fmaxf(__builtin_fmaxf(mxa, p1[r]), p1[r + 1]); mxb = __builtin_fmaxf(__builtin_fmaxf(mxb, p1[r + 2]), p1[r + 3]); }
                const float dgrow = half_max(__builtin_fmaxf(mxa, mxb));
                if (i == 0 || __builtin_amdgcn_ballot_w64(dgrow > ATT_THR) != 0ull) {
                    const float dn = (i == 0) ? dgrow : __builtin_fmaxf(dgrow, 0.f);
                    const float alpha = (i == 0) ? 0.f : fast_exp2(-dn);
                    mm += dn; ll *= alpha; oo[0] = oo[0] * alpha; oo[1] = oo[1] * alpha; ngm = ngm - dn; p0 = p0 - dn; p1 = p1 - dn;
                }
#pragma unroll
                for (int r = 0; r < 16; ++r) { p0[r] = fast_exp2(p0[r]); p1[r] = fast_exp2(p1[r]); }
                { const f32x16 sv = p0 + p1; const f32x4 s4 = (f32x4){sv[0], sv[1], sv[2], sv[3]} + (f32x4){sv[4], sv[5], sv[6], sv[7]} + (f32x4){sv[8], sv[9], sv[10], sv[11]} + (f32x4){sv[12], sv[13], sv[14], sv[15]};
                  ll += (s4.x + s4.y) + (s4.z + s4.w); }
#pragma unroll
                for (int s = 0; s < 4; ++s) { u32x4 w;
                    if (s < 2) { w.x = cvt_pk_bf16(p0[8 * s + 0], p0[8 * s + 1]); w.y = cvt_pk_bf16(p0[8 * s + 2], p0[8 * s + 3]); w.z = cvt_pk_bf16(p0[8 * s + 4], p0[8 * s + 5]); w.w = cvt_pk_bf16(p0[8 * s + 6], p0[8 * s + 7]); }
                    else { const int q8 = 8 * (s - 2); w.x = cvt_pk_bf16(p1[q8 + 0], p1[q8 + 1]); w.y = cvt_pk_bf16(p1[q8 + 2], p1[q8 + 3]); w.z = cvt_pk_bf16(p1[q8 + 4], p1[q8 + 5]); w.w = cvt_pk_bf16(p1[q8 + 6], p1[q8 + 7]); }
                    pk[c][s] = __builtin_bit_cast(bf16x8, w); }
            }
            if (MODE == 1 && i + 1 < ntl) { const int nb = ((i + 1) & 1) * 8192; *(LAS u32x4*)(lds + nb + kst) = kreg; u32x4 vv = vreg; if (vswap) vv = (u32x4){vreg.z, vreg.w, vreg.x, vreg.y}; *(LAS u32x4*)(lds + nb + vst) = vv; }
#pragma unroll
            for (int db = 0; db < 2; ++db)
#pragma unroll
                for (int s = 0; s < 4; ++s) {
                    const u32x2 lo = *(const LAS u32x2*)(lds + buf + vfr + 4096 * db + (((2 * s) ^ rsw) << 4));
                    const u32x2 hh = *(const LAS u32x2*)(lds + buf + vfr + 4096 * db + (((2 * s + 1) ^ rsw) << 4));
                    const bf16x8 vf = __builtin_bit_cast(bf16x8, (u32x4){lo.x, lo.y, hh.x, hh.y});
                    oA[db] = __builtin_amdgcn_mfma_f32_32x32x16_bf16(vf, pk[0][s], oA[db], 0, 0, 0);
                    if (MODE == 1) oB[db] = __builtin_amdgcn_mfma_f32_32x32x16_bf16(vf, pk[MODE == 1 ? 1 : 0][s], oB[db], 0, 0, 0);
                }
        }
        if (MODE != 1 && i + 1 < ntl) { const int nb = ((i + 1) & 1) * 8192; *(LAS u32x4*)(lds + nb + kst) = kreg; u32x4 vv = vreg; if (vswap) vv = (u32x4){vreg.z, vreg.w, vreg.x, vreg.y}; *(LAS u32x4*)(lds + nb + vst) = vv; }
        __syncthreads();
    }
    }
    bf16_t* op = PROJ + qrow * LDP + qcol + 4 * hi;
    if (MODE == 1) {
        const float lam = WSF(WS_MOD)[131072 + l], lam_init = 0.8f - 0.6f * expf(-0.3f * (float)l);
        const float i0 = 1.0f / half_sum(l0), i1 = lam / half_sum(l1);
        float ss = 0.f;
#pragma unroll
        for (int db = 0; db < 2; ++db)
#pragma unroll
            for (int r = 0; r < 16; ++r) { const float v = oA[db][r] * i0 - oB[db][r] * i1; oA[db][r] = v; ss += v * v; }
        ss = half_sum(ss);
        const float rn = rsqrtf(ss * (1.0f / 64.0f) + RMS_EPS) * (1.0f - lam_init);
        const float* gn = inptr(I_DNG) + l * 64 + 4 * hi;
#pragma unroll
        for (int db = 0; db < 2; ++db)
#pragma unroll
            for (int g4 = 0; g4 < 4; ++g4) { const f32x4 g = *(const f32x4*)(gn + 32 * db + 8 * g4);
                u32x2 w; w.x = pk2(oA[db][4 * g4 + 0] * rn * g.x, oA[db][4 * g4 + 1] * rn * g.y); w.y = pk2(oA[db][4 * g4 + 2] * rn * g.z, oA[db][4 * g4 + 3] * rn * g.w);
                *(u32x2*)(op + 32 * db + 8 * g4) = w; }
    } else {
        const float i0 = 1.0f / half_sum(l0);
#pragma unroll
        for (int db = 0; db < 2; ++db)
#pragma unroll
            for (int g4 = 0; g4 < 4; ++g4) { u32x2 w; w.x = pk2(oA[db][4 * g4 + 0] * i0, oA[db][4 * g4 + 1] * i0); w.y = pk2(oA[db][4 * g4 + 2] * i0, oA[db][4 * g4 + 3] * i0);
                *(u32x2*)(op + 32 * db + 8 * g4) = w; }
    }
}
template <int MODE>
__device__ __forceinline__ void attn_queue(Frame& F, int l, unsigned* qbase, int nq) {
    const int per = 4 * nq;
    volatile LAS int* slot = (volatile LAS int*)(F.lds + LDS_MISC + 64);
    const int x0 = (int)(xb_xcc_id() & 7u);
    for (int dx = 0; dx < 8; ++dx) {
        const int x = (x0 + dx) & 7;
        unsigned* qctr = qbase + x * 64;
        for (;;) {
            if (F.tid == 0) slot[0] = (int)__hip_atomic_fetch_add(qctr, 1u, RLX_AGENT);
            __syncthreads();
            const int id = slot[0];
            __syncthreads();
            if (id >= per) break;
            const int qt = id % nq, bh = (id / nq) * 8 + x;
            attn_unit<MODE>(F, l, bh >> 2, bh & 3, qt);
        }
    }
}

__device__ __forceinline__ void convert_experts_queue(Frame& F, int l, int max_chunks = 1 << 30) {
    const float *w_eg = inptr(I_WEG), *w_eu = inptr(I_WEU), *w_ed = inptr(I_WED);
    bf16_t *GUT = WSB(WS_GUT), *DT = WSB(WS_DT);
    LAS float* scr = (LAS float*)(F.lds + F.wave * 16384);
    volatile LAS int* slot = (volatile LAS int*)(F.lds + LDS_MISC + 64);
    unsigned* qctr = WSU(WS_CTL) + CW_XQ + l * 64;
    constexpr int I_G = 16 * 16, I_D = 8 * 32, PER_E = 2 * I_G + I_D, NCH = NEXP * PER_E / 64;
    for (int done = 0; done < max_chunks; ++done) {
        if (F.tid == 0) slot[0] = (int)__hip_atomic_fetch_add(qctr, 1u, RLX_AGENT);
        __syncthreads();
        const int ch = slot[0];
        __syncthreads();
        if (ch >= NCH) break;
        for (int j = 0; j < 8; ++j) {
            const int it = ch * 64 + F.wave * 8 + j;
            const int e = it / PER_E; int r = it % PER_E;
            const size_t eo = ((size_t)l * NEXP + e);
            if (r < I_G) { transpose_item(w_eg + eo * D * DEXP, D, DEXP, GUT + (size_t)e * 1024 * 1024, 1024, scr, r, F.lane, RowGU{0}); continue; } r -= I_G;
            if (r < I_G) { transpose_item(w_eu + eo * D * DEXP, D, DEXP, GUT + (size_t)e * 1024 * 1024, 1024, scr, r, F.lane, RowGU{1}); continue; } r -= I_G;
            transpose_item(w_ed + eo * DEXP * D, DEXP, D, DT + (size_t)e * 1024 * 512, 512, scr, r, F.lane, RowId{});
        }
    }
}
__device__ __forceinline__ void phase_router(Frame& F, int l) {
    const float *w_rg = inptr(I_WRG), *w_re = inptr(I_WRE), *b_rg = inptr(I_BRG), *b_re = inptr(I_BRE), *g_ffn = inptr(I_GFFN);
    bf16_t *H = WSB(WS_H); float *XCTX = WSF(WS_XCTX), *MOD = WSF(WS_MOD); unsigned *ROUTE = WSU(WS_ROUTE), *ctl = WSU(WS_CTL);
    __syncthreads();
    LAS float* wt = (LAS float*)F.lds;
    LAS int* lcnt = (LAS int*)(F.lds + 147456);
    LAS unsigned* rinfo = (LAS unsigned*)(F.lds + 147456 + 256);
#pragma unroll 4
    for (int c = F.tid; c < 1024 * 8; c += 512) { const int k = c >> 3, o4 = c & 7, rk = ((k & 255) >> 2) + 64 * (4 * (k >> 8) + (k & 3)); *(LAS f32x4*)(wt + rk * 36 + 4 + o4 * 4) = *(const f32x4*)(w_re + ((size_t)l * D + k) * 32 + o4 * 4); }
#pragma unroll
    for (int k = F.tid; k < 1024; k += 512) { const int rk = ((k & 255) >> 2) + 64 * (4 * (k >> 8) + (k & 3)); *(LAS f32x4*)(wt + rk * 36) = *(const f32x4*)(w_rg + ((size_t)l * D + k) * 4); }
    if (F.tid < 64) lcnt[F.tid] = 0;
    __syncthreads();
    const int row_base = F.vcu * 136;
    const float* gf = g_ffn + l * D;
    LAS float* bias = (LAS float*)(F.lds + 150976 + 8 * 256);
    if (F.tid < 4) bias[F.tid] = b_rg[l * 4 + F.tid]; else if (F.tid < 36) bias[F.tid] = b_re[l * 32 + F.tid - 4];
    __syncthreads();
    for (int rp = 0; rp < 17; rp += 2) {
        bool ok[2]; int rls[2]; const float* shp[2]; const float* xrp[2]; float rr[2];
#pragma unroll
        for (int q = 0; q < 2; ++q) {
            const int rl = F.wave + 8 * (rp + q); rls[q] = rl; ok[q] = (rp + q) < 17;
            const int row = row_base + (ok[q] ? rl : 0); const int b = row / TPB, t = row % TPB; const bool isctx = t >= SEQ;
            if (ok[q] && isctx && l == 1) { if (F.lane == 0) rinfo[rl * 6] = 0xffffffffu; ok[q] = false; }
            const int mb = isctx ? 8 : b;
            xrp[q] = isctx ? XCTX + ((size_t)b * CTXL + (t - SEQ)) * D : F.out + ((size_t)b * SEQ + t) * D;
            shp[q] = MOD + ((size_t)l * 9 + mb) * 6144 + 3 * 1024;
        }
#pragma unroll
        for (int q = 0; q < 2; ++q) { float ss = 0.f; const f32x4* xp = (const f32x4*)xrp[q] + F.lane;
#pragma unroll
            for (int j = 0; j < 4; ++j) { const f32x4 x4 = xp[64 * j]; ss += (x4.x * x4.x + x4.y * x4.y) + (x4.z * x4.z + x4.w * x4.w); }
            rr[q] = rsqrtf(wave_sum(ss) * (1.0f / D) + RMS_EPS); }
        float hv[2][16];
#pragma unroll
        for (int j = 0; j < 4; ++j) {
            const f32x4 g4 = ((const f32x4*)gf)[F.lane + 64 * j];
#pragma unroll
            for (int q = 0; q < 2; ++q) { const f32x4 x4 = ((const f32x4*)xrp[q])[F.lane + 64 * j], s4 = ((const f32x4*)shp[q])[F.lane + 64 * j], c4 = ((const f32x4*)(shp[q] + 1024))[F.lane + 64 * j];
                const f32x4 h = (x4 * rr[q] * g4) * (c4 + 1.0f) + s4;
                hv[q][4 * j + 0] = h.x; hv[q][4 * j + 1] = h.y; hv[q][4 * j + 2] = h.z; hv[q][4 * j + 3] = h.w;
                if (ok[q]) { u32x2 w; w.x = pk2(h.x, h.y); w.y = pk2(h.z, h.w); ((u32x2*)(H + (size_t)(row_base + rls[q]) * D))[F.lane + 64 * j] = w; } }
        }
        float ag[2][4];
#pragma unroll
        for (int q = 0; q < 2; ++q)
#pragma unroll
            for (int o = 0; o < 4; ++o) ag[q][o] = 0.f;
#pragma unroll
        for (int je = 0; je < 16; ++je) { const f32x4 w = *(const LAS f32x4*)(wt + (F.lane + 64 * je) * 36);
#pragma unroll
            for (int q = 0; q < 2; ++q) { ag[q][0] += hv[q][je] * w.x; ag[q][1] += hv[q][je] * w.y; ag[q][2] += hv[q][je] * w.z; ag[q][3] += hv[q][je] * w.w; } }
        int grp[2]; float wgrp[2];
#pragma unroll
        for (int q = 0; q < 2; ++q) {
#pragma unroll
            for (int o = 0; o < 4; ++o) ag[q][o] = wave_sum(ag[q][o]) + bias[o];
            int g0 = 0; float gm = ag[q][0];
#pragma unroll
            for (int g = 1; g < 4; ++g) if (ag[q][g] > gm) { gm = ag[q][g]; g0 = g; }
            float gs = 0.f;
#pragma unroll
            for (int g = 0; g < 4; ++g) gs += __expf(ag[q][g] - gm);
            grp[q] = __builtin_amdgcn_readfirstlane(g0); wgrp[q] = 1.0f / gs;
        }
        float ae[2][8];
#pragma unroll
        for (int q = 0; q < 2; ++q)
#pragma unroll
            for (int o = 0; o < 8; ++o) ae[q][o] = 0.f;
#pragma unroll
        for (int je = 0; je < 16; ++je) {
#pragma unroll
            for (int q = 0; q < 2; ++q) { const LAS f32x4* wp = (const LAS f32x4*)(wt + (F.lane + 64 * je) * 36 + 4 + 8 * grp[q]); const f32x4 w0 = wp[0], w1 = wp[1];
                ae[q][0] += hv[q][je] * w0.x; ae[q][1] += hv[q][je] * w0.y; ae[q][2] += hv[q][je] * w0.z; ae[q][3] += hv[q][je] * w0.w;
                ae[q][4] += hv[q][je] * w1.x; ae[q][5] += hv[q][je] * w1.y; ae[q][6] += hv[q][je] * w1.z; ae[q][7] += hv[q][je] * w1.w; } }
#pragma unroll
        for (int q = 0; q < 2; ++q) {
#pragma unroll
            for (int o = 0; o < 8; ++o) ae[q][o] = wave_sum(ae[q][o]) + bias[4 + 8 * grp[q] + o];
            int i1 = 0; float v1 = ae[q][0];
#pragma unroll
            for (int j = 1; j < 8; ++j) if (ae[q][j] > v1) { v1 = ae[q][j]; i1 = j; }
            int i2 = -1; float v2 = -3.0e38f;
#pragma unroll
            for (int j = 0; j < 8; ++j) if (j != i1 && ae[q][j] > v2) { v2 = ae[q][j]; i2 = j; }
            const float e2 = __expf(v2 - v1), w1 = wgrp[q] / (1.0f + e2), w2 = wgrp[q] * e2 / (1.0f + e2);
            if (ok[q] && F.lane == 0) {
                const int rl = rls[q];
                const int ea = grp[q] * 8 + i1, eb = grp[q] * 8 + i2;
                const int sa = __hip_atomic_fetch_add(lcnt + ea, 1, __ATOMIC_RELAXED, __HIP_MEMORY_SCOPE_WORKGROUP);
                const int sb = __hip_atomic_fetch_add(lcnt + eb, 1, __ATOMIC_RELAXED, __HIP_MEMORY_SCOPE_WORKGROUP);
                rinfo[rl * 6 + 0] = (unsigned)ea; rinfo[rl * 6 + 1] = (unsigned)eb; rinfo[rl * 6 + 2] = (unsigned)sa; rinfo[rl * 6 + 3] = (unsigned)sb;
                rinfo[rl * 6 + 4] = __builtin_bit_cast(unsigned, w1); rinfo[rl * 6 + 5] = __builtin_bit_cast(unsigned, w2);
            }
        }
    }
    __syncthreads();
    if (F.tid < 32) lcnt[32 + F.tid] = (int)__hip_atomic_fetch_add(ctl + CW_CNT + l * 32 + F.tid, (unsigned)lcnt[F.tid], RLX_AGENT);
    __syncthreads();
    if (F.tid < 136) { const int rl = F.tid; const unsigned ea = rinfo[rl * 6];
        if (ea != 0xffffffffu) { const unsigned eb = rinfo[rl * 6 + 1]; unsigned* ro = ROUTE + (size_t)(row_base + rl) * 8;
            ro[0] = ea; ro[1] = eb; ro[2] = rinfo[rl * 6 + 2] + (unsigned)lcnt[32 + ea]; ro[3] = rinfo[rl * 6 + 3] + (unsigned)lcnt[32 + eb]; ro[4] = rinfo[rl * 6 + 4]; ro[5] = rinfo[rl * 6 + 5]; } }
    __syncthreads();
}
__device__ __forceinline__ int build_tiles(Frame& F, int l) {
    LAS int* offs = (LAS int*)(F.lds + LDS_MISC + 128);
    LAS int* cnts = (LAS int*)(F.lds + LDS_MISC + 320);
    LAS int* tile_e = (LAS int*)(F.lds + LDS_TILE_E);
    __syncthreads();
    if (F.tid < NEXP) cnts[F.tid] = (int)__hip_atomic_load(WSU(WS_CTL) + CW_CNT + l * 32 + F.tid, RLX_AGENT);
    __syncthreads();
    if (F.tid == 0) { int o = 0, k = 0;
        for (int e = 0; e < NEXP; ++e) { const int c = cnts[e]; offs[e] = o; const int nt = (c + 255) >> 8;
            for (int j = 0; j < nt && k < MPAD / 256; ++j) tile_e[k++] = e; o += nt << 8; }
        offs[32] = k; }
    __syncthreads();
    return __builtin_amdgcn_readfirstlane(offs[32]);
}
constexpr size_t WS_ROWMAP = WS_ROWW + 512 * 1024;
__device__ __forceinline__ void phase_scatter(Frame& F, int l) {
    (void)build_tiles(F, l);
    const LAS int* offs = (const LAS int*)(F.lds + LDS_MISC + 128);
    const LAS int* cnts = (const LAS int*)(F.lds + LDS_MISC + 320);
    const int gw = F.vcu * 8 + F.wave, NGW = F.G * 8;
    unsigned* ROUTE = WSU(WS_ROUTE); float* ROWW = WSF(WS_ROWW); int* ROWMAP = (int*)(F.ws + WS_ROWMAP);
    for (int r0 = gw * 64 + F.lane; r0 < T; r0 += NGW * 64) {
        const int row = r0;
        if (l == 1 && (row % TPB) >= SEQ) continue;
        unsigned* ro = ROUTE + (size_t)row * 8;
        const u32x4 r4 = *(const u32x4*)ro;
        const unsigned pa = (unsigned)offs[r4.x] + r4.z, pb = (unsigned)offs[r4.y] + r4.w;
        if (pa < (unsigned)MPAD && pb < (unsigned)MPAD) {
            ROWW[pa] = __builtin_bit_cast(float, ro[4]); ROWW[pb] = __builtin_bit_cast(float, ro[5]); ro[6] = pa; ro[7] = pb; ROWMAP[pa] = row; ROWMAP[pb] = row; }
    }
    if (F.vcu < NEXP) { const int e = F.vcu, c = cnts[e], o = offs[e], end = o + (((c + 255) >> 8) << 8);
        for (int p = o + c + F.tid; p < end && p < MPAD; p += 512) { ROWMAP[p] = 0; ROWW[p] = 0.f; } }
}

#define IN(k) (lo <= (k) && (k) < hi)
#define SEAM(k) do { if (IN(k) && IN((k) + 1)) { XcdBarrier b2 = bar; asm volatile("" : "+s"(b2.bar)); xcd_barrier(b2); } } while (0)
#if MK_STAMP
#define STAMP(k) do { if (blockIdx.x == 0 && threadIdx.x == 0) ((unsigned long long*)(F0.ws + 262144))[k] = __builtin_amdgcn_s_memrealtime(); } while (0)
#else
#define STAMP(k) do { } while (0)
#endif
template <int l>
__device__ __forceinline__ void run_layer(const Frame& F0, const XcdBarrier& bar, int lo, int hi) {
    constexpr int P = 1 + 11 * l;
        STAMP(P + 0);
        STAMP(P + 1);
    if (IN(P + 1)) { Frame F = launder(F0); if (l == 0) p0_prologue(F, 1); phase_modulate(F, l, 0); } SEAM(P + 1);
        STAMP(P + 2);
    if (IN(P + 2)) { Frame F = launder(F0);
            pg8::Gemm g{LDP * 2, D * 2}; SchedIn S{F.G, F.bx, (const char*)(WSB(WS_PROJ) + C_H), (const char*)(WSB(WS_WIN) + (size_t)l * NIN * D)}; EpiIn E{WSB(WS_PROJ)};
            pg8::gemm_phase<EpiIn, SchedIn, true>(F.lds, g, S, E);
        } SEAM(P + 2);
        STAMP(P + 3);
    if (IN(P + 3)) { Frame F = launder(F0); phase_post(F, l); } SEAM(P + 3);
        STAMP(P + 4);
    if (IN(P + 4)) { Frame F = launder(F0);
            const int nq = l == 0 ? 17 : 16;
            const int cslot = (l == 1) ? (F.vcu & 3) : -1;
            if (cslot == 0) convert_experts_queue(F, l, 2);
            attn_queue<1>(F, l, WSU(WS_CTL) + CW_Q + ((l * 4 + 0) * 8) * 64, nq);
            if (cslot == 1) convert_experts_queue(F, l, 2);
            attn_queue<0>(F, l, WSU(WS_CTL) + CW_Q + ((l * 4 + 1) * 8) * 64, nq);
            if (cslot == 2) convert_experts_queue(F, l, 2);
            attn_queue<2>(F, l, WSU(WS_CTL) + CW_Q + ((l * 4 + 2) * 8) * 64, nq);
            if (cslot == 3) convert_experts_queue(F, l, 2);
        } SEAM(P + 4);
        STAMP(P + 5);
    if (IN(P + 5)) { Frame F = launder(F0);
            pg8::Gemm g{LDP * 2, D * 2}; SchedMerge S{F.G, F.bx, 128, 1, l == 0 ? 1 : 0, (const char*)WSB(WS_PROJ), (const char*)(WSB(WS_WIN) + ((size_t)l * NIN + 2304) * D), (const char*)(WSB(WS_WBR) + (size_t)l * 4 * D * D)};
            EpiMerge E{WSB(WS_H), WSB(WS_VT) + (size_t)F.bx * 65536, WSB(WS_SLAB)};
            pg8::gemm_phase<EpiMerge, SchedMerge, true>(F.lds, g, S, E);
            convert_experts_queue(F, l);
        } SEAM(P + 5);
        STAMP(P + 6);
    if (IN(P + 6)) { Frame F = launder(F0);
            pg8::Gemm g{D * 2, D * 2}; SchedOut S{F.G, F.bx, l == 0 ? 136 : 128, l, (const char*)WSB(WS_H), (const char*)(WSB(WS_WOUT) + (size_t)l * D * D), l == 0 ? (const char*)WSB(WS_PRIV) : nullptr};
            if (l == 0) sum_ctx_slabs(F, S);
            EpiOut E{l == 0 ? inptr(I_X) : (const float*)F.out, l == 0 ? inptr(I_CTX) : (const float*)WSF(WS_XCTX), F.out, WSF(WS_XCTX), WSF(WS_MOD) + (size_t)l * 9 * 6144};
            pg8::gemm_phase<EpiOut, SchedOut, true>(F.lds, g, S, E);
        } SEAM(P + 6);
        STAMP(P + 7);
    if (IN(P + 7)) { Frame F = launder(F0); phase_router(F, l); } SEAM(P + 7);
        STAMP(P + 8);
    if (IN(P + 8)) { Frame F = launder(F0); phase_scatter(F, l); } SEAM(P + 8);
        STAMP(P + 9);
    if (IN(P + 9)) { Frame F = launder(F0);
            const int ntiles = build_tiles(F, l);
            LAS int* rmt = (LAS int*)(F.lds + 131072);
            { const int* ROWMAP = (const int*)(F.ws + WS_ROWMAP);
              for (int i = 0; i < 8; ++i) { const int L = i * F.G + F.vcu; if (L < ntiles * 4 && F.tid < 256) rmt[i * 256 + F.tid] = ROWMAP[(size_t)(L >> 2) * 256 + F.tid]; }
              __syncthreads(); }
            pg8::Gemm g{D * 2, D * 2}; SchedMoe<1024> S{F.G, F.vcu, ntiles, (const LAS int*)(F.lds + LDS_TILE_E), (const char*)WSB(WS_H), (const char*)WSB(WS_GUT)}; EpiGU E{WSB(WS_HMID)};
            pg8::gemm_phase<EpiGU, SchedMoe<1024>, true, true>(F.lds, g, S, E, (const char*)WSB(WS_H), rmt);
        } SEAM(P + 9);
        STAMP(P + 10);
    if (IN(P + 10)) { Frame F = launder(F0);
            const int ntiles = build_tiles(F, l);
            pg8::Gemm g{DEXP * 2, DEXP * 2}; SchedMoe<512> S{F.G, F.vcu, ntiles, (const LAS int*)(F.lds + LDS_TILE_E), (const char*)WSB(WS_HMID), (const char*)WSB(WS_DT)}; EpiDown E{WSB(WS_Y), WSF(WS_ROWW)};
            pg8::gemm_phase<EpiDown, SchedMoe<512>, true>(F.lds, g, S, E);
        } SEAM(P + 10);
    }
constexpr int N_PHASES = 24;
__global__ void __launch_bounds__(512, 2) fwd_kernel(Args args) {
    extern __shared__ __attribute__((aligned(16))) unsigned char lds_raw[];
    Frame F0;
    F0.lds = (LAS unsigned char*)lds_raw;
    F0.tid = threadIdx.x; F0.lane = F0.tid & 63; F0.wave = __builtin_amdgcn_readfirstlane(F0.tid >> 6);
    F0.G = gridDim.x; F0.bx = blockIdx.x; { const int bx = blockIdx.x; F0.vcu = (F0.G % 8 == 0) ? (bx % 8) * (F0.G / 8) + bx / 8 : bx; }
    F0.ws = args.ws; F0.out = args.out;
    for (int u = F0.tid; u < (LDS_BYTES - LDS_MISC) / 4; u += 512) ((LAS unsigned*)(F0.lds + LDS_MISC))[u] = 0u;
    __syncthreads();
    const int lo = args.ph_lo, hi = args.ph_hi;
    XcdBarrier bar; bar.bar = ((unsigned*)(F0.ws + WS_CTL)) + CW_BAR; bar.x = 0; bar.st = nullptr;
    if (hi - lo > 1) bar = xcd_barrier_post(((unsigned*)(F0.ws + WS_CTL)) + CW_BAR, (volatile LAS unsigned*)(F0.lds + LDS_MISC + 32));

    STAMP(0);
    if (IN(0)) { Frame F = launder(F0); p0_prologue(F, 0); } SEAM(0);
    run_layer<0>(F0, bar, lo, hi);
    run_layer<1>(F0, bar, lo, hi);
    STAMP(23);
    if (IN(23)) { Frame F = launder(F0); phase_modulate(F, 2, 0); }
    STAMP(24);
#if MK_STAMP
    if (blockIdx.x == 0 && threadIdx.x == 0) {
        const unsigned long long* ts = (const unsigned long long*)(F0.ws + 262144);
        const unsigned long long wait = 4ull * (ts[MK_STAMP_A % 100] - ts[MK_STAMP_A / 100]), t0 = __builtin_amdgcn_s_memrealtime();
        while (__builtin_amdgcn_s_memrealtime() - t0 < wait) __builtin_amdgcn_s_sleep(32);
    }
#endif
#undef IN
#undef SEAM
}


#if MK_CHECK
constexpr size_t WS_CHK = 512 * 1024;
constexpr size_t WS_CHKBUF = WS_END;
__device__ __forceinline__ unsigned hsh(unsigned x) { x ^= x >> 16; x *= 0x7feb352du; x ^= x >> 15; x *= 0x846ca68bu; x ^= x >> 16; return x; }
__device__ __forceinline__ void chk_put(unsigned* CHK, int id, float err) { if (!(err >= 0.f)) err = 1e30f; atomicMax(CHK + id, __builtin_bit_cast(unsigned, err)); }
__device__ __forceinline__ float ref_rope_elem(const float* v, int nd, int idx, int t) {
    if (idx >= nd) return 0.f;
    const int h = nd / 2, half = h / 2; const int sec = idx / h, ii = idx % h; const float pos = sec == 0 ? (float)(t / 64) : (float)(t % 64);
    const int i = ii % half; const float inv = powf(10000.0f, -(float)i / (float)half); const float ang = pos * inv, cs = cosf(ang), sn = sinf(ang);
    const float x1 = v[sec * h + i], x2 = v[sec * h + half + i];
    return ii < half ? x1 * cs - x2 * sn : x1 * sn + x2 * cs;
}
__global__ void chk_kernel(Args args, int which, int l) {
    unsigned char* ws = args.ws; unsigned* CHK = (unsigned*)(ws + WS_CHK);
    const float* const* in = args.in;
    const bf16_t* H = (const bf16_t*)(ws + WS_H); const bf16_t* PROJ = (const bf16_t*)(ws + WS_PROJ); const bf16_t* VT = (const bf16_t*)(ws + WS_VT);
    const float* MOD = (const float*)(ws + WS_MOD); const float* XCTX = (const float*)(ws + WS_XCTX); const unsigned* ROUTE = (const unsigned*)(ws + WS_ROUTE); const float* ROWW = (const float*)(ws + WS_ROWW);
    float* CB = (float*)(ws + WS_CHKBUF);
    const int s = blockIdx.x, tid = threadIdx.x; const unsigned h1 = hsh(s * 2654435761u + 12345u + (which == 5 ? 4 : which) * 977u), h2 = hsh(h1 + 0x9e3779b9u), h3 = hsh(h2 + 77u);
    const int id = l * 16 + which;
    __shared__ float sh[4608]; __shared__ float red[64];
    if (which == 0) {
        if (tid != 0) return; const int ll = s & 1, bb = (s >> 1) % 9, j = h1 % 6144; float acc = 0.f;
        for (int k = 0; k < 1024; ++k) { const float v = bb < 8 ? in[I_C][bb * 1024 + k] : in[I_CCTX][k]; acc += v / (1.f + expf(-v)) * in[I_WMOD][((size_t)ll * 1024 + k) * 6144 + j]; }
        acc += in[I_BMOD][ll * 6144 + j]; chk_put(CHK, id, fabsf(acc - MOD[((size_t)ll * 9 + bb) * 6144 + j]));
    } else if (which == 1) {
        if (tid != 0) return; const int row = h1 % T, col = h2 % 1024, b = row / TPB, t = row % TPB; const bool ic = t >= SEQ;
        const float* x = ic ? in[I_CTX] + ((size_t)b * CTXL + t - SEQ) * D : in[I_X] + ((size_t)b * SEQ + t) * D; float ss = 0.f;
        for (int k = 0; k < 1024; ++k) ss += x[k] * x[k];
        const float r = 1.0f / sqrtf(ss / 1024.f + 1e-6f); const float* m = MOD + (size_t)(ic ? 8 : b) * 6144;
        const float e = x[col] * r * in[I_GMIX][col] * (1.f + m[1024 + col]) + m[col]; chk_put(CHK, id, fabsf(e - bf2f(PROJ[(size_t)row * LDP + C_H + col])));
    } else if (which == 2) {
        if (tid != 0) return; const int row = h1 % T, col = h2 % 2304; float acc = 0.f;
        for (int k = 0; k < 1024; ++k) acc += bf2f(PROJ[(size_t)row * LDP + C_H + k]) * in[I_WIN][((size_t)l * 1024 + k) * NIN + col];
        chk_put(CHK, id, fabsf(acc - bf2f(PROJ[(size_t)row * LDP + col])));
    } else if (which == 3) {
        const int kind = s % 7, row = h1 % T, b = row / TPB, t = row % TPB; const bool ic = t >= SEQ;
        int c0 = 0, nd = 64; const int hh = h2 & 3;
        if (kind == 0) { c0 = C_DQ + 32 * (h2 & 7); nd = 32; } else if (kind == 1) { c0 = C_DK + 32 * (h2 & 7); nd = 32; } else if (kind == 2) c0 = C_GQ + 64 * hh; else if (kind == 3) c0 = C_GK + 64 * (hh & 1);
        else if (kind == 4) c0 = C_NQ + 64 * hh; else if (kind == 5) c0 = 64 * hh; else c0 = (h3 % 10 < 4 ? C_DV + 64 * (h3 % 10) : (h3 % 10 < 8 ? C_NV + 64 * (h3 % 10 - 4) : C_GV + 64 * (h3 % 10 - 8)));
        if (kind == 5) {
            const int ch = c0 + tid, win = 2 << (ch / 64), n = ic ? CTXL : SEQ, ts = ic ? t - SEQ : t, lo = max(ts - win / 2, 0), hi = min(ts + win / 2, n); float sum = 0.f, self = 0.f;
            for (int i = lo; i < hi; ++i) { const size_t r2 = (size_t)(row - ts + i); float acc = 0.f; for (int k = 0; k < 1024; ++k) acc += bf2f(PROJ[r2 * LDP + C_H + k]) * in[I_WIN][((size_t)l * 1024 + k) * NIN + ch]; sum += acc; if (i == ts) self = acc; }
            chk_put(CHK, id, fabsf(sum / (float)(hi - lo) - self - bf2f(PROJ[(size_t)row * LDP + C_POOL + ch]))); return; }
        float acc = 0.f; if (tid < nd) for (int k = 0; k < 1024; ++k) acc += bf2f(PROJ[(size_t)row * LDP + C_H + k]) * in[I_WIN][((size_t)l * 1024 + k) * NIN + c0 + tid];
        sh[tid] = acc; __syncthreads();
        if (kind == 6) { const int vh = h3 % 10; chk_put(CHK, id, fabsf(acc - bf2f(VT[(((size_t)b * 10 + vh) * 64 + tid) * TPB + t]))); return; }
        float* v = sh + 64;
        if (kind == 2 || kind == 3) { float ss = 0.f; for (int i = 0; i < 64; ++i) ss += sh[i] * sh[i]; const float r = 1.f / sqrtf(ss / 64.f + 1e-6f); const float* g = (kind == 2 ? in[I_QN] : in[I_KN]) + l * 64; v[tid] = sh[tid] * r * g[tid]; }
        else v[tid] = sh[tid];
        __syncthreads();
        float e = v[tid]; if (!ic && kind <= 3) e = ref_rope_elem(v, nd, tid, t);
        if (kind == 0) e *= 0.17677669529663687f * LOG2E; if (kind == 2 || kind == 4) e *= 0.125f * LOG2E;
        if (tid < nd) chk_put(CHK, id, fabsf(e - bf2f(PROJ[(size_t)row * LDP + c0 + tid])));
    } else if (which == 4 || which == 5) {
        const int mode = s % 3, nq = l == 0 ? 17 : 16, b = h1 % NB, h = h2 & 3, qt = h3 % nq, q = qt * 256 + (hsh(h3) & 255); const size_t rowb = (size_t)b * TPB;
        const int qcol = mode == 0 ? C_GQ + 64 * h : (mode == 1 ? C_DQ + 64 * h : C_NQ + 64 * h), kcol = mode == 0 ? C_GK + 64 * (h >> 1) : (mode == 1 ? C_DK + 64 * h : C_NK + 64 * h), vcol = mode == 0 ? C_GV + 64 * (h >> 1) : (mode == 1 ? C_DV + 64 * h : C_NV + 64 * h);
        if (which == 5) { const float er = fabsf(CB[s * 64 + tid] - bf2f(PROJ[(rowb + q) * LDP + qcol + tid])); chk_put(CHK, l * 16 + (mode == 0 ? 5 : 11 + mode), er);
            if (l == 0 && mode == MK_CHK_MODE) { const float ex = CB[s * 64 + tid], gt = bf2f(PROJ[(rowb + q) * LDP + qcol + tid]);
                atomicAdd((float*)(CHK + 60), ex * gt); atomicAdd((float*)(CHK + 61), ex * ex); atomicAdd((float*)(CHK + 62), gt * gt); } return; }
        const bool ic = q >= SEQ; const int k_lo = ic ? SEQ : 0, k_hi = TPB;
        float outv = 0.f, out2 = 0.f;
        for (int map = 0; map < (mode == 1 ? 2 : 1); ++map) {
            float mx = -3e38f;
            for (int k = k_lo + tid; k < k_hi; k += 64) { float sc = 0.f; const int d0 = mode == 1 ? 32 * map : 0, dn = mode == 1 ? 32 : 64;
                for (int d = 0; d < dn; ++d) sc += bf2f(PROJ[(rowb + q) * LDP + qcol + d0 + d]) * bf2f(PROJ[(rowb + k) * LDP + kcol + d0 + d]);
                if (mode == 2 && !ic) { if (k < SEQ) { const int r = q / 64, j = q % 64, kr = k / 64, kj = k % 64, ws_ = min(max(r - 4, 0), 56), cs = min(max(j - 8, 0), 48);
                        if (kr >= ws_ && kr < ws_ + 8 && kj >= cs && kj < cs + 16) sc += in[I_RPB][(((size_t)l * 4 + h) * 15 + (kr - r + 7)) * 31 + min(max(kj - j, -15), 15) + 15] * LOG2E; else sc = -1e30f; } }
                sh[k] = sc; mx = fmaxf(mx, sc); }
            red[tid] = mx; __syncthreads(); mx = -3e38f; for (int i = 0; i < 64; ++i) mx = fmaxf(mx, red[i]); __syncthreads();
            float sum = 0.f, o = 0.f;
            for (int k = k_lo; k < k_hi; ++k) { const float p = exp2f(sh[k] - mx); sum += p; o += p * bf2f(PROJ[(rowb + k) * LDP + vcol + tid]); }
            __syncthreads();
            if (map == 0) outv = o / sum; else out2 = o / sum;
        }
        if (mode == 1) { const float lam = MOD[131072 + l], li = 0.8f - 0.6f * expf(-0.3f * (float)l); const float v = outv - lam * out2; red[tid] = v * v; __syncthreads(); float ss = 0.f; for (int i = 0; i < 64; ++i) ss += red[i];
            outv = v / sqrtf(ss / 64.f + 1e-6f) * in[I_DNG][l * 64 + tid] * (1.f - li); }
        CB[s * 64 + tid] = outv;
    } else if (which == 12) {
        const unsigned hh = hsh(h1 + tid * 7919u); const int b = hh % NB, vh = (hh >> 4) % 10, d = (hh >> 8) & 63; int key = (hh >> 14) % TPB; if (tid & 1) key = SEQ + (key & 255);
        const int vcol = vh < 4 ? C_DV + 64 * vh : (vh < 8 ? C_NV + 64 * (vh - 4) : C_GV + 64 * (vh - 8));
        if (VT[(((size_t)b * 10 + vh) * 64 + d) * TPB + key] != PROJ[((size_t)b * TPB + key) * LDP + vcol + d]) { atomicAdd(CHK + 58, 1u); atomicOr(CHK + 59, (1u << vh) | (key >= SEQ ? 1024u : 2048u)); }
    } else if (which == 6) {
        if (tid != 0) return; const int nM = l == 0 ? T : NB * SEQ; int row = h1 % nM; if (l == 1) row = (row / SEQ) * TPB + row % SEQ; const int n = h2 % 1024; float tot = 0.f;
        for (int br = 0; br < 4; ++br) { float acc = 0.f;
            if (br == 0) { for (int g = 0; g < 4; ++g) for (int dp = 0; dp < 64; ++dp) { float y = 0.f; for (int c = 0; c < 64; ++c) y += bf2f(PROJ[(size_t)row * LDP + C_POOL + 64 * g + c]) * in[I_POOLW][(((size_t)l * 4 + g) * 64 + c) * 64 + dp];
                    acc += y * in[I_POOLS][l * 256 + 64 * g + dp] * in[I_WBR][(((size_t)l * 4 + 0) * 256 + 64 * g + dp) * D + n]; } }
            else { const int c0 = branch_col(br); for (int k = 0; k < 256; ++k) acc += bf2f(PROJ[(size_t)row * LDP + c0 + k]) * in[I_WBR][(((size_t)l * 4 + br) * 256 + k) * D + n]; }
            float gl = 0.f; for (int k = 0; k < 1024; ++k) gl += bf2f(PROJ[(size_t)row * LDP + C_H + k]) * in[I_WIN][((size_t)l * 1024 + k) * NIN + 2304 + br * 1024 + n];
            tot += acc / (1.f + expf(-gl)); }
        chk_put(CHK, id, fabsf(tot - bf2f(H[(size_t)row * D + n])));
    } else if (which == 7) {
        if (tid != 0 || l != 0) return; const int row = h1 % T, n = h2 % 1024, b = row / TPB, t = row % TPB; const bool ic = t >= SEQ; float acc = 0.f;
        for (int k = 0; k < 1024; ++k) acc += bf2f(H[(size_t)row * D + k]) * in[I_WOUT][((size_t)l * 1024 + k) * D + n];
        const size_t xo = ic ? ((size_t)b * CTXL + t - SEQ) * D + n : ((size_t)b * SEQ + t) * D + n;
        const float e = (ic ? in[I_CTX] : in[I_X])[xo] + MOD[((size_t)l * 9 + (ic ? 8 : b)) * 6144 + 2048 + n] * acc; chk_put(CHK, id, fabsf(e - (ic ? XCTX : args.out)[xo]));
    } else if (which == 8) {
        if (tid != 0) return; int row = h1 % T; if (l == 1) { row = h1 % (NB * SEQ); row = (row / SEQ) * TPB + row % SEQ; } const int b = row / TPB, t = row % TPB; const bool ic = t >= SEQ;
        const float* x = ic ? XCTX + ((size_t)b * CTXL + t - SEQ) * D : args.out + ((size_t)b * SEQ + t) * D; float ss = 0.f; for (int k = 0; k < 1024; ++k) ss += x[k] * x[k];
        const float r = 1.f / sqrtf(ss / 1024.f + 1e-6f); const float* m = MOD + ((size_t)l * 9 + (ic ? 8 : b)) * 6144; float* lg = red; for (int o = 0; o < 36; ++o) lg[o] = 0.f; float herr = 0.f;
        for (int k = 0; k < 1024; ++k) { const float hv = x[k] * r * in[I_GFFN][l * 1024 + k] * (1.f + m[4096 + k]) + m[3072 + k]; herr = fmaxf(herr, fabsf(hv - bf2f(H[(size_t)row * D + k])));
            for (int o = 0; o < 4; ++o) lg[o] += hv * in[I_WRG][((size_t)l * 1024 + k) * 4 + o]; for (int o = 0; o < 32; ++o) lg[4 + o] += hv * in[I_WRE][((size_t)l * 1024 + k) * 32 + o]; }
        for (int o = 0; o < 4; ++o) lg[o] += in[I_BRG][l * 4 + o]; for (int o = 0; o < 32; ++o) lg[4 + o] += in[I_BRE][l * 32 + o];
        int g = 0; for (int o = 1; o < 4; ++o) if (lg[o] > lg[g]) g = o; float gs = 0.f; for (int o = 0; o < 4; ++o) gs += expf(lg[o] - lg[g]);
        int i1 = 0; for (int j = 1; j < 8; ++j) if (lg[4 + g * 8 + j] > lg[4 + g * 8 + i1]) i1 = j; int i2 = -1; for (int j = 0; j < 8; ++j) if (j != i1 && (i2 < 0 || lg[4 + g * 8 + j] > lg[4 + g * 8 + i2])) i2 = j;
        const float v1 = lg[4 + g * 8 + i1], v2 = lg[4 + g * 8 + i2], e2 = expf(v2 - v1), w1 = 1.f / gs / (1.f + e2), w2 = 1.f / gs * e2 / (1.f + e2);
        const unsigned* ro = ROUTE + (size_t)row * 8; float err = herr;
        if (ro[0] != (unsigned)(g * 8 + i1) || ro[1] != (unsigned)(g * 8 + i2)) err = 10.f; else err = fmaxf(err, fmaxf(fabsf(w1 - __builtin_bit_cast(float, ro[4])), fabsf(w2 - __builtin_bit_cast(float, ro[5]))));
        chk_put(CHK, id, err);
    } else if (which == 9) {
        if (tid != 0) return; int row = h1 % T; if (l == 1) { row = h1 % (NB * SEQ); row = (row / SEQ) * TPB + row % SEQ; } const unsigned* ro = ROUTE + (size_t)row * 8; const unsigned* ctl = (const unsigned*)(ws + WS_CTL);
        int off = 0, ofa = 0, ofb = 0; for (int e = 0; e < 32; ++e) { const int c = (int)ctl[CW_CNT + l * 32 + e]; if (e == (int)ro[0]) ofa = off; if (e == (int)ro[1]) ofb = off; off += ((c + 255) >> 8) << 8; }
        float err = 0.f; if (ro[6] != ofa + ro[2] || ro[7] != ofb + ro[3] || ro[2] >= ctl[CW_CNT + l * 32 + ro[0]] || ro[3] >= ctl[CW_CNT + l * 32 + ro[1]]) err = 10.f;
        const bf16_t* S0 = PROJ; for (int k = 0; k < 1024; ++k) { if (S0[(size_t)ro[6] * D + k] != H[(size_t)row * D + k] || S0[(size_t)ro[7] * D + k] != H[(size_t)row * D + k]) err = 5.f; }
        if (ROWW[ro[6]] != __builtin_bit_cast(float, ro[4]) || ROWW[ro[7]] != __builtin_bit_cast(float, ro[5])) err = 3.f; chk_put(CHK, id, err);
    } else if (which == 10 || which == 11) {
        if (tid != 0) return; int row = h1 % T; if (l == 1) { row = h1 % (NB * SEQ); row = (row / SEQ) * TPB + row % SEQ; } const unsigned* ro = ROUTE + (size_t)row * 8; const int sl = h2 & 1; const int e = ro[sl], pos = ro[6 + sl];
        const bf16_t* HM = (const bf16_t*)(ws + WS_HMID);
        if (which == 10) { const int col = h3 % 512; float g = 0.f, u = 0.f; for (int k = 0; k < 1024; ++k) { const float a = bf2f(PROJ[(size_t)pos * D + k]); g += a * in[I_WEG][(((size_t)l * 32 + e) * 1024 + k) * 512 + col]; u += a * in[I_WEU][(((size_t)l * 32 + e) * 1024 + k) * 512 + col]; }
            chk_put(CHK, id, fabsf(g / (1.f + expf(-g)) * u - bf2f(HM[(size_t)pos * 512 + col]))); }
        else { const int n = h3 % 1024; float acc = 0.f; for (int k = 0; k < 512; ++k) acc += bf2f(HM[(size_t)pos * 512 + k]) * in[I_WED][(((size_t)l * 32 + e) * 512 + k) * 1024 + n];
            chk_put(CHK, id, fabsf(acc * __builtin_bit_cast(float, ro[4 + sl]) - bf2f(PROJ[(size_t)pos * D + n]))); }
    }
}
__global__ void chk_encode(Args args) {
    const unsigned* CHK = (const unsigned*)(args.ws + WS_CHK);
    const int order[24] = {0, 1, 2, 3, 12, 13, 5, 6, 7, 8, 9, 10, 11, 16 + 2, 16 + 3, 16 + 5, 16 + 12, 16 + 13, 16 + 6, 16 + 8, 16 + 9, 16 + 10, 16 + 11, -1};
    const float tol[14] = {1e-3f, 0.03f, 0.04f, 0.04f, 0.f, 0.03f, 0.04f, 0.02f, 0.02f, 0.5f, 0.04f, 0.04f, 0.03f, 0.03f};
    float k = 0.f;
    for (int r = 0; r < 24 && order[r] >= 0; ++r) { const float e = __builtin_bit_cast(float, CHK[order[r]]); if (e > tol[order[r] & 15]) { float dg = floorf(log10f(e) + 5.f); dg = fminf(fmaxf(dg, 1.f), 9.f); k = sqrtf(dg * powf(10.f, (float)(r + 2))); break; } }
    float k2 = 0.f;
    if (k == 0.f) return;
    for (size_t i = (size_t)blockIdx.x * blockDim.x + threadIdx.x; i < (size_t)NB * SEQ * D; i += (size_t)gridDim.x * blockDim.x) args.out[i] = (i == 12345 && k2 > 0.f) ? k2 : k;
}
#endif


extern "C" void kernel_launch(void* const* d_in, const int* in_sizes, int n_in, void* d_out, int out_size, void* d_ws, size_t ws_size, hipStream_t stream) {
    static int grid = 0;
    if (grid == 0) {
        if (n_in != 26 || ws_size < WS_END) { fprintf(stderr, "kernel_launch: need 26 inputs and %zu bytes of workspace (got %d, %zu)\n", (size_t)WS_END, n_in, ws_size); grid = -1; return; }
        int dev = 0, cus = 0, per_cu = 0;
        if (hipGetDevice(&dev) != hipSuccess || hipDeviceGetAttribute(&cus, hipDeviceAttributeMultiprocessorCount, dev) != hipSuccess) { grid = -1; return; }
        if (hipFuncSetAttribute((const void*)fwd_kernel, hipFuncAttributeMaxDynamicSharedMemorySize, LDS_BYTES) != hipSuccess) { fprintf(stderr, "kernel_launch: hipFuncSetAttribute failed\n"); grid = -1; return; }
        if (hipOccupancyMaxActiveBlocksPerMultiprocessor(&per_cu, (const void*)fwd_kernel, 512, LDS_BYTES) != hipSuccess || per_cu < 1) { fprintf(stderr, "kernel_launch: occupancy query says %d\n", per_cu); }
        (void)hipGetLastError();
        grid = cus;
    }
    if (grid < 0) return;
    (void)hipMemsetAsync((char*)d_ws + WS_CTL, 0, CTL_ZERO_BYTES, stream);
    Args a{};
    for (int i = 0; i < 26; ++i) a.in[i] = (const float*)d_in[i];
    a.out = (float*)d_out; a.ws = (unsigned char*)d_ws;
#if MK_MULTI
    for (int p = 0; p < N_PHASES; ++p) {
#if MK_CHECK
        const int lq = p == 0 ? 0 : (p - 1) / 11, ph = p == 0 ? -2 : (p - 1) % 11 - 1;
        if (p < 23 && ph == 3) hipLaunchKernelGGL(chk_kernel, dim3(192), dim3(64), 0, stream, a, 4, lq);
#endif
        a.ph_lo = p; a.ph_hi = p + 1; hipLaunchKernelGGL(fwd_kernel, dim3(grid), dim3(512), LDS_BYTES, stream, a);
#if MK_CHECK
        if (p == 0) hipLaunchKernelGGL(chk_kernel, dim3(256), dim3(64), 0, stream, a, 0, 0);
        if (p == 2) hipLaunchKernelGGL(chk_kernel, dim3(256), dim3(64), 0, stream, a, 1, 0);
        if (p < 23 && ph == 1) hipLaunchKernelGGL(chk_kernel, dim3(512), dim3(64), 0, stream, a, 2, lq);
        if (p < 23 && ph == 2) hipLaunchKernelGGL(chk_kernel, dim3(448), dim3(64), 0, stream, a, 3, lq);
        if (p < 23 && ph == 3) hipLaunchKernelGGL(chk_kernel, dim3(192), dim3(64), 0, stream, a, 5, lq);
        if (p == 5) hipLaunchKernelGGL(chk_kernel, dim3(1024), dim3(64), 0, stream, a, 12, 0);
        if (p < 23 && ph == 4) hipLaunchKernelGGL(chk_kernel, dim3(256), dim3(64), 0, stream, a, 6, lq);
        if (p < 23 && ph == 5) hipLaunchKernelGGL(chk_kernel, dim3(256), dim3(64), 0, stream, a, 7, lq);
        if (p < 23 && ph == 6) hipLaunchKernelGGL(chk_kernel, dim3(256), dim3(64), 0, stream, a, 8, lq);
        if (p < 23 && ph == 7) hipLaunchKernelGGL(chk_kernel, dim3(128), dim3(64), 0, stream, a, 9, lq);
        if (p < 23 && ph == 8) hipLaunchKernelGGL(chk_kernel, dim3(256), dim3(64), 0, stream, a, 10, lq);
        if (p < 23 && ph == 9) hipLaunchKernelGGL(chk_kernel, dim3(256), dim3(64), 0, stream, a, 11, lq);
#endif
    }
#if MK_CHECK
    hipLaunchKernelGGL(chk_encode, dim3(1024), dim3(256), 0, stream, a);
#endif
#else
    a.ph_lo = 0; a.ph_hi = N_PHASES;
    hipLaunchKernelGGL(fwd_kernel, dim3(grid), dim3(512), LDS_BYTES, stream, a);
#endif
}
```

```cpp
#include <hip/hip_runtime.h>
#include <cstdint>
#include <cstdio>

#ifndef MK_CHECK
#define MK_CHECK 0
#endif
#ifndef MK_CHK_MODE
#define MK_CHK_MODE 0
#endif
#ifndef MK_STAMP
#define MK_STAMP 0
#endif
#ifndef MK_STAMP_A
#define MK_STAMP_A 0
#define MK_STAMP_B 0
#endif
#ifndef MK_MULTI
#define MK_MULTI 0
#endif

#define GAS __attribute__((address_space(1)))
#define LAS __attribute__((address_space(3)))
typedef unsigned short bf16_t;
typedef short bf16x8 __attribute__((ext_vector_type(8)));
typedef float f32x4 __attribute__((ext_vector_type(4)));
typedef float f32x2 __attribute__((ext_vector_type(2)));
typedef float f32x16 __attribute__((ext_vector_type(16)));
typedef unsigned u32x4 __attribute__((ext_vector_type(4)));
typedef unsigned u32x2 __attribute__((ext_vector_type(2)));

constexpr int D = 1024, NB = 8, SEQ = 4096, CTXL = 256, TPB = SEQ + CTXL  , T = NB * TPB  ;
constexpr int LDP = 3584;
constexpr int NGATE = 4096, NIN = 6400;
constexpr int C_DQ = 256, C_DK = 512, C_DV = 768, C_NQ = 1024, C_NK = 1280, C_NV = 1536, C_GQ = 1792, C_GK = 2048, C_GV = 2176, C_POOL = 2304, C_H = 2560;
constexpr int NEXP = 32, DEXP = 512;
constexpr int MPAD = 77824;
constexpr float RMS_EPS = 1e-6f;
constexpr float LOG2E = 1.4426950408889634f;

constexpr size_t MiB = 1u << 20;
constexpr size_t WS_CTL = 0, CTL_ZERO_BYTES = 1 * MiB;
constexpr size_t WS_MOD = 1 * MiB;
constexpr size_t WS_ROUTE = 2 * MiB;
constexpr size_t WS_ROWW = 4 * MiB;
constexpr size_t WS_XCTX = 5 * MiB;
constexpr size_t WS_WIN = 13 * MiB;
constexpr size_t WS_WOUT = 38 * MiB;
constexpr size_t WS_WBR = 42 * MiB;
constexpr size_t WS_H = 58 * MiB;
constexpr size_t WS_PROJ = 126 * MiB;
constexpr size_t WS_X2 = 364 * MiB;
constexpr size_t WS_VT = 536 * MiB;
constexpr size_t WS_END = 624 * MiB;
constexpr size_t WS_DT = WS_X2, WS_HMID = WS_X2 + 32 * MiB, WS_GUT = WS_X2 + 108 * MiB;
constexpr size_t WS_SLAB = WS_VT + 43 * MiB;
constexpr size_t WS_PRIV = WS_SLAB + 16 * MiB;
constexpr size_t WS_Y = WS_GUT;
static_assert((size_t)T * LDP * 2 <= WS_X2 - WS_PROJ && (size_t)MPAD * 1024 * 2 <= WS_X2 - WS_PROJ, "proj region");
static_assert(108 * MiB + 64 * MiB == WS_VT - WS_X2 && WS_Y + (size_t)MPAD * 1024 * 2 <= WS_END, "x2 / y region");
static_assert((size_t)NB * 10 * 64 * TPB * 2 <= WS_END - WS_VT, "vt region");
constexpr int CW_BAR = 1024;
constexpr int CW_CNT = 8192;
constexpr int CW_Q = 8448;
constexpr int CW_XQ = 16384;

constexpr int RING_BYTES = 131072;
constexpr int LDS_MISC = 155648;
constexpr int LDS_BYTES = 159744;
constexpr int LDS_TILE_E = LDS_MISC + 512;
static_assert(LDS_TILE_E + 320 * 4 <= LDS_BYTES, "lds map");

#define RLX_AGENT __ATOMIC_RELAXED, __HIP_MEMORY_SCOPE_AGENT
__device__ __forceinline__ unsigned f2bf(float f) { unsigned u = __builtin_bit_cast(unsigned, f); return (u + 0x7fffu + ((u >> 16) & 1u)) >> 16; }
__device__ __forceinline__ unsigned pk2(float lo, float hi) { return f2bf(lo) | (f2bf(hi) << 16); }
__device__ __forceinline__ float bflo(unsigned w) { return __builtin_bit_cast(float, w << 16); }
__device__ __forceinline__ float bfhi(unsigned w) { return __builtin_bit_cast(float, w & 0xffff0000u); }
__device__ __forceinline__ float bf2f(bf16_t h) { return __builtin_bit_cast(float, (unsigned)h << 16); }
typedef __bf16 bf16x2_t __attribute__((ext_vector_type(2)));
__device__ __forceinline__ unsigned cvt_pk_bf16(float lo, float hi) { f32x2 v = {lo, hi}; bf16x2_t b = __builtin_convertvector(v, bf16x2_t); return __builtin_bit_cast(unsigned, b); }
template <int CTRL, int ROWM = 0xf> __device__ __forceinline__ float dpp_f(float v) { return __builtin_bit_cast(float, __builtin_amdgcn_update_dpp(0, __builtin_bit_cast(int, v), CTRL, ROWM, 0xf, false)); }
template <int M> __device__ __forceinline__ float swz_xor(float v) {
    static_assert(M == 1 || M == 2, "quad permutes only");
    return M == 1 ? dpp_f<0xB1>(v) : dpp_f<0x4E>(v);
}
__device__ __forceinline__ float sum8(float v) { v += dpp_f<0xB1>(v); v += dpp_f<0x4E>(v); v += dpp_f<0x141>(v); return v; }
__device__ __forceinline__ void plswap32(float& a, float& b) { asm volatile("s_nop 1\n\tv_permlane32_swap_b32 %0, %1\n\ts_nop 1" : "+v"(a), "+v"(b)); }
__device__ __forceinline__ float half_sum(float v) { float a = v, b = v; plswap32(a, b); return a + b; }
__device__ __forceinline__ float half_max(float v) { float a = v, b = v; plswap32(a, b); return fmaxf(a, b); }
__device__ __forceinline__ float wave_sum(float v) {
    v = sum8(v); v += dpp_f<0x140>(v);
    v += __builtin_bit_cast(float, __builtin_amdgcn_update_dpp(0, __builtin_bit_cast(int, v), 0x142, 0xa, 0xf, true));
    v += __builtin_bit_cast(float, __builtin_amdgcn_update_dpp(0, __builtin_bit_cast(int, v), 0x143, 0xc, 0xf, true));
    return __builtin_bit_cast(float, __builtin_amdgcn_readlane(__builtin_bit_cast(int, v), 63));
}
__device__ __forceinline__ float fast_exp2(float x) { return __builtin_amdgcn_exp2f(x); }
__device__ __forceinline__ float fast_rcp(float x) { return __builtin_amdgcn_rcpf(x); }
__device__ __forceinline__ float sigmoidf_(float x) { return fast_rcp(1.0f + fast_exp2(-x * LOG2E)); }

#define XB_TMO      128
#define XB_XCNT(j)  (256  + 64 * (j))
#define XB_XSUB(j)  (1280 + 64 * (j))
#define XB_XGEN(j)  (2304 + 64 * (j))
#define XB_TOP      3328
#define XB_TOPGEN   3392
#define XCD_BAR_WORDS 3456
#define XB_SPIN_CAP (1u << 20)
__device__ __forceinline__ unsigned xb_ld(unsigned* p)              { return __hip_atomic_load(p, __ATOMIC_RELAXED, __HIP_MEMORY_SCOPE_AGENT); }
__device__ __forceinline__ unsigned xb_add(unsigned* p, unsigned v) { return __hip_atomic_fetch_add(p, v, __ATOMIC_RELAXED, __HIP_MEMORY_SCOPE_AGENT); }
__device__ __forceinline__ unsigned xb_xcc_id() { return (unsigned)__builtin_amdgcn_s_getreg((3 << 11) | 20) & 0xFu; }
#define XB_SPIN(cond, bar) do { unsigned _sp = 0; while (cond) { __builtin_amdgcn_s_sleep(1); \
    if ((++_sp & 255u) == 0u) { if (xb_ld(&(bar)[XB_TMO])) break; if (_sp > XB_SPIN_CAP) { atomicAdd(&(bar)[XB_TMO], 1u); break; } } } } while (0)
struct XcdBarrier { unsigned* bar; unsigned x; volatile LAS unsigned* st; };
__device__ __forceinline__ XcdBarrier xcd_barrier_post(unsigned* bar, volatile LAS unsigned* st) {
    XcdBarrier b; b.bar = bar; b.x = xb_xcc_id(); b.st = st;
    if (threadIdx.x == 0) (void)xb_add(&bar[XB_XCNT(b.x)], 1u);
    return b;
}
__device__ __forceinline__ void xcd_barrier_complete(unsigned* bar, unsigned x, unsigned& nloc, unsigned& nx) {
    const unsigned G = gridDim.x * gridDim.y * gridDim.z;
    unsigned sum, cnt, mine, sp = 0u;
    for (;;) {
        sum = 0u; cnt = 0u; mine = 0u;
#pragma unroll
        for (unsigned j = 0; j < 16; ++j) { const unsigned c = xb_ld(&bar[XB_XCNT(j)]); sum += c; cnt += (c > 0u) ? 1u : 0u; mine = (j == x) ? c : mine; }
        if (sum == G) break;
        __builtin_amdgcn_s_sleep(1);
        if ((++sp & 255u) == 0u) { if (xb_ld(&bar[XB_TMO])) break; if (sp > XB_SPIN_CAP) { atomicAdd(&bar[XB_TMO], 1u); break; } }
    }
    nloc = mine > 0u ? mine : 1u; nx = cnt > 0u ? cnt : 1u;
}
__device__ __forceinline__ void xcd_barrier(const XcdBarrier& b) {
    asm volatile("s_waitcnt vmcnt(0)" ::: "memory");
    __syncthreads();
    if (threadIdx.x == 0) {
        unsigned* bar = b.bar;
        __builtin_amdgcn_s_waitcnt(0);
        unsigned nloc = b.st[0], nx = b.st[1];
        if (nloc == 0u) { xcd_barrier_complete(bar, b.x, nloc, nx); b.st[0] = nloc; b.st[1] = nx; }
        const unsigned old = xb_add(&bar[XB_XSUB(b.x)], 1u);
        const unsigned gen = old / nloc;
        if (old + 1u == (gen + 1u) * nloc) {
            __builtin_amdgcn_fence(__ATOMIC_RELEASE, "agent");
            asm volatile("s_waitcnt vmcnt(0)" ::: "memory");
            const unsigned og = xb_add(&bar[XB_TOP], 1u);
            const unsigned tg = og / nx;
            if (og + 1u == (tg + 1u) * nx) xb_add(&bar[XB_TOPGEN], 1u);
            else XB_SPIN(xb_ld(&bar[XB_TOPGEN]) == tg, bar);
            __builtin_amdgcn_fence(__ATOMIC_ACQUIRE, "agent");
            xb_add(&bar[XB_XGEN(b.x)], 1u);
            asm volatile("s_waitcnt vmcnt(0)" ::: "memory");
        } else {
            XB_SPIN(xb_ld(&bar[XB_XGEN(b.x)]) == gen, bar);
            __builtin_amdgcn_fence(__ATOMIC_ACQUIRE, "agent");
            asm volatile("s_waitcnt vmcnt(0)" ::: "memory");
        }
    }
    __syncthreads();
}

namespace pg8 {
constexpr int BM = 256, BK = 64, HALF = 128, HTB = HALF * BK * 2, STAGE_BYTES = 8 * HTB, NXCD = 8, WGM = 8;
__host__ __device__ __forceinline__ int lds_byte(int r, int c) { const int st = (r >> 4) * 2 + (c >> 5), rr = r & 15, cc = c & 31, ob = rr * 64 + cc * 2; return st * 1024 + (ob ^ (((ob >> 9) & 1) << 5)); }
__host__ __device__ __forceinline__ void stage_rc(int b, int& R, int& C) { const int st = b / 1024, sb = b % 1024, swz = sb ^ (((sb >> 9) & 1) << 5); R = (st >> 1) * 16 + swz / 64; C = (st & 1) * 32 + (swz % 64) / 2; }
__host__ __device__ __forceinline__ int perm32(int rho) { const int n = rho >> 4, i = rho & 15; return 8 * (i >> 2) + 4 * n + (i & 3); }

struct Unit { int pm, pn, aux, nt; const char* A; const char* B; };
struct Gemm { int lda, ldb; };

__device__ __forceinline__ bool tile_order(int nM, int nN, int G, int c, int i, int& pm, int& pn) {
    const int nwg = nM * nN; const long L = (long)i * G + c; if (L >= nwg) return false;
    int wgid = (int)L; { const int q = nwg / NXCD, r = nwg % NXCD, xcd = wgid % NXCD, off = wgid / NXCD; wgid = (xcd < r ? xcd * (q + 1) : r * (q + 1) + (xcd - r) * q) + off; }
    const int nig = WGM * nN, gid = wgid / nig, fm = gid * WGM, gsz = (nM - fm) < WGM ? (nM - fm) : WGM;
    pm = fm + ((wgid % nig) % gsz); pn = (wgid % nig) / gsz; return true;
}

template <class Epi, class Sched, bool ALIGN_EPI, bool GATHER = false>
__device__ __forceinline__ void gemm_phase(LAS unsigned char* lds, const Gemm g, const Sched& S, const Epi& E, const char* Abase = nullptr, const LAS int* rm = nullptr) {
    int tid_ = threadIdx.x; asm volatile("" : "+v"(tid_));
    const int tid = tid_, wid = __builtin_amdgcn_readfirstlane(tid >> 6), lane = tid & 63, wr = wid >> 2, wc = wid & 3, fr = lane & 15, fq = lane >> 4;
    unsigned voffA[2], voffB[2];
#pragma unroll
    for (int i = 0; i < 2; ++i) { int R, C; stage_rc(tid * 16 + i * 8192, R, C); const int Rb = (R & ~31) + perm32(R & 31);
        voffA[i] = (unsigned)(R * g.lda + C * 2); voffB[i] = (unsigned)(Rb * g.ldb + C * 2); }
    const size_t kstep = (size_t)(BK * 2);
    const size_t hsA = (size_t)HALF * g.lda, hsB = (size_t)HALF * g.ldb;
    int rIdx[2], cOff[2];
#pragma unroll
    for (int i = 0; i < 2; ++i) { int R, C; stage_rc(tid * 16 + i * 8192, R, C); rIdx[i] = R; cOff[i] = C * 2; }
    unsigned vgc[2][2], vgn[2][2];
    auto load_vg = [&](unsigned (&v)[2][2], int unit_i) {
#pragma unroll
        for (int h = 0; h < 2; ++h)
#pragma unroll
            for (int i = 0; i < 2; ++i) v[h][i] = (unsigned)rm[unit_i * 256 + h * 128 + rIdx[i]] * (unsigned)g.lda + (unsigned)cOff[i]; };
    const unsigned ldsw = (unsigned)wid * 1024u;
    const int aoff = lds_byte(wr * 64 + fr, fq * 8), boff = lds_byte(wc * 32 + fr, fq * 8);
#define PG8_SA(b, h) (((b) * 2 + (h)) * HTB)
#define PG8_SB(b, h) ((4 + (b) * 2 + (h)) * HTB)
#define PG8_STAGE(bufoff, gbase, voff) do { _Pragma("unroll") for (int _i = 0; _i < 2; ++_i) \
        __builtin_amdgcn_global_load_lds((const unsigned*)((const char*)(gbase) + (voff)[_i]), (LAS unsigned*)(lds + (bufoff) + ldsw + _i * 8192), 16, 0, 0); } while (0)
#define PG8_STAGE_A(bufoff, gptr, kt, h, nx) do { if constexpr (GATHER) { _Pragma("unroll") for (int _i = 0; _i < 2; ++_i) \
        __builtin_amdgcn_global_load_lds((const unsigned*)(Abase + (size_t)(kt) * kstep + ((nx) ? vgn[h][_i] : vgc[h][_i])), (LAS unsigned*)(lds + (bufoff) + ldsw + _i * 8192), 16, 0, 0); } \
        else { PG8_STAGE(bufoff, gptr, voffA); } } while (0)
#define PG8_LDA(dst, b, h) do { _Pragma("unroll") for (int m = 0; m < 4; ++m) _Pragma("unroll") for (int k = 0; k < 2; ++k) dst[m][k] = *(const LAS bf16x8*)(lds + PG8_SA(b, h) + aoff + m * 2048 + k * 1024); } while (0)
#define PG8_LDB(dst, b, h) do { _Pragma("unroll") for (int n = 0; n < 2; ++n) _Pragma("unroll") for (int k = 0; k < 2; ++k) dst[n][k] = *(const LAS bf16x8*)(lds + PG8_SB(b, h) + boff + n * 2048 + k * 1024); } while (0)
#define PG8_MMA(ai, bj, At, Bt) do { __builtin_amdgcn_s_setprio(1); _Pragma("unroll") for (int m = 0; m < 4; ++m) _Pragma("unroll") for (int n = 0; n < 2; ++n) _Pragma("unroll") for (int k = 0; k < 2; ++k) \
        acc[ai][bj][m][n] = __builtin_amdgcn_mfma_f32_16x16x32_bf16(Bt[n][k], At[m][k], acc[ai][bj][m][n], 0, 0, 0); __builtin_amdgcn_s_setprio(0); } while (0)
#define PG8_WAIT_V(n) asm volatile("s_waitcnt vmcnt(" #n ")" ::: "memory")
#define PG8_WAIT_L(n) asm volatile("s_waitcnt lgkmcnt(" #n ")" ::: "memory")
#define PG8_BAR __builtin_amdgcn_s_barrier()
#define PG8_SCHED __builtin_amdgcn_sched_barrier(0)
    Unit cur, nxt; int ui = 0;
    if (!S.next(0, cur)) return;
    f32x4 acc[2][2][4][2];
#pragma unroll
    for (int a = 0; a < 2; ++a)
#pragma unroll
        for (int b = 0; b < 2; ++b)
#pragma unroll
            for (int m = 0; m < 4; ++m)
#pragma unroll
                for (int n = 0; n < 2; ++n) acc[a][b][m][n] = (f32x4){0.f, 0.f, 0.f, 0.f};
    bf16x8 At[4][2], B0[2][2], B1[2][2];
    const char* cA = cur.A; const char* cB = cur.B;
    if constexpr (GATHER) load_vg(vgc, 0);
    PG8_STAGE(PG8_SB(0, 0), cB, voffB); PG8_STAGE(PG8_SB(0, 1), cB + hsB, voffB); PG8_STAGE_A(PG8_SA(0, 0), cA, 0, 0, false); PG8_STAGE_A(PG8_SA(0, 1), cA + hsA, 0, 1, false);
    if (wr == 1) PG8_BAR;
    PG8_WAIT_V(2); PG8_BAR;
    PG8_STAGE(PG8_SB(1, 0), cB + kstep, voffB); PG8_STAGE_A(PG8_SA(1, 0), cA + kstep, 1, 0, false); PG8_STAGE(PG8_SB(1, 1), cB + hsB + kstep, voffB);
    PG8_WAIT_V(6); PG8_BAR;
    for (;;) {
        const bool has_next = S.next(ui + 1, nxt);
        const int nt = cur.nt;
        if constexpr (GATHER) { if (has_next) load_vg(vgn, ui + 1); else { vgn[0][0] = vgc[0][0]; vgn[0][1] = vgc[0][1]; vgn[1][0] = vgc[1][0]; vgn[1][1] = vgc[1][1]; } }
        const char* nA = has_next ? nxt.A : cA; const char* nB = has_next ? nxt.B : cB;
        for (int t = 0; t < nt; t += 2) {
            const bool last = (t == nt - 2);
            const char* a1 = cA + (size_t)(t + 1) * kstep;
            const char* a2 = last ? nA : cA + (size_t)(t + 2) * kstep; const char* b2 = last ? nB : cB + (size_t)(t + 2) * kstep;
            const char* a3 = a2 + kstep; const char* b3 = b2 + kstep;
            PG8_LDB(B0, 0, 0); PG8_LDB(B1, 0, 1); PG8_SCHED; PG8_LDA(At, 0, 0); PG8_STAGE_A(PG8_SA(1, 1), a1 + hsA, t + 1, 1, false);
            PG8_WAIT_V(8); PG8_WAIT_L(0); PG8_BAR; PG8_MMA(0, 0, At, B0); PG8_MMA(0, 1, At, B1); PG8_BAR; PG8_SCHED;
            PG8_LDA(At, 0, 1); PG8_STAGE(PG8_SB(0, 0), b2, voffB); PG8_STAGE(PG8_SB(0, 1), b2 + hsB, voffB); PG8_STAGE_A(PG8_SA(0, 0), a2, (last ? 0 : t + 2), 0, last);
            PG8_WAIT_V(8); PG8_WAIT_L(0); PG8_BAR; PG8_MMA(1, 0, At, B0); PG8_MMA(1, 1, At, B1); PG8_BAR; PG8_SCHED;
            PG8_LDB(B0, 1, 0); PG8_LDB(B1, 1, 1); PG8_SCHED; PG8_LDA(At, 1, 0); PG8_STAGE_A(PG8_SA(0, 1), a2 + hsA, (last ? 0 : t + 2), 1, last);
            PG8_WAIT_V(8); PG8_WAIT_L(0); PG8_BAR; PG8_MMA(0, 0, At, B0); PG8_MMA(0, 1, At, B1); PG8_BAR; PG8_SCHED;
            PG8_LDA(At, 1, 1); PG8_STAGE(PG8_SB(1, 0), b3, voffB); PG8_STAGE(PG8_SB(1, 1), b3 + hsB, voffB); PG8_STAGE_A(PG8_SA(1, 0), a3, (last ? 1 : t + 3), 0, last);
            PG8_WAIT_V(8); PG8_WAIT_L(0); PG8_BAR; PG8_MMA(1, 0, At, B0); PG8_MMA(1, 1, At, B1); PG8_BAR; PG8_SCHED;
        }
        if constexpr (ALIGN_EPI) { if (wr == 0) PG8_BAR; }
        E(acc, cur, wr, wc, fr, fq);
        if (!has_next) break;
#pragma unroll
        for (int a = 0; a < 2; ++a)
#pragma unroll
            for (int b = 0; b < 2; ++b)
#pragma unroll
                for (int m = 0; m < 4; ++m)
#pragma unroll
                    for (int n = 0; n < 2; ++n) acc[a][b][m][n] = (f32x4){0.f, 0.f, 0.f, 0.f};
        cur = nxt; cA = nA; cB = nB; ++ui;
        if constexpr (GATHER) { vgc[0][0] = vgn[0][0]; vgc[0][1] = vgn[0][1]; vgc[1][0] = vgn[1][0]; vgc[1][1] = vgn[1][1]; }
        if constexpr (ALIGN_EPI) { if (wr == 1) PG8_BAR; }
    }
    PG8_WAIT_V(0);
    if constexpr (!ALIGN_EPI) { if (wr == 0) PG8_BAR; }
    PG8_BAR;
#undef PG8_SA
#undef PG8_SB
#undef PG8_STAGE
#undef PG8_STAGE_A
#undef PG8_LDA
#undef PG8_LDB
#undef PG8_MMA
#undef PG8_WAIT_V
#undef PG8_WAIT_L
#undef PG8_BAR
#undef PG8_SCHED
}
}

struct Args {
    const float* in[26];
    float* out; unsigned char* ws;
    int ph_lo, ph_hi;
};
struct Frame {
    LAS unsigned char* lds;
    unsigned char* ws; float* out;
    int tid, lane, wave, vcu, G, bx;
};
__device__ __forceinline__ const float* inptr(int i) {
    const __attribute__((address_space(4))) unsigned char* kp = (const __attribute__((address_space(4))) unsigned char*)__builtin_amdgcn_kernarg_segment_ptr();
    asm volatile("" : "+s"(kp));
    const __attribute__((address_space(1))) float* gp = *(const __attribute__((address_space(1))) float* const __attribute__((address_space(4)))*)(kp + 8 * i);
    return (const float*)gp;
}
__device__ __forceinline__ Frame launder(const Frame& F) {
    Frame P = F; int t = F.tid; int g = F.G, v = F.vcu, wv = F.wave, bx = F.bx;
    __attribute__((address_space(1))) unsigned char* w = (__attribute__((address_space(1))) unsigned char*)F.ws; __attribute__((address_space(1))) float* o = (__attribute__((address_space(1))) float*)F.out;
    asm volatile("" : "+v"(t), "+s"(w), "+s"(o), "+s"(g), "+s"(v), "+s"(wv), "+s"(bx));
    P.tid = t; P.lane = t & 63; P.ws = (unsigned char*)w; P.out = (float*)o; P.G = g; P.vcu = v; P.wave = wv; P.bx = bx; return P;
}
enum { I_X = 0, I_C, I_CTX, I_CCTX, I_WMOD, I_BMOD, I_GMIX, I_GFFN, I_WIN, I_POOLW, I_POOLS, I_DLAM, I_DNG, I_RPB, I_QN, I_KN, I_WBR, I_WOUT, I_WRG, I_BRG, I_WRE, I_BRE, I_WEG, I_WEU, I_WED, I_GFIN };
#define WSF(off) ((float*)(F.ws + (off)))
#define WSB(off) ((bf16_t*)(F.ws + (off)))
#define WSU(off) ((unsigned*)(F.ws + (off)))

template <class RowMap>
__device__ __forceinline__ void transpose_item(const float* W, int K, int N, bf16_t* WT, int ldt, LAS float* scr, int item, int lane, const RowMap& rm) {
    const int nblk = N / 32, kb = item / nblk, nb = item % nblk, k0 = 64 * kb, n0 = 32 * nb;
#pragma unroll 8
    for (int i = 0; i < 32; ++i) { const int kk = 2 * i + (lane >> 5); scr[kk * 33 + (lane & 31)] = __builtin_nontemporal_load(W + (size_t)(k0 + kk) * N + n0 + (lane & 31)); }
    asm volatile("s_waitcnt lgkmcnt(0)" ::: "memory");
    const int c = lane & 7;
#pragma unroll
    for (int j = 0; j < 4; ++j) { const int n = (lane >> 3) + 8 * j; const LAS float* s = scr + (8 * c) * 33 + n;
        u32x4 o; o.x = pk2(s[0 * 33], s[1 * 33]); o.y = pk2(s[2 * 33], s[3 * 33]); o.z = pk2(s[4 * 33], s[5 * 33]); o.w = pk2(s[6 * 33], s[7 * 33]);
        *(u32x4*)(WT + (size_t)rm(n0 + n) * ldt + k0 + 8 * c) = o; }
    asm volatile("s_waitcnt lgkmcnt(0)" ::: "memory");
}
struct RowId { __device__ __forceinline__ int operator()(int n) const { return n; } };
struct RowGU { int up; __device__ __forceinline__ int operator()(int n) const { return 256 * (n >> 7) + 128 * up + (n & 127); } };

__device__ __forceinline__ void p0_prologue(Frame& F, int part) {
    LAS float* scr = (LAS float*)(F.lds + F.wave * 16384);
    const int gw = F.vcu * 8 + F.wave, NGW = F.G * 8;
    const float *w_in = inptr(I_WIN), *w_out = inptr(I_WOUT), *w_branch = inptr(I_WBR), *pool_w = inptr(I_POOLW), *pool_scale = inptr(I_POOLS);
    bf16_t *WIN = WSB(WS_WIN), *WOUT = WSB(WS_WOUT), *WBR = WSB(WS_WBR); float* MOD = WSF(WS_MOD);
    if (part == 1) {
    constexpr int I_IN = 16 * 200, I_OUT = 16 * 32, I_BR = 4 * 32;
    constexpr int PER_L = I_IN + I_OUT + 3 * I_BR, NITEMS = 2 * PER_L;
    for (int it = gw; it < NITEMS; it += NGW) {
        const int l = it / PER_L; int r = it % PER_L;
        if (r < I_IN) { transpose_item(w_in + (size_t)l * D * NIN, D, NIN, WIN + (size_t)l * NIN * D, D, scr, r, F.lane, RowId{}); continue; } r -= I_IN;
        if (r < I_OUT) { transpose_item(w_out + (size_t)l * D * D, D, D, WOUT + (size_t)l * D * D, D, scr, r, F.lane, RowId{}); continue; } r -= I_OUT;
        const int br = 1 + r / I_BR; r %= I_BR;
        transpose_item(w_branch + ((size_t)l * 4 + br) * 256 * D, 256, D, WBR + ((size_t)l * 4 + br) * D * D, D, scr, r, F.lane, RowId{});
    }
    for (int it = gw; it < 2 * 4 * 16 * 8; it += NGW) {
        const int l = it >> 9, g = (it >> 7) & 3, n = ((it >> 3) & 15) * 64 + F.lane, c8 = it & 7;
        const float* pw = pool_w + (size_t)(l * 4 + g) * 4096 + c8 * 8 * 64;
        const float* ps = pool_scale + l * 256 + 64 * g;
        const float* wb = w_branch + ((size_t)(l * 4 + 0) * 256 + 64 * g) * D + n;
        float o[8];
#pragma unroll
        for (int cc = 0; cc < 8; ++cc) o[cc] = 0.f;
#pragma unroll 4
        for (int cp = 0; cp < 64; ++cp) { const float w = ps[cp] * wb[(size_t)cp * D];
#pragma unroll
            for (int cc = 0; cc < 8; ++cc) o[cc] += pw[cc * 64 + cp] * w; }
        u32x4 w; w.x = pk2(o[0], o[1]); w.y = pk2(o[2], o[3]); w.z = pk2(o[4], o[5]); w.w = pk2(o[6], o[7]);
        *(u32x4*)(WBR + ((size_t)l * 4 + 0) * D * D + (size_t)n * D + 64 * g + c8 * 8) = w;
    }
    return; }
    if (F.vcu < 192) {
        const float *cvec = inptr(I_C), *c_ctx = inptr(I_CCTX), *w_mod = inptr(I_WMOD), *b_mod = inptr(I_BMOD);
        __syncthreads();
        LAS float* sv = (LAS float*)(F.lds);
        LAS float* part = (LAS float*)(F.lds + 65536);
        for (int i = F.tid; i < 9 * 1024; i += 512) { const int bb = i >> 10, k = i & 1023; const float v = bb < 8 ? cvec[bb * 1024 + k] : c_ctx[k]; sv[i] = v / (1.0f + __expf(-v)); }
        __syncthreads();
        const int l = F.vcu / 96, j = (F.vcu % 96) * 64 + F.lane;
        float acc[9];
#pragma unroll
        for (int bb = 0; bb < 9; ++bb) acc[bb] = 0.f;
        const float* wm = w_mod + (size_t)l * D * 6144 + j;
        for (int k0 = F.wave * 128; k0 < F.wave * 128 + 128; k0 += 16) { float w[16];
#pragma unroll
            for (int u = 0; u < 16; ++u) w[u] = __builtin_nontemporal_load(wm + (size_t)(k0 + u) * 6144);
#pragma unroll
            for (int u = 0; u < 16; ++u)
#pragma unroll
                for (int bb = 0; bb < 9; ++bb) acc[bb] += sv[bb * 1024 + k0 + u] * w[u]; }
#pragma unroll
        for (int bb = 0; bb < 9; ++bb) part[(F.wave * 9 + bb) * 64 + F.lane] = acc[bb];
        __syncthreads();
        for (int i = F.tid; i < 9 * 64; i += 512) { const int bb = i >> 6, jj = i & 63; float s = 0.f;
#pragma unroll
            for (int w = 0; w < 8; ++w) s += part[(w * 9 + bb) * 64 + jj];
            const int col = (F.vcu % 96) * 64 + jj;
            MOD[((size_t)l * 9 + bb) * 6144 + col] = s + b_mod[l * 6144 + col]; }
        __syncthreads();
    }
    if (F.vcu == 200 && F.tid < 2) {
        const float* diff_lambda = inptr(I_DLAM);
        const int l = F.tid; const float* lf = diff_lambda + l * 128; float s0 = 0.f, s1 = 0.f;
        for (int i = 0; i < 32; ++i) { s0 += lf[i] * lf[32 + i]; s1 += lf[64 + i] * lf[96 + i]; }
        const float lam_init = 0.8f - 0.6f * expf(-0.3f * (float)l);
        MOD[131072 + l] = expf(s0) - expf(s1) + lam_init;
    }
}

__device__ __forceinline__ void phase_modulate(Frame& F, int l, int part) {
    const int gw = F.vcu * 8 + F.wave, NGW = F.G * 8;
    const float *xin = inptr(I_X), *ctxin = inptr(I_CTX), *g_mix = inptr(I_GMIX), *g_final = inptr(I_GFIN);
    float *MOD = WSF(WS_MOD), *XCTX = WSF(WS_XCTX); unsigned* ROUTE = WSU(WS_ROUTE); bf16_t *Y = WSB(WS_Y), *PROJ = WSB(WS_PROJ);
    const bool comb = (l > 0) && (part != 2);
    for (int row0 = gw; row0 < T; row0 += 2 * NGW) {
        f32x4 v[2][4]; bool ok[2]; float* xr[2]; u32x2 pp[2]; u32x2 ya[2][4], yb[2][4];
#pragma unroll
        for (int q = 0; q < 2; ++q) {
            const int row = row0 + q * NGW; ok[q] = row < T; xr[q] = nullptr; pp[q] = (u32x2){0u, 0u};
            if (ok[q]) { const int b = row / TPB, t = row % TPB; const bool isctx = t >= SEQ;
                if (isctx && l == 2) { ok[q] = false; }
                else {
                    const float* src0 = (l == 0) ? (isctx ? ctxin + ((size_t)b * CTXL + (t - SEQ)) * D : xin + ((size_t)b * SEQ + t) * D)
                                                 : (isctx ? XCTX + ((size_t)b * CTXL + (t - SEQ)) * D : F.out + ((size_t)b * SEQ + t) * D);
                    xr[q] = const_cast<float*>(src0);
                    const f32x4* src = (const f32x4*)src0 + F.lane;
#pragma unroll
                    for (int j = 0; j < 4; ++j) v[q][j] = src[64 * j];
                    if (comb) pp[q] = *(const u32x2*)(ROUTE + (size_t)row * 8 + 6);
                } }
        }
        if (comb) {
#pragma unroll
            for (int q = 0; q < 2; ++q) if (ok[q]) {
                const u32x2* y0 = (const u32x2*)(Y + (size_t)pp[q].x * D) + F.lane; const u32x2* y1 = (const u32x2*)(Y + (size_t)pp[q].y * D) + F.lane;
#pragma unroll
                for (int j = 0; j < 4; ++j) { ya[q][j] = y0[64 * j]; yb[q][j] = y1[64 * j]; } }
        }
#pragma unroll
        for (int q = 0; q < 2; ++q) if (ok[q]) {
            const int row = row0 + q * NGW; const int b = row / TPB, t = row % TPB; const bool isctx = t >= SEQ; const int mb = isctx ? 8 : b;
            if (comb) {
                const f32x4* gt = (const f32x4*)(MOD + ((size_t)(l - 1) * 9 + mb) * 6144 + 5 * 1024) + F.lane;
#pragma unroll
                for (int j = 0; j < 4; ++j) { const u32x2 a = ya[q][j], c2 = yb[q][j]; const f32x4 g = gt[64 * j];
                    v[q][j].x += g.x * (bflo(a.x) + bflo(c2.x)); v[q][j].y += g.y * (bfhi(a.x) + bfhi(c2.x)); v[q][j].z += g.z * (bflo(a.y) + bflo(c2.y)); v[q][j].w += g.w * (bfhi(a.y) + bfhi(c2.y)); }
                if (l < 2) { f32x4* dst = (f32x4*)xr[q] + F.lane;
#pragma unroll
                    for (int j = 0; j < 4; ++j) dst[64 * j] = v[q][j]; }
            }
            if (part == 1) continue;
            float ss = 0.f;
#pragma unroll
            for (int j = 0; j < 4; ++j) ss += (v[q][j].x * v[q][j].x + v[q][j].y * v[q][j].y) + (v[q][j].z * v[q][j].z + v[q][j].w * v[q][j].w);
            const float r = rsqrtf(wave_sum(ss) * (1.0f / D) + RMS_EPS);
            if (l == 2) {
                f32x4* dst = (f32x4*)(F.out + ((size_t)b * SEQ + t) * D) + F.lane; const f32x4* g = (const f32x4*)g_final + F.lane;
#pragma unroll
                for (int j = 0; j < 4; ++j) dst[64 * j] = v[q][j] * r * g[64 * j];
            } else {
                const f32x4* g = (const f32x4*)(g_mix + l * D) + F.lane;
                const f32x4* sh = (const f32x4*)(MOD + ((size_t)l * 9 + mb) * 6144) + F.lane; const f32x4* sc = sh + 256;
                u32x2* dst = (u32x2*)(PROJ + (size_t)row * LDP + C_H) + F.lane;
#pragma unroll
                for (int j = 0; j < 4; ++j) { const f32x4 o = (v[q][j] * r * g[64 * j]) * (sc[64 * j] + 1.0f) + sh[64 * j]; u32x2 w; w.x = pk2(o.x, o.y); w.y = pk2(o.z, o.w); dst[64 * j] = w; }
            }
        }
    }
}

struct SchedIn {
    int G, c; const char* A; const char* B;
    __device__ __forceinline__ bool next(int i, pg8::Unit& u) const {
        int pm, pn; if (!pg8::tile_order(T / 256, 9, G, c, i, pm, pn)) return false;
        u.pm = pm; u.pn = pn; u.aux = 0; u.nt = D / 64; u.A = A + (size_t)pm * 256 * (LDP * 2); u.B = B + (size_t)pn * 256 * (D * 2); return true; }
};
struct EpiIn {
    bf16_t* PROJ;
    __device__ __forceinline__ void operator()(const f32x4 (&acc)[2][2][4][2], const pg8::Unit& u, int wr, int wc, int fr, int fq) const {
        const int row0 = u.pm * 256 + wr * 64 + fr;
        bf16_t* base = PROJ + (size_t)u.pn * 256 + wc * 32 + 8 * fq;
#pragma unroll
        for (int ai = 0; ai < 2; ++ai)
#pragma unroll
            for (int m = 0; m < 4; ++m) { bf16_t* rowp = base + (size_t)(row0 + ai * 128 + m * 16) * LDP;
#pragma unroll
                for (int bj = 0; bj < 2; ++bj) { const f32x4 v0 = acc[ai][bj][m][0], v1 = acc[ai][bj][m][1];
                    u32x4 w; w.x = cvt_pk_bf16(v0.x, v0.y); w.y = cvt_pk_bf16(v0.z, v0.w); w.z = cvt_pk_bf16(v1.x, v1.y); w.w = cvt_pk_bf16(v1.z, v1.w);
                    *(u32x4*)(rowp + bj * 128) = w; } }
    }
};
__device__ __forceinline__ int branch_col(int br) { return br == 0 ? C_POOL : (br == 1 ? C_DQ : (br == 2 ? C_NQ : C_GQ)); }
struct SchedMerge {
    int G, c, nM, skip, split; const char* PROJ; const char* WG; const char* WBR;
    __device__ __forceinline__ bool next(int i, pg8::Unit& u) const {
        int pm, pn, sub, aux;
        if (split && c < 128 && i < 2) { const int ct = c >> 2, br = c & 3; pm = (ct >> 2) * 17 + 16; pn = ct & 3; sub = 2 * br + i; aux = sub | 8; }
        else { const int ii = (split && c < 128) ? i - 2 : i;
            if (!pg8::tile_order(nM, 4, G, c, ii >> 3, pm, pn)) return false;
            if (skip) pm += pm >> 4;
            sub = ii & 7; aux = sub; }
        const int br = sub >> 1; u.pm = pm; u.pn = pn; u.aux = aux;
        if ((sub & 1) == 0) { u.nt = D / 64; u.A = PROJ + ((size_t)pm * 256 * LDP + C_H) * 2; u.B = WG + ((size_t)br * 1024 + (size_t)pn * 256) * (D * 2); }
        else { u.nt = 4; u.A = PROJ + ((size_t)pm * 256 * LDP + branch_col(br)) * 2; u.B = WBR + ((size_t)br * 1024 + (size_t)pn * 256) * (D * 2); }
        return true; }
};
struct EpiMerge {
    bf16_t* MERGED; bf16_t* SCR; bf16_t* SLAB;
    __device__ __forceinline__ void operator()(const f32x4 (&acc)[2][2][4][2], const pg8::Unit& u, int wr, int wc, int fr, int fq) const {
        const int sub = u.aux & 7, br = sub >> 1; const bool sjob = (u.aux & 8) != 0;
        int fr_ = fr, fq_ = fq; asm volatile("" : "+v"(fr_), "+v"(fq_));
        const int r0 = wr * 64 + fr_, c0 = wc * 32 + 8 * fq_;
        const int row0 = u.pm * 256 + r0, col0 = u.pn * 256 + c0;
        if ((sub & 1) == 0) {
#pragma unroll
            for (int ai = 0; ai < 2; ++ai)
#pragma unroll
                for (int m = 0; m < 4; ++m) { const int rl = r0 + ai * 128 + m * 16;
#pragma unroll
                    for (int bj = 0; bj < 2; ++bj) {
                        f32x4 v0 = acc[ai][bj][m][0], v1 = acc[ai][bj][m][1];
                        v0.x = sigmoidf_(v0.x); v0.y = sigmoidf_(v0.y); v0.z = sigmoidf_(v0.z); v0.w = sigmoidf_(v0.w); v1.x = sigmoidf_(v1.x); v1.y = sigmoidf_(v1.y); v1.z = sigmoidf_(v1.z); v1.w = sigmoidf_(v1.w);
                        u32x4 w; w.x = cvt_pk_bf16(v0.x, v0.y); w.y = cvt_pk_bf16(v0.z, v0.w); w.z = cvt_pk_bf16(v1.x, v1.y); w.w = cvt_pk_bf16(v1.z, v1.w);
                        *(u32x4*)(SCR + (size_t)rl * 256 + c0 + bj * 128) = w; } }
        } else {
            const bool rd = (br > 0) && !sjob;
#pragma unroll
            for (int ai = 0; ai < 2; ++ai) {
                u32x4 gq[4][2], oq[4][2];
#pragma unroll
                for (int m = 0; m < 4; ++m) { const int rl = r0 + ai * 128 + m * 16;
#pragma unroll
                    for (int bj = 0; bj < 2; ++bj) {
                        gq[m][bj] = *(const u32x4*)(SCR + (size_t)rl * 256 + c0 + bj * 128);
                        const u32x4* sp = sjob ? (const u32x4*)(SLAB + ((size_t)br * 2048 + (size_t)(u.pm / 17) * 256 + rl) * D + col0 + bj * 128)
                                               : (const u32x4*)(MERGED + (size_t)(row0 + ai * 128 + m * 16) * D + col0 + bj * 128);
                        oq[m][bj] = rd ? *sp : (u32x4){0u, 0u, 0u, 0u}; } }
#pragma unroll
                for (int m = 0; m < 4; ++m) { const int rl = r0 + ai * 128 + m * 16;
#pragma unroll
                    for (int bj = 0; bj < 2; ++bj) {
                        f32x4 v0 = acc[ai][bj][m][0], v1 = acc[ai][bj][m][1]; const u32x4 g4 = gq[m][bj], o = oq[m][bj];
                        v0.x = v0.x * bflo(g4.x) + bflo(o.x); v0.y = v0.y * bfhi(g4.x) + bfhi(o.x); v0.z = v0.z * bflo(g4.y) + bflo(o.y); v0.w = v0.w * bfhi(g4.y) + bfhi(o.y);
                        v1.x = v1.x * bflo(g4.z) + bflo(o.z); v1.y = v1.y * bfhi(g4.z) + bfhi(o.z); v1.z = v1.z * bflo(g4.w) + bflo(o.w); v1.w = v1.w * bfhi(g4.w) + bfhi(o.w);
                        u32x4 w; w.x = cvt_pk_bf16(v0.x, v0.y); w.y = cvt_pk_bf16(v0.z, v0.w); w.z = cvt_pk_bf16(v1.x, v1.y); w.w = cvt_pk_bf16(v1.z, v1.w);
                        u32x4* sp = sjob ? (u32x4*)(SLAB + ((size_t)br * 2048 + (size_t)(u.pm / 17) * 256 + rl) * D + col0 + bj * 128)
                                         : (u32x4*)(MERGED + (size_t)(row0 + ai * 128 + m * 16) * D + col0 + bj * 128);
                        *sp = w; } }
            }
        }
    }
};
struct SchedOut {
    int G, c, nM, skip; const char* A; const char* B; const char* PRIV;
    __device__ __forceinline__ bool next(int i, pg8::Unit& u) const {
        int pm, pn;
        if (PRIV != nullptr) {
            if (c < 32) { if (i == 0) { pm = (c >> 2) * 17 + 16; pn = c & 3; } else if (i == 1) { if (!pg8::tile_order(128, 4, G, c, 0, pm, pn)) return false; pm += pm >> 4; } else return false; }
            else if (c < 64 && i == 2) { if (!pg8::tile_order(128, 4, G, c - 32, 1, pm, pn)) return false; pm += pm >> 4; }
            else { if (i >= 2 || !pg8::tile_order(128, 4, G, c, i, pm, pn)) return false; pm += pm >> 4; }
        } else { if (!pg8::tile_order(nM, 4, G, c, i, pm, pn)) return false; if (skip) pm += pm >> 4; }
        u.pm = pm; u.pn = pn; u.aux = 0; u.nt = D / 64; u.B = B + (size_t)pn * 256 * (D * 2);
        u.A = (PRIV != nullptr && pm % 17 == 16) ? PRIV + (size_t)((pm / 17) * 4 + pn) * (256 * D * 2) : A + (size_t)pm * 256 * (D * 2);
        return true; }
};
__device__ __forceinline__ void sum_ctx_slabs(Frame& F, const SchedOut& S) {
    const bf16_t* SLAB = WSB(WS_SLAB); bf16_t* PRIV = WSB(WS_PRIV);
    for (int i = 0; i < 4; ++i) { pg8::Unit u; if (!S.next(i, u)) break;
        if (u.pm % 17 != 16) continue;
        const int b = u.pm / 17; bf16_t* dst = PRIV + (size_t)(b * 4 + u.pn) * 256 * D;
        for (int ch0 = F.tid; ch0 < 256 * 128; ch0 += 8 * 512) {
            u32x4 w[8][4];
#pragma unroll
            for (int q = 0; q < 8; ++q) { const int ch = ch0 + q * 512, r = ch >> 7, c8 = (ch & 127) * 8;
#pragma unroll
                for (int br = 0; br < 4; ++br) w[q][br] = *(const u32x4*)(SLAB + ((size_t)br * 2048 + (size_t)b * 256 + r) * D + c8); }
#pragma unroll
            for (int q = 0; q < 8; ++q) { const int ch = ch0 + q * 512, r = ch >> 7, c8 = (ch & 127) * 8; float s[8];
#pragma unroll
                for (int e = 0; e < 8; ++e) s[e] = 0.f;
#pragma unroll
                for (int br = 0; br < 4; ++br) { const u32x4 x = w[q][br];
                    s[0] += bflo(x.x); s[1] += bfhi(x.x); s[2] += bflo(x.y); s[3] += bfhi(x.y); s[4] += bflo(x.z); s[5] += bfhi(x.z); s[6] += bflo(x.w); s[7] += bfhi(x.w); }
                u32x4 o; o.x = pk2(s[0], s[1]); o.y = pk2(s[2], s[3]); o.z = pk2(s[4], s[5]); o.w = pk2(s[6], s[7]);
                *(u32x4*)(dst + (size_t)r * D + c8) = o; } } }
    asm volatile("s_waitcnt vmcnt(0)" ::: "memory");
    __syncthreads();
}
struct EpiOut {
    const float* xlat_src; const float* xctx_src; float* out; float* XCTX; const float* MODL;
    __device__ __forceinline__ void operator()(const f32x4 (&acc)[2][2][4][2], const pg8::Unit& u, int wr, int wc, int fr, int fq) const {
        const int b = u.pm / 17, j = u.pm % 17; const bool isctx = j == 16;
        const size_t rbase = isctx ? (size_t)b * CTXL : (size_t)b * SEQ + j * 256;
        const float* src = isctx ? xctx_src : xlat_src; float* dst = isctx ? XCTX : out;
        const float* gt = MODL + (size_t)(isctx ? 8 : b) * 6144 + 2 * 1024;
        const int r0 = wr * 64 + fr, col0 = u.pn * 256 + wc * 32 + 8 * fq;
        f32x4 g[2][2];
#pragma unroll
        for (int bj = 0; bj < 2; ++bj) { g[bj][0] = *(const f32x4*)(gt + col0 + bj * 128); g[bj][1] = *(const f32x4*)(gt + col0 + bj * 128 + 4); }
#pragma unroll
        for (int ai = 0; ai < 2; ++ai) {
            f32x4 xs[4][2][2];
#pragma unroll
            for (int m = 0; m < 4; ++m) { const size_t off = (rbase + r0 + ai * 128 + m * 16) * D + col0;
#pragma unroll
                for (int bj = 0; bj < 2; ++bj) { xs[m][bj][0] = *(const f32x4*)(src + off + bj * 128); xs[m][bj][1] = *(const f32x4*)(src + off + bj * 128 + 4); } }
#pragma unroll
            for (int m = 0; m < 4; ++m) { const size_t off = (rbase + r0 + ai * 128 + m * 16) * D + col0;
#pragma unroll
                for (int bj = 0; bj < 2; ++bj) {
                    *(f32x4*)(dst + off + bj * 128) = xs[m][bj][0] + g[bj][0] * acc[ai][bj][m][0];
                    *(f32x4*)(dst + off + bj * 128 + 4) = xs[m][bj][1] + g[bj][1] * acc[ai][bj][m][1]; } }
        }
    }
};
template <int KD>
struct SchedMoe {
    int G, c, ntiles; const LAS int* tile_e; const char* A; const char* B;
    __device__ __forceinline__ bool next(int i, pg8::Unit& u) const {
        const int L = i * G + c; if (L >= ntiles * 4) return false;
        const int k = L >> 2, j = L & 3, e = __builtin_amdgcn_readfirstlane(tile_e[k]);
        u.pm = k; u.pn = j; u.aux = e; u.nt = KD / 64; u.A = A + (size_t)k * (256 * KD * 2); u.B = B + ((size_t)e * 1024 + (size_t)j * 256) * (KD * 2); return true; }
};
struct EpiGU {
    bf16_t* HMID;
    __device__ __forceinline__ void operator()(const f32x4 (&acc)[2][2][4][2], const pg8::Unit& u, int wr, int wc, int fr, int fq) const {
        const int row0 = u.pm * 256 + wr * 64 + fr, col0 = u.pn * 128 + wc * 32 + 8 * fq;
#pragma unroll
        for (int ai = 0; ai < 2; ++ai)
#pragma unroll
            for (int m = 0; m < 4; ++m) {
                float h[8];
#pragma unroll
                for (int n = 0; n < 2; ++n)
#pragma unroll
                    for (int e = 0; e < 4; ++e) { const float gv = acc[ai][0][m][n][e], uv = acc[ai][1][m][n][e]; h[n * 4 + e] = gv * sigmoidf_(gv) * uv; }
                u32x4 w; w.x = cvt_pk_bf16(h[0], h[1]); w.y = cvt_pk_bf16(h[2], h[3]); w.z = cvt_pk_bf16(h[4], h[5]); w.w = cvt_pk_bf16(h[6], h[7]);
                *(u32x4*)(HMID + (size_t)(row0 + ai * 128 + m * 16) * DEXP + col0) = w; }
    }
};
struct EpiDown {
    bf16_t* Y; const float* ROWW;
    __device__ __forceinline__ void operator()(const f32x4 (&acc)[2][2][4][2], const pg8::Unit& u, int wr, int wc, int fr, int fq) const {
        const int row0 = u.pm * 256 + wr * 64 + fr, col0 = u.pn * 256 + wc * 32 + 8 * fq;
#pragma unroll
        for (int ai = 0; ai < 2; ++ai)
#pragma unroll
            for (int m = 0; m < 4; ++m) { const size_t row = (size_t)(row0 + ai * 128 + m * 16); const float w8 = ROWW[row];
#pragma unroll
                for (int bj = 0; bj < 2; ++bj) { const f32x4 v0 = acc[ai][bj][m][0] * w8, v1 = acc[ai][bj][m][1] * w8;
                    u32x4 w; w.x = cvt_pk_bf16(v0.x, v0.y); w.y = cvt_pk_bf16(v0.z, v0.w); w.z = cvt_pk_bf16(v1.x, v1.y); w.w = cvt_pk_bf16(v1.z, v1.w);
                    *(u32x4*)(Y + row * D + col0 + bj * 128) = w; } }
    }
};

constexpr int ROPE_T8 = 131072, ROPE_T16 = 131072 + 64 * 8 * 2 * 4;
template <int NF>
__device__ __forceinline__ void rope8(float (&v)[8], float (&o)[8], const LAS f32x2* tab, int pos, int i0, bool second) {
#pragma unroll
    for (int e = 0; e < 8; ++e) { const f32x2 cs = tab[pos * NF + i0 + e]; v[e] = second ? (o[e] * cs.y + v[e] * cs.x) : (v[e] * cs.x - o[e] * cs.y); }
}
__device__ __forceinline__ void phase_post(Frame& F, int l) {
    const int gw = F.vcu * 8 + F.wave, NGW = F.G * 8, lane = F.lane;
    const float *gqa_q_norm = inptr(I_QN), *gqa_k_norm = inptr(I_KN); bf16_t *PROJ = WSB(WS_PROJ), *VT = WSB(WS_VT);
    { LAS f32x2* t8 = (LAS f32x2*)(F.lds + ROPE_T8); LAS f32x2* t16 = (LAS f32x2*)(F.lds + ROPE_T16);
      for (int i = F.tid; i < 64 * 8; i += 512) { const int pos = i >> 3, f = i & 7; float sn, cs; sincosf((float)pos * exp2f(-(float)f * (13.287712379549449f / 8.0f)), &sn, &cs); t8[i] = (f32x2){cs, sn}; }
      for (int i = F.tid; i < 64 * 16; i += 512) { const int pos = i >> 4, f = i & 15; float sn, cs; sincosf((float)pos * exp2f(-(float)f * (13.287712379549449f / 16.0f)), &sn, &cs); t16[i] = (f32x2){cs, sn}; }
      __syncthreads(); }
    const LAS f32x2* t8 = (const LAS f32x2*)(F.lds + ROPE_T8); const LAS f32x2* t16 = (const LAS f32x2*)(F.lds + ROPE_T16);
    for (int row = gw; row < T; row += NGW) {
        const int b = row / TPB, t = row % TPB; const bool isctx = t >= SEQ; (void)b;
        bf16_t* pr = PROJ + (size_t)row * LDP;
        const int prow = t >> 6, pcol = t & 63;
        const bool gact = lane < 48; const int lc = gact ? lane : 0;
        const u32x4 wD = *(const u32x4*)(pr + C_DQ + lane * 8);
        const u32x4 wN = *(const u32x4*)(pr + C_NQ + (lane & 31) * 8);
        const u32x4 wG = *(const u32x4*)(pr + C_GQ + lc * 8);
        const int win = 2 << (lane >> 4), nseq = isctx ? CTXL : SEQ, ts = isctx ? t - SEQ : t;
        const int lo = max(ts - win / 2, 0), hi = min(ts + win / 2, nseq);
        const bf16_t* ub = PROJ + ((size_t)(row - ts)) * LDP + lane * 4;
        u32x2 wu[16];
#pragma unroll
        for (int i = 0; i < 16; ++i) { const int ii = ts - 8 + i; wu[i] = (ii >= lo && ii < hi) ? *(const u32x2*)(ub + (size_t)ii * LDP) : (u32x2){0u, 0u}; }
        const u32x2 wself = *(const u32x2*)(ub + (size_t)ts * LDP);
        {
            u32x4 w = wD;
            float v[8] = {bflo(w.x), bfhi(w.x), bflo(w.y), bfhi(w.y), bflo(w.z), bfhi(w.z), bflo(w.w), bfhi(w.w)};
            if (!isctx) {
                float o[8];
#pragma unroll
                for (int e = 0; e < 8; ++e) o[e] = swz_xor<1>(v[e]);
                rope8<8>(v, o, t8, (lane & 2) ? pcol : prow, 0, (lane & 1) != 0);
            }
            const float sc = lane < 32 ? 0.17677669529663687f * LOG2E : 1.0f;
#pragma unroll
            for (int e = 0; e < 8; ++e) v[e] *= sc;
            w.x = pk2(v[0], v[1]); w.y = pk2(v[2], v[3]); w.z = pk2(v[4], v[5]); w.w = pk2(v[6], v[7]);
            *(u32x4*)(pr + C_DQ + lane * 8) = w;
        }
        if (lane < 32) {
            u32x4 w = wN; const float sc = 0.125f * LOG2E;
            w.x = pk2(bflo(w.x) * sc, bfhi(w.x) * sc); w.y = pk2(bflo(w.y) * sc, bfhi(w.y) * sc); w.z = pk2(bflo(w.z) * sc, bfhi(w.z) * sc); w.w = pk2(bflo(w.w) * sc, bfhi(w.w) * sc);
            *(u32x4*)(pr + C_NQ + lane * 8) = w;
        }
        {
            u32x4 w = wG;
            float v[8] = {bflo(w.x), bfhi(w.x), bflo(w.y), bfhi(w.y), bflo(w.z), bfhi(w.z), bflo(w.w), bfhi(w.w)};
            float ss = 0.f;
#pragma unroll
            for (int e = 0; e < 8; ++e) ss += v[e] * v[e];
            ss = sum8(ss);
            const float r = rsqrtf(ss * (1.0f / 64.0f) + RMS_EPS);
            const float* gn = (lc < 32 ? gqa_q_norm : gqa_k_norm) + l * 64 + (lc & 7) * 8;
#pragma unroll
            for (int e = 0; e < 8; ++e) v[e] = v[e] * r * gn[e];
            float o[8];
#pragma unroll
            for (int e = 0; e < 8; ++e) o[e] = swz_xor<2>(v[e]);
            if (!isctx) rope8<16>(v, o, t16, (lc & 4) ? pcol : prow, (lc & 1) * 8, (lc & 2) != 0);
            const float sc = lc < 32 ? 0.125f * LOG2E : 1.0f;
#pragma unroll
            for (int e = 0; e < 8; ++e) v[e] *= sc;
            w.x = pk2(v[0], v[1]); w.y = pk2(v[2], v[3]); w.z = pk2(v[4], v[5]); w.w = pk2(v[6], v[7]);
            if (gact) *(u32x4*)(pr + C_GQ + lc * 8) = w;
        }
        {
            float s0 = 0.f, s1 = 0.f, s2 = 0.f, s3 = 0.f;
#pragma unroll
            for (int i = 0; i < 16; ++i) { s0 += bflo(wu[i].x); s1 += bfhi(wu[i].x); s2 += bflo(wu[i].y); s3 += bfhi(wu[i].y); }
            const float inv = 1.0f / (float)(hi - lo);
            u32x2 o; o.x = pk2(s0 * inv - bflo(wself.x), s1 * inv - bfhi(wself.x)); o.y = pk2(s2 * inv - bflo(wself.y), s3 * inv - bfhi(wself.y));
            *(u32x2*)(pr + C_POOL + lane * 4) = o;
        }
    }
    LAS bf16_t* scr = (LAS bf16_t*)(F.lds + F.wave * 16384);
    for (int it = gw; it < (T / 64) * 10; it += NGW) {
        const int tt = it / 10, vh = it % 10, b = tt / 68, key0 = (tt % 68) * 64;
        const int vcol = vh < 4 ? C_DV + 64 * vh : (vh < 8 ? C_NV + 64 * (vh - 4) : C_GV + 64 * (vh - 8));
        const int lt = lane >> 3, lch = lane & 7;
        u32x4 w[8];
#pragma unroll
        for (int g = 0; g < 8; ++g) w[g] = *(const u32x4*)(PROJ + ((size_t)tt * 64 + g * 8 + lt) * LDP + vcol + lch * 8);
#pragma unroll
        for (int g = 0; g < 8; ++g) { const int tok = g * 8 + lt; LAS bf16_t* s = scr + (lch * 8) * 66 + tok;
            s[0 * 66] = (bf16_t)(w[g].x & 0xffff); s[1 * 66] = (bf16_t)(w[g].x >> 16); s[2 * 66] = (bf16_t)(w[g].y & 0xffff); s[3 * 66] = (bf16_t)(w[g].y >> 16);
            s[4 * 66] = (bf16_t)(w[g].z & 0xffff); s[5 * 66] = (bf16_t)(w[g].z >> 16); s[6 * 66] = (bf16_t)(w[g].w & 0xffff); s[7 * 66] = (bf16_t)(w[g].w >> 16); }
        asm volatile("s_waitcnt lgkmcnt(0)" ::: "memory");
#pragma unroll
        for (int g = 0; g < 8; ++g) { const int d = g * 8 + lt; const LAS unsigned* rd = (const LAS unsigned*)(scr + d * 66) + lch * 4;
            u32x4 o; o.x = rd[0]; o.y = rd[1]; o.z = rd[2]; o.w = rd[3];
            *(u32x4*)(VT + (((size_t)b * 10 + vh) * 64 + d) * TPB + key0 + lch * 8) = o; }
        asm volatile("s_waitcnt lgkmcnt(0)" ::: "memory");
    }
}

constexpr int ATT_K = 0, ATT_V = 16384, ATT_BIAS = 32768, ATT_Q = 36864;
constexpr float ATT_THR = 6.0f;
template <int MODE>
__device__ __forceinline__ void attn_unit(Frame& F, int l, int b, int h, int qt) {
    LAS unsigned char* lds = F.lds;
    bf16_t* PROJ = WSB(WS_PROJ); const bf16_t* VT = WSB(WS_VT);
    int tid_ = F.tid; asm volatile("" : "+v"(tid_));
    const int tid = tid_, lane = tid & 63, wid = F.wave, r32 = lane & 31, hi = lane >> 5;
    const int qcol = MODE == 0 ? C_GQ + 64 * h : (MODE == 1 ? C_DQ + 64 * h : C_NQ + 64 * h);
    const int kcol = MODE == 0 ? C_GK + 64 * (h >> 1) : (MODE == 1 ? C_DK + 64 * h : C_NK + 64 * h);
    const int vh = MODE == 0 ? 8 + (h >> 1) : (MODE == 1 ? h : 4 + h);
    const size_t rowbase = (size_t)b * TPB;
    const size_t qrow = rowbase + (size_t)qt * 256 + wid * 32 + r32;
    int a0, nA, b0 = 0, nBt = 0;
    if (qt == 16) { a0 = 64; nA = 4; }
    else if (MODE == 2) { a0 = 64; nA = 4; b0 = min(max(4 * qt - 4, 0), 56); nBt = min(max(4 * qt - 1, 0), 56) + 8 - b0; }
    else { a0 = 0; nA = 68; }
    const int ntl = nA + nBt;
    bf16x8 qr[4];
    { const bf16_t* qp = PROJ + qrow * LDP + qcol + 8 * hi;
#pragma unroll
      for (int s = 0; s < 4; ++s) qr[s] = *(const bf16x8*)(qp + 16 * s); }
    const int srow = tid >> 3, sch = tid & 7;
    const bf16_t* kg = PROJ + (rowbase + srow) * LDP + kcol + sch * 8;
    const bf16_t* vg = VT + (((size_t)b * 10 + vh) * 64 + srow) * TPB + sch * 8;
    const int swz = (srow >> 1) & 7;
    const int kst = srow * 128 + ((sch ^ swz) << 4), vst = ATT_V + srow * 128 + ((sch ^ swz) << 4);
    const bool vswap = (srow & 16) != 0;
    const int rsw = (r32 >> 1) & 7;
    const int kfr = r32 * 128;
    const int vfr = ATT_V + r32 * 128 + 8 * (hi ^ ((r32 >> 4) & 1));
    if (MODE == 2 && qt < 16) { for (int i = tid; i < 465; i += 512) ((LAS float*)(lds + ATT_BIAS))[i] = inptr(I_RPB)[((size_t)l * 4 + h) * 465 + i] * LOG2E; }
    float m0 = 0.f, l0 = 0.f, m1 = 0.f, l1 = 0.f;
    f32x16 oA[2], oB[2];
#pragma unroll
    for (int i = 0; i < 2; ++i) { oA[i] = (f32x16){}; oB[i] = (f32x16){}; }
    f32x16 ngm0 = (f32x16){}, ngm1 = (f32x16){};
    const int qgr = 4 * qt + (wid >> 1), qj = 32 * (wid & 1) + r32;
    const int wstart = min(max(qgr - 4, 0), 56), cst = min(max(qj - 8, 0), 48);

    auto tile_key0 = [&](int i) -> int { return (i < nA ? a0 + i : b0 + (i - nA)) * 64; };
    if constexpr (MODE == 0) {
        constexpr int PV0 = 32768;
        const int nst = ntl >> 1;
        u32x4 kr[2], vr[2];
#pragma unroll
        for (int u = 0; u < 2; ++u) { const int k0 = tile_key0(u); kr[u] = *(const u32x4*)(kg + (size_t)k0 * LDP); vr[u] = *(const u32x4*)(vg + k0); }
#pragma unroll
        for (int u = 0; u < 2; ++u) { *(LAS u32x4*)(lds + u * 8192 + kst) = kr[u]; u32x4 vv = vr[u]; if (vswap) vv = (u32x4){vr[u].z, vr[u].w, vr[u].x, vr[u].y}; *(LAS u32x4*)(lds + PV0 - ATT_V + u * 8192 + vst) = vv; }
        __syncthreads();
        for (int ip = 0; ip < nst; ++ip) {
            const int buf = (ip & 1) * 16384;
            if (ip + 1 < nst) {
#pragma unroll
                for (int u = 0; u < 2; ++u) { const int k0 = tile_key0(2 * ip + 2 + u); kr[u] = *(const u32x4*)(kg + (size_t)k0 * LDP); vr[u] = *(const u32x4*)(vg + k0); } }
            f32x16 p[2][2];
#pragma unroll
            for (int u = 0; u < 2; ++u) { p[u][0] = ngm0; p[u][1] = ngm0;
#pragma unroll
                for (int s = 0; s < 4; ++s) {
                    const bf16x8 k0f = *(const LAS bf16x8*)(lds + buf + u * 8192 + kfr + (((2 * s + hi) ^ rsw) << 4));
                    const bf16x8 k1f = *(const LAS bf16x8*)(lds + buf + u * 8192 + kfr + 4096 + (((2 * s + hi) ^ rsw) << 4));
                    p[u][0] = __builtin_amdgcn_mfma_f32_32x32x16_bf16(k0f, qr[s], p[u][0], 0, 0, 0);
                    p[u][1] = __builtin_amdgcn_mfma_f32_32x32x16_bf16(k1f, qr[s], p[u][1], 0, 0, 0);
                } }
            float mxa = -3.0e38f, mxb = -3.0e38f;
#pragma unroll
            for (int u = 0; u < 2; ++u)
#pragma unroll
                for (int r = 0; r < 16; r += 2) { mxa = __builtin_fmaxf(__builtin_fmaxf(mxa, p[u][0][r]), p[u][0][r + 1]); mxb = __builtin_fmaxf(__builtin_fmaxf(mxb, p[u][1][r]), p[u][1][r + 1]); }
            const float dgrow = half_max(__builtin_fmaxf(mxa, mxb));
            if (ip == 0 || __builtin_amdgcn_ballot_w64(dgrow > ATT_THR) != 0ull) {
                const float dn = (ip == 0) ? dgrow : __builtin_fmaxf(dgrow, 0.f);
                const float alpha = (ip == 0) ? 0.f : fast_exp2(-dn);
                m0 += dn; l0 *= alpha; oA[0] = oA[0] * alpha; oA[1] = oA[1] * alpha; ngm0 = ngm0 - dn;
#pragma unroll
                for (int u = 0; u < 2; ++u) { p[u][0] = p[u][0] - dn; p[u][1] = p[u][1] - dn; }
            }
            bf16x8 pk[2][4];
#pragma unroll
            for (int u = 0; u < 2; ++u) {
#pragma unroll
                for (int r = 0; r < 16; ++r) { p[u][0][r] = fast_exp2(p[u][0][r]); p[u][1][r] = fast_exp2(p[u][1][r]); }
                { const f32x16 sv = p[u][0] + p[u][1]; const f32x4 s4 = (f32x4){sv[0], sv[1], sv[2], sv[3]} + (f32x4){sv[4], sv[5], sv[6], sv[7]} + (f32x4){sv[8], sv[9], sv[10], sv[11]} + (f32x4){sv[12], sv[13], sv[14], sv[15]};
                  l0 += (s4.x + s4.y) + (s4.z + s4.w); }
#pragma unroll
                for (int s = 0; s < 4; ++s) { u32x4 w; const f32x16& pp = p[u][s >> 1]; const int q8 = 8 * (s & 1);
                    w.x = cvt_pk_bf16(pp[q8 + 0], pp[q8 + 1]); w.y = cvt_pk_bf16(pp[q8 + 2], pp[q8 + 3]); w.z = cvt_pk_bf16(pp[q8 + 4], pp[q8 + 5]); w.w = cvt_pk_bf16(pp[q8 + 6], pp[q8 + 7]);
                    pk[u][s] = __builtin_bit_cast(bf16x8, w); }
            }
            if (ip + 1 < nst) { const int nb = ((ip + 1) & 1) * 16384;
#pragma unroll
                for (int u = 0; u < 2; ++u) { *(LAS u32x4*)(lds + nb + u * 8192 + kst) = kr[u]; u32x4 vv = vr[u]; if (vswap) vv = (u32x4){vr[u].z, vr[u].w, vr[u].x, vr[u].y}; *(LAS u32x4*)(lds + PV0 - ATT_V + nb + u * 8192 + vst) = vv; } }
#pragma unroll
            for (int u = 0; u < 2; ++u)
#pragma unroll
                for (int db = 0; db < 2; ++db)
#pragma unroll
                    for (int s = 0; s < 4; ++s) {
                        const u32x2 lo = *(const LAS u32x2*)(lds + PV0 - ATT_V + buf + u * 8192 + vfr + 4096 * db + (((2 * s) ^ rsw) << 4));
                        const u32x2 hh = *(const LAS u32x2*)(lds + PV0 - ATT_V + buf + u * 8192 + vfr + 4096 * db + (((2 * s + 1) ^ rsw) << 4));
                        const bf16x8 vf = __builtin_bit_cast(bf16x8, (u32x4){lo.x, lo.y, hh.x, hh.y});
                        oA[db] = __builtin_amdgcn_mfma_f32_32x32x16_bf16(vf, pk[u][s], oA[db], 0, 0, 0);
                    }
            __syncthreads();
        }
    } else {
    u32x4 kreg, vreg;
    { const int k0 = tile_key0(0); kreg = *(const u32x4*)(kg + (size_t)k0 * LDP); vreg = *(const u32x4*)(vg + k0); }
    { *(LAS u32x4*)(lds + kst) = kreg; u32x4 vv = vreg; if (vswap) vv = (u32x4){vreg.z, vreg.w, vreg.x, vreg.y}; *(LAS u32x4*)(lds + vst) = vv; }
    __syncthreads();
    for (int i = 0; i < ntl; ++i) {
        const int buf = (i & 1) * 8192;
        if (i + 1 < ntl) { const int k0 = tile_key0(i + 1); kreg = *(const u32x4*)(kg + (size_t)k0 * LDP); vreg = *(const u32x4*)(vg + k0); }
        bool part = true; int dr = 0;
        if (MODE == 2 && i >= nA) { const int kr = b0 + (i - nA); part = (kr >= wstart) && (kr < wstart + 8); dr = kr - qgr + 7; }
        if (part) {
            bf16x8 pk[MODE == 1 ? 2 : 1][4];
#pragma unroll
            for (int c = 0; c < (MODE == 1 ? 2 : 1); ++c) {
                f32x16& ngm = (c == 0) ? ngm0 : ngm1;
                f32x16 p0 = ngm, p1 = ngm;
#pragma unroll
                for (int s = (MODE == 1 ? 2 * c : 0); s < (MODE == 1 ? 2 * c + 2 : 4); ++s) {
                    const bf16x8 k0f = *(const LAS bf16x8*)(lds + buf + kfr + (((2 * s + hi) ^ rsw) << 4));
                    const bf16x8 k1f = *(const LAS bf16x8*)(lds + buf + kfr + 4096 + (((2 * s + hi) ^ rsw) << 4));
                    p0 = __builtin_amdgcn_mfma_f32_32x32x16_bf16(k0f, qr[s], p0, 0, 0, 0);
                    p1 = __builtin_amdgcn_mfma_f32_32x32x16_bf16(k1f, qr[s], p1, 0, 0, 0);
                }
                if (MODE == 2 && i >= nA) {
                    const LAS float* bt = (const LAS float*)(lds + ATT_BIAS) + dr * 31 + 15 - qj;
#pragma unroll
                    for (int r = 0; r < 16; ++r) { const int kj = (r & 3) + 8 * (r >> 2) + 4 * hi;
                        { const int ix = min(max(kj - qj, -15), 15) + qj; const bool ok = (kj >= cst) && (kj < cst + 16); p0[r] = ok ? p0[r] + bt[ix] : -1e30f; }
                        { const int k2 = kj + 32; const int ix = min(max(k2 - qj, -15), 15) + qj; const bool ok = (k2 >= cst) && (k2 < cst + 16); p1[r] = ok ? p1[r] + bt[ix] : -1e30f; } }
                }
                float& mm = (c == 0) ? m0 : m1; float& ll = (c == 0) ? l0 : l1; f32x16* oo = (c == 0) ? oA : oB;
                float mxa = __builtin_fmaxf(__builtin_fmaxf(p0[0], p0[1]), p1[0]), mxb = __builtin_fmaxf(__builtin_fmaxf(p0[2], p0[3]), p1[1]);
                mxa = __builtin_fmaxf(__builtin_fmaxf(mxa, p1[2]), p1[3]);
#pragma unroll
                for (int r = 4; r < 16; r += 4) { mxa = __builtin_fmaxf(__builtin_fmaxf(mxa, p0[r]), p0[r + 1]); mxb = __builtin_fmaxf(__builtin_fmaxf(mxb, p0[r + 2]), p0[r + 3]);
                    mxa = __builtin_fmaxf(__builtin_fmaxf(mxa, p1[r]), p1[r + 1]); mxb = __builtin_fmaxf(__builtin_fmaxf(mxb, p1[r + 2]), p1[r + 3]); }
                const float dgrow = half_max(__builtin_fmaxf(mxa, mxb));
                if (i == 0 || __builtin_amdgcn_ballot_w64(dgrow > ATT_THR) != 0ull) {
                    const float dn = (i == 0) ? dgrow : __builtin_fmaxf(dgrow, 0.f);
                    const float alpha = (i == 0) ? 0.f : fast_exp2(-dn);
                    mm += dn; ll *= alpha; oo[0] = oo[0] * alpha; oo[1] = oo[1] * alpha; ngm = ngm - dn; p0 = p0 - dn; p1 = p1 - dn;
                }
#pragma unroll
                for (int r = 0; r < 16; ++r) { p0[r] = fast_exp2(p0[r]); p1[r] = fast_exp2(p1[r]); }
                { const f32x16 sv = p0 + p1; const f32x4 s4 = (f32x4){sv[0], sv[1], sv[2], sv[3]} + (f32x4){sv[4], sv[5], sv[6], sv[7]} + (f32x4){sv[8], sv[9], sv[10], sv[11]} + (f32x4){sv[12], sv[13], sv[14], sv[15]};
                  ll += (s4.x + s4.y) + (s4.z + s4.w); }
#pragma unroll
                for (int s = 0; s < 4; ++s) { u32x4 w;
                    if (s < 2) { w.x = cvt_pk_bf16(p0[8 * s + 0], p0[8 * s + 1]); w.y = cvt_pk_bf16(p0[8 * s + 2], p0[8 * s + 3]); w.z = cvt_pk_bf16(p0[8 * s + 4], p0[8 * s + 5]); w.w = cvt_pk_bf16(p0[8 * s + 6], p0[8 * s + 7]); }
                    else { const int q8 = 8 * (s - 2); w.x = cvt_pk_bf16(p1[q8 + 0], p1[q8 + 1]); w.y = cvt_pk_bf16(p1[q8 + 2], p1[q8 + 3]); w.z = cvt_pk_bf16(p1[q8 + 4], p1[q8 + 5]); w.w = cvt_pk_bf16(p1[q8 + 6], p1[q8 + 7]); }
                    pk[c][s] = __builtin_bit_cast(bf16x8, w); }
            }
            if (MODE == 1 && i + 1 < ntl) { const int nb = ((i + 1) & 1) * 8192; *(LAS u32x4*)(lds + nb + kst) = kreg; u32x4 vv = vreg; if (vswap) vv = (u32x4){vreg.z, vreg.w, vreg.x, vreg.y}; *(LAS u32x4*)(lds + nb + vst) = vv; }
#pragma unroll
            for (int db = 0; db < 2; ++db)
#pragma unroll
                for (int s = 0; s < 4; ++s) {
                    const u32x2 lo = *(const LAS u32x2*)(lds + buf + vfr + 4096 * db + (((2 * s) ^ rsw) << 4));
                    const u32x2 hh = *(const LAS u32x2*)(lds + buf + vfr + 4096 * db + (((2 * s + 1) ^ rsw) << 4));
                    const bf16x8 vf = __builtin_bit_cast(bf16x8, (u32x4){lo.x, lo.y, hh.x, hh.y});
                    oA[db] = __builtin_amdgcn_mfma_f32_32x32x16_bf16(vf, pk[0][s], oA[db], 0, 0, 0);
                    if (MODE == 1) oB[db] = __builtin_amdgcn_mfma_f32_32x32x16_bf16(vf, pk[MODE == 1 ? 1 : 0][s], oB[db], 0, 0, 0);
                }
        }
        if (MODE != 1 && i + 1 < ntl) { const int nb = ((i + 1) & 1) * 8192; *(LAS u32x4*)(lds + nb + kst) = kreg; u32x4 vv = vreg; if (vswap) vv = (u32x4){vreg.z, vreg.w, vreg.x, vreg.y}; *(LAS u32x4*)(lds + nb + vst) = vv; }
        __syncthreads();
    }
    }
    bf16_t* op = PROJ + qrow * LDP + qcol + 4 * hi;
    if (MODE == 1) {
        const float lam = WSF(WS_MOD)[131072 + l], lam_init = 0.8f - 0.6f * expf(-0.3f * (float)l);
        const float i0 = 1.0f / half_sum(l0), i1 = lam / half_sum(l1);
        float ss = 0.f;
#pragma unroll
        for (int db = 0; db < 2; ++db)
#pragma unroll
            for (int r = 0; r < 16; ++r) { const float v = oA[db][r] * i0 - oB[db][r] * i1; oA[db][r] = v; ss += v * v; }
        ss = half_sum(ss);
        const float rn = rsqrtf(ss * (1.0f / 64.0f) + RMS_EPS) * (1.0f - lam_init);
        const float* gn = inptr(I_DNG) + l * 64 + 4 * hi;
#pragma unroll
        for (int db = 0; db < 2; ++db)
#pragma unroll
            for (int g4 = 0; g4 < 4; ++g4) { const f32x4 g = *(const f32x4*)(gn + 32 * db + 8 * g4);
                u32x2 w; w.x = pk2(oA[db][4 * g4 + 0] * rn * g.x, oA[db][4 * g4 + 1] * rn * g.y); w.y = pk2(oA[db][4 * g4 + 2] * rn * g.z, oA[db][4 * g4 + 3] * rn * g.w);
                *(u32x2*)(op + 32 * db + 8 * g4) = w; }
    } else {
        const float i0 = 1.0f / half_sum(l0);
#pragma unroll
        for (int db = 0; db < 2; ++db)
#pragma unroll
            for (int g4 = 0; g4 < 4; ++g4) { u32x2 w; w.x = pk2(oA[db][4 * g4 + 0] * i0, oA[db][4 * g4 + 1] * i0); w.y = pk2(oA[db][4 * g4 + 2] * i0, oA[db][4 * g4 + 3] * i0);
                *(u32x2*)(op + 32 * db + 8 * g4) = w; }
    }
}
template <int MODE>
__device__ __forceinline__ void attn_queue(Frame& F, int l, unsigned* qbase, int nq) {
    const int per = 4 * nq;
    volatile LAS int* slot = (volatile LAS int*)(F.lds + LDS_MISC + 64);
    const int x0 = (int)(xb_xcc_id() & 7u);
    for (int dx = 0; dx < 8; ++dx) {
        const int x = (x0 + dx) & 7;
        unsigned* qctr = qbase + x * 64;
        for (;;) {
            if (F.tid == 0) slot[0] = (int)__hip_atomic_fetch_add(qctr, 1u, RLX_AGENT);
            __syncthreads();
            const int id = slot[0];
            __syncthreads();
            if (id >= per) break;
            const int qt = id % nq, bh = (id / nq) * 8 + x;
            attn_unit<MODE>(F, l, bh >> 2, bh & 3, qt);
        }
    }
}

__device__ __forceinline__ void convert_experts_queue(Frame& F, int l, int max_chunks = 1 << 30) {
    const float *w_eg = inptr(I_WEG), *w_eu = inptr(I_WEU), *w_ed = inptr(I_WED);
    bf16_t *GUT = WSB(WS_GUT), *DT = WSB(WS_DT);
    LAS float* scr = (LAS float*)(F.lds + F.wave * 16384);
    volatile LAS int* slot = (volatile LAS int*)(F.lds + LDS_MISC + 64);
    unsigned* qctr = WSU(WS_CTL) + CW_XQ + l * 64;
    constexpr int I_G = 16 * 16, I_D = 8 * 32, PER_E = 2 * I_G + I_D, NCH = NEXP * PER_E / 64;
    for (int done = 0; done < max_chunks; ++done) {
        if (F.tid == 0) slot[0] = (int)__hip_atomic_fetch_add(qctr, 1u, RLX_AGENT);
        __syncthreads();
        const int ch = slot[0];
        __syncthreads();
        if (ch >= NCH) break;
        for (int j = 0; j < 8; ++j) {
            const int it = ch * 64 + F.wave * 8 + j;
            const int e = it / PER_E; int r = it % PER_E;
            const size_t eo = ((size_t)l * NEXP + e);
            if (r < I_G) { transpose_item(w_eg + eo * D * DEXP, D, DEXP, GUT + (size_t)e * 1024 * 1024, 1024, scr, r, F.lane, RowGU{0}); continue; } r -= I_G;
            if (r < I_G) { transpose_item(w_eu + eo * D * DEXP, D, DEXP, GUT + (size_t)e * 1024 * 1024, 1024, scr, r, F.lane, RowGU{1}); continue; } r -= I_G;
            transpose_item(w_ed + eo * DEXP * D, DEXP, D, DT + (size_t)e * 1024 * 512, 512, scr, r, F.lane, RowId{});
        }
    }
}
__device__ __forceinline__ void phase_router(Frame& F, int l) {
    const float *w_rg = inptr(I_WRG), *w_re = inptr(I_WRE), *b_rg = inptr(I_BRG), *b_re = inptr(I_BRE), *g_ffn = inptr(I_GFFN);
    bf16_t *H = WSB(WS_H); float *XCTX = WSF(WS_XCTX), *MOD = WSF(WS_MOD); unsigned *ROUTE = WSU(WS_ROUTE), *ctl = WSU(WS_CTL);
    __syncthreads();
    LAS float* wt = (LAS float*)F.lds;
    LAS int* lcnt = (LAS int*)(F.lds + 147456);
    LAS unsigned* rinfo = (LAS unsigned*)(F.lds + 147456 + 256);
#pragma unroll 4
    for (int c = F.tid; c < 1024 * 8; c += 512) { const int k = c >> 3, o4 = c & 7, rk = ((k & 255) >> 2) + 64 * (4 * (k >> 8) + (k & 3)); *(LAS f32x4*)(wt + rk * 36 + 4 + o4 * 4) = *(const f32x4*)(w_re + ((size_t)l * D + k) * 32 + o4 * 4); }
#pragma unroll
    for (int k = F.tid; k < 1024; k += 512) { const int rk = ((k & 255) >> 2) + 64 * (4 * (k >> 8) + (k & 3)); *(LAS f32x4*)(wt + rk * 36) = *(const f32x4*)(w_rg + ((size_t)l * D + k) * 4); }
    if (F.tid < 64) lcnt[F.tid] = 0;
    __syncthreads();
    const int row_base = F.vcu * 136;
    const float* gf = g_ffn + l * D;
    LAS float* bias = (LAS float*)(F.lds + 150976 + 8 * 256);
    if (F.tid < 4) bias[F.tid] = b_rg[l * 4 + F.tid]; else if (F.tid < 36) bias[F.tid] = b_re[l * 32 + F.tid - 4];
    __syncthreads();
    auto xrow = [&](int rpq) -> const float* { const int row = row_base + (rpq < 17 ? F.wave + 8 * rpq : 0); const int b = row / TPB, t = row % TPB;
        return t >= SEQ ? XCTX + ((size_t)b * CTXL + (t - SEQ)) * D : F.out + ((size_t)b * SEQ + t) * D; };
    f32x4 xc[2][4], xn[2][4];
#pragma unroll
    for (int q = 0; q < 2; ++q) { const f32x4* xp = (const f32x4*)xrow(q) + F.lane;
#pragma unroll
        for (int j = 0; j < 4; ++j) xc[q][j] = xp[64 * j]; }
    for (int rp = 0; rp < 17; rp += 2) {
        bool ok[2]; int rls[2]; const float* shp[2]; float rr[2];
#pragma unroll
        for (int q = 0; q < 2; ++q) {
            const int rl = F.wave + 8 * (rp + q); rls[q] = rl; ok[q] = (rp + q) < 17;
            const int row = row_base + (ok[q] ? rl : 0); const int b = row / TPB, t = row % TPB; const bool isctx = t >= SEQ;
            if (ok[q] && isctx && l == 1) { if (F.lane == 0) rinfo[rl * 6] = 0xffffffffu; ok[q] = false; }
            const int mb = isctx ? 8 : b;
            shp[q] = MOD + ((size_t)l * 9 + mb) * 6144 + 3 * 1024;
        }
#pragma unroll
        for (int q = 0; q < 2; ++q) { float ss = 0.f;
#pragma unroll
            for (int j = 0; j < 4; ++j) { const f32x4 x4 = xc[q][j]; ss += (x4.x * x4.x + x4.y * x4.y) + (x4.z * x4.z + x4.w * x4.w); }
            rr[q] = rsqrtf(wave_sum(ss) * (1.0f / D) + RMS_EPS); }
        float hv[2][16];
#pragma unroll
        for (int j = 0; j < 4; ++j) {
            const f32x4 g4 = ((const f32x4*)gf)[F.lane + 64 * j];
#pragma unroll
            for (int q = 0; q < 2; ++q) { const f32x4 x4 = xc[q][j], s4 = ((const f32x4*)shp[q])[F.lane + 64 * j], c4 = ((const f32x4*)(shp[q] + 1024))[F.lane + 64 * j];
                const f32x4 h = (x4 * rr[q] * g4) * (c4 + 1.0f) + s4;
                hv[q][4 * j + 0] = h.x; hv[q][4 * j + 1] = h.y; hv[q][4 * j + 2] = h.z; hv[q][4 * j + 3] = h.w;
                if (ok[q]) { u32x2 w; w.x = pk2(h.x, h.y); w.y = pk2(h.z, h.w); ((u32x2*)(H + (size_t)(row_base + rls[q]) * D))[F.lane + 64 * j] = w; } }
        }
#pragma unroll
        for (int q = 0; q < 2; ++q) { const f32x4* xp = (const f32x4*)xrow(min(rp + 2 + q, 17)) + F.lane;
#pragma unroll
            for (int j = 0; j < 4; ++j) xn[q][j] = xp[64 * j]; }
        float ag[2][4];
#pragma unroll
        for (int q = 0; q < 2; ++q)
#pragma unroll
            for (int o = 0; o < 4; ++o) ag[q][o] = 0.f;
#pragma unroll
        for (int je = 0; je < 16; ++je) { const f32x4 w = *(const LAS f32x4*)(wt + (F.lane + 64 * je) * 36);
#pragma unroll
            for (int q = 0; q < 2; ++q) { ag[q][0] += hv[q][je] * w.x; ag[q][1] += hv[q][je] * w.y; ag[q][2] += hv[q][je] * w.z; ag[q][3] += hv[q][je] * w.w; } }
        int grp[2]; float wgrp[2];
#pragma unroll
        for (int q = 0; q < 2; ++q) {
#pragma unroll
            for (int o = 0; o < 4; ++o) ag[q][o] = wave_sum(ag[q][o]) + bias[o];
            int g0 = 0; float gm = ag[q][0];
#pragma unroll
            for (int g = 1; g < 4; ++g) if (ag[q][g] > gm) { gm = ag[q][g]; g0 = g; }
            float gs = 0.f;
#pragma unroll
            for (int g = 0; g < 4; ++g) gs += __expf(ag[q][g] - gm);
            grp[q] = __builtin_amdgcn_readfirstlane(g0); wgrp[q] = 1.0f / gs;
        }
        float ae[2][8];
#pragma unroll
        for (int q = 0; q < 2; ++q)
#pragma unroll
            for (int o = 0; o < 8; ++o) ae[q][o] = 0.f;
#pragma unroll
        for (int je = 0; je < 16; ++je) {
#pragma unroll
            for (int q = 0; q < 2; ++q) { const LAS f32x4* wp = (const LAS f32x4*)(wt + (F.lane + 64 * je) * 36 + 4 + 8 * grp[q]); const f32x4 w0 = wp[0], w1 = wp[1];
                ae[q][0] += hv[q][je] * w0.x; ae[q][1] += hv[q][je] * w0.y; ae[q][2] += hv[q][je] * w0.z; ae[q][3] += hv[q][je] * w0.w;
                ae[q][4] += hv[q][je] * w1.x; ae[q][5] += hv[q][je] * w1.y; ae[q][6] += hv[q][je] * w1.z; ae[q][7] += hv[q][je] * w1.w; } }
#pragma unroll
        for (int q = 0; q < 2; ++q) {
#pragma unroll
            for (int o = 0; o < 8; ++o) ae[q][o] = wave_sum(ae[q][o]) + bias[4 + 8 * grp[q] + o];
            int i1 = 0; float v1 = ae[q][0];
#pragma unroll
            for (int j = 1; j < 8; ++j) if (ae[q][j] > v1) { v1 = ae[q][j]; i1 = j; }
            int i2 = -1; float v2 = -3.0e38f;
#pragma unroll
            for (int j = 0; j < 8; ++j) if (j != i1 && ae[q][j] > v2) { v2 = ae[q][j]; i2 = j; }
            const float e2 = __expf(v2 - v1), w1 = wgrp[q] / (1.0f + e2), w2 = wgrp[q] * e2 / (1.0f + e2);
            if (ok[q] && F.lane == 0) {
                const int rl = rls[q];
                const int ea = grp[q] * 8 + i1, eb = grp[q] * 8 + i2;
                const int sa = __hip_atomic_fetch_add(lcnt + ea, 1, __ATOMIC_RELAXED, __HIP_MEMORY_SCOPE_WORKGROUP);
                const int sb = __hip_atomic_fetch_add(lcnt + eb, 1, __ATOMIC_RELAXED, __HIP_MEMORY_SCOPE_WORKGROUP);
                rinfo[rl * 6 + 0] = (unsigned)ea; rinfo[rl * 6 + 1] = (unsigned)eb; rinfo[rl * 6 + 2] = (unsigned)sa; rinfo[rl * 6 + 3] = (unsigned)sb;
                rinfo[rl * 6 + 4] = __builtin_bit_cast(unsigned, w1); rinfo[rl * 6 + 5] = __builtin_bit_cast(unsigned, w2);
            }
        }
#pragma unroll
        for (int q = 0; q < 2; ++q)
#pragma unroll
            for (int j = 0; j < 4; ++j) xc[q][j] = xn[q][j];
    }
    __syncthreads();
    if (F.tid < 32) lcnt[32 + F.tid] = (int)__hip_atomic_fetch_add(ctl + CW_CNT + l * 32 + F.tid, (unsigned)lcnt[F.tid], RLX_AGENT);
    __syncthreads();
    if (F.tid < 136) { const int rl = F.tid; const unsigned ea = rinfo[rl * 6];
        if (ea != 0xffffffffu) { const unsigned eb = rinfo[rl * 6 + 1]; unsigned* ro = ROUTE + (size_t)(row_base + rl) * 8;
            ro[0] = ea; ro[1] = eb; ro[2] = rinfo[rl * 6 + 2] + (unsigned)lcnt[32 + ea]; ro[3] = rinfo[rl * 6 + 3] + (unsigned)lcnt[32 + eb]; ro[4] = rinfo[rl * 6 + 4]; ro[5] = rinfo[rl * 6 + 5]; } }
    __syncthreads();
}
__device__ __forceinline__ int build_tiles(Frame& F, int l) {
    LAS int* offs = (LAS int*)(F.lds + LDS_MISC + 128);
    LAS int* cnts = (LAS int*)(F.lds + LDS_MISC + 320);
    LAS int* tile_e = (LAS int*)(F.lds + LDS_TILE_E);
    __syncthreads();
    if (F.tid < NEXP) cnts[F.tid] = (int)__hip_atomic_load(WSU(WS_CTL) + CW_CNT + l * 32 + F.tid, RLX_AGENT);
    __syncthreads();
    if (F.tid == 0) { int o = 0, k = 0;
        for (int e = 0; e < NEXP; ++e) { const int c = cnts[e]; offs[e] = o; const int nt = (c + 255) >> 8;
            for (int j = 0; j < nt && k < MPAD / 256; ++j) tile_e[k++] = e; o += nt << 8; }
        offs[32] = k; }
    __syncthreads();
    return __builtin_amdgcn_readfirstlane(offs[32]);
}
constexpr size_t WS_ROWMAP = WS_ROWW + 512 * 1024;
__device__ __forceinline__ void phase_scatter(Frame& F, int l) {
    (void)build_tiles(F, l);
    const LAS int* offs = (const LAS int*)(F.lds + LDS_MISC + 128);
    const LAS int* cnts = (const LAS int*)(F.lds + LDS_MISC + 320);
    const int gw = F.vcu * 8 + F.wave, NGW = F.G * 8;
    unsigned* ROUTE = WSU(WS_ROUTE); float* ROWW = WSF(WS_ROWW); int* ROWMAP = (int*)(F.ws + WS_ROWMAP);
    for (int r0 = gw * 64 + F.lane; r0 < T; r0 += NGW * 64) {
        const int row = r0;
        if (l == 1 && (row % TPB) >= SEQ) continue;
        unsigned* ro = ROUTE + (size_t)row * 8;
        const u32x4 r4 = *(const u32x4*)ro;
        const unsigned pa = (unsigned)offs[r4.x] + r4.z, pb = (unsigned)offs[r4.y] + r4.w;
        if (pa < (unsigned)MPAD && pb < (unsigned)MPAD) {
            ROWW[pa] = __builtin_bit_cast(float, ro[4]); ROWW[pb] = __builtin_bit_cast(float, ro[5]); ro[6] = pa; ro[7] = pb; ROWMAP[pa] = row; ROWMAP[pb] = row; }
    }
    if (F.vcu < NEXP) { const int e = F.vcu, c = cnts[e], o = offs[e], end = o + (((c + 255) >> 8) << 8);
        for (int p = o + c + F.tid; p < end && p < MPAD; p += 512) { ROWMAP[p] = 0; ROWW[p] = 0.f; } }
}

#define IN(k) (lo <= (k) && (k) < hi)
#define SEAM(k) do { if (IN(k) && IN((k) + 1)) { XcdBarrier b2 = bar; asm volatile("" : "+s"(b2.bar)); xcd_barrier(b2); } } while (0)
#if MK_STAMP
#define STAMP(k) do { if (blockIdx.x == 0 && threadIdx.x == 0) ((unsigned long long*)(F0.ws + 262144))[k] = __builtin_amdgcn_s_memrealtime(); } while (0)
#else
#define STAMP(k) do { } while (0)
#endif
template <int l>
__device__ __forceinline__ void run_layer(const Frame& F0, const XcdBarrier& bar, int lo, int hi) {
    constexpr int P = 1 + 11 * l;
        STAMP(P + 0);
        STAMP(P + 1);
    if (IN(P + 1)) { Frame F = launder(F0); if (l == 0) p0_prologue(F, 1); phase_modulate(F, l, 0); } SEAM(P + 1);
        STAMP(P + 2);
    if (IN(P + 2)) { Frame F = launder(F0);
            pg8::Gemm g{LDP * 2, D * 2}; SchedIn S{F.G, F.bx, (const char*)(WSB(WS_PROJ) + C_H), (const char*)(WSB(WS_WIN) + (size_t)l * NIN * D)}; EpiIn E{WSB(WS_PROJ)};
            pg8::gemm_phase<EpiIn, SchedIn, true>(F.lds, g, S, E);
        } SEAM(P + 2);
        STAMP(P + 3);
    if (IN(P + 3)) { Frame F = launder(F0); phase_post(F, l); } SEAM(P + 3);
        STAMP(P + 4);
    if (IN(P + 4)) { Frame F = launder(F0);
            const int nq = l == 0 ? 17 : 16;
            const int cslot = (l == 1) ? (F.vcu & 3) : -1;
            if (cslot == 0) convert_experts_queue(F, l, 2);
            attn_queue<1>(F, l, WSU(WS_CTL) + CW_Q + ((l * 4 + 0) * 8) * 64, nq);
            if (cslot == 1) convert_experts_queue(F, l, 2);
            attn_queue<0>(F, l, WSU(WS_CTL) + CW_Q + ((l * 4 + 1) * 8) * 64, nq);
            if (cslot == 2) convert_experts_queue(F, l, 2);
            attn_queue<2>(F, l, WSU(WS_CTL) + CW_Q + ((l * 4 + 2) * 8) * 64, nq);
            if (cslot == 3) convert_experts_queue(F, l, 2);
        } SEAM(P + 4);
        STAMP(P + 5);
    if (IN(P + 5)) { Frame F = launder(F0);
            pg8::Gemm g{LDP * 2, D * 2}; SchedMerge S{F.G, F.bx, 128, 1, l == 0 ? 1 : 0, (const char*)WSB(WS_PROJ), (const char*)(WSB(WS_WIN) + ((size_t)l * NIN + 2304) * D), (const char*)(WSB(WS_WBR) + (size_t)l * 4 * D * D)};
            EpiMerge E{WSB(WS_H), WSB(WS_VT) + (size_t)F.bx * 65536, WSB(WS_SLAB)};
            pg8::gemm_phase<EpiMerge, SchedMerge, true>(F.lds, g, S, E);
            convert_experts_queue(F, l);
        } SEAM(P + 5);
        STAMP(P + 6);
    if (IN(P + 6)) { Frame F = launder(F0);
            pg8::Gemm g{D * 2, D * 2}; SchedOut S{F.G, F.bx, l == 0 ? 136 : 128, l, (const char*)WSB(WS_H), (const char*)(WSB(WS_WOUT) + (size_t)l * D * D), l == 0 ? (const char*)WSB(WS_PRIV) : nullptr};
            if (l == 0) sum_ctx_slabs(F, S);
            EpiOut E{l == 0 ? inptr(I_X) : (const float*)F.out, l == 0 ? inptr(I_CTX) : (const float*)WSF(WS_XCTX), F.out, WSF(WS_XCTX), WSF(WS_MOD) + (size_t)l * 9 * 6144};
            pg8::gemm_phase<EpiOut, SchedOut, true>(F.lds, g, S, E);
        } SEAM(P + 6);
        STAMP(P + 7);
    if (IN(P + 7)) { Frame F = launder(F0); phase_router(F, l); } SEAM(P + 7);
        STAMP(P + 8);
    if (IN(P + 8)) { Frame F = launder(F0); phase_scatter(F, l); } SEAM(P + 8);
        STAMP(P + 9);
    if (IN(P + 9)) { Frame F = launder(F0);
            const int ntiles = build_tiles(F, l);
            LAS int* rmt = (LAS int*)(F.lds + 131072);
            { const int* ROWMAP = (const int*)(F.ws + WS_ROWMAP);
              for (int i = 0; i < 8; ++i) { const int L = i * F.G + F.vcu; if (L < ntiles * 4 && F.tid < 256) rmt[i * 256 + F.tid] = ROWMAP[(size_t)(L >> 2) * 256 + F.tid]; }
              __syncthreads(); }
            pg8::Gemm g{D * 2, D * 2}; SchedMoe<1024> S{F.G, F.vcu, ntiles, (const LAS int*)(F.lds + LDS_TILE_E), (const char*)WSB(WS_H), (const char*)WSB(WS_GUT)}; EpiGU E{WSB(WS_HMID)};
            pg8::gemm_phase<EpiGU, SchedMoe<1024>, true, true>(F.lds, g, S, E, (const char*)WSB(WS_H), rmt);
        } SEAM(P + 9);
        STAMP(P + 10);
    if (IN(P + 10)) { Frame F = launder(F0);
            const int ntiles = build_tiles(F, l);
            pg8::Gemm g{DEXP * 2, DEXP * 2}; SchedMoe<512> S{F.G, F.vcu, ntiles, (const LAS int*)(F.lds + LDS_TILE_E), (const char*)WSB(WS_HMID), (const char*)WSB(WS_DT)}; EpiDown E{WSB(WS_Y), WSF(WS_ROWW)};
            pg8::gemm_phase<EpiDown, SchedMoe<512>, true>(F.lds, g, S, E);
        } SEAM(P + 10);
    }
constexpr int N_PHASES = 24;
__global__ void __launch_bounds__(512, 2) fwd_kernel(Args args) {
    extern __shared__ __attribute__((aligned(16))) unsigned char lds_raw[];
    Frame F0;
    F0.lds = (LAS unsigned char*)lds_raw;
    F0.tid = threadIdx.x; F0.lane = F0.tid & 63; F0.wave = __builtin_amdgcn_readfirstlane(F0.tid >> 6);
    F0.G = gridDim.x; F0.bx = blockIdx.x; { const int bx = blockIdx.x; F0.vcu = (F0.G % 8 == 0) ? (bx % 8) * (F0.G / 8) + bx / 8 : bx; }
    F0.ws = args.ws; F0.out = args.out;
    for (int u = F0.tid; u < (LDS_BYTES - LDS_MISC) / 4; u += 512) ((LAS unsigned*)(F0.lds + LDS_MISC))[u] = 0u;
    __syncthreads();
    const int lo = args.ph_lo, hi = args.ph_hi;
    XcdBarrier bar; bar.bar = ((unsigned*)(F0.ws + WS_CTL)) + CW_BAR; bar.x = 0; bar.st = nullptr;
    if (hi - lo > 1) bar = xcd_barrier_post(((unsigned*)(F0.ws + WS_CTL)) + CW_BAR, (volatile LAS unsigned*)(F0.lds + LDS_MISC + 32));

    STAMP(0);
    if (IN(0)) { Frame F = launder(F0); p0_prologue(F, 0); } SEAM(0);
    run_layer<0>(F0, bar, lo, hi);
    run_layer<1>(F0, bar, lo, hi);
    STAMP(23);
    if (IN(23)) { Frame F = launder(F0); phase_modulate(F, 2, 0); }
    STAMP(24);
#if MK_STAMP
    if (blockIdx.x == 0 && threadIdx.x == 0) {
        const unsigned long long* ts = (const unsigned long long*)(F0.ws + 262144);
        const unsigned long long wait = 4ull * (ts[MK_STAMP_A % 100] - ts[MK_STAMP_A / 100]), t0 = __builtin_amdgcn_s_memrealtime();
        while (__builtin_amdgcn_s_memrealtime() - t0 < wait) __builtin_amdgcn_s_sleep(32);
    }
#endif
#undef IN
#undef SEAM
}


#if MK_CHECK
constexpr size_t WS_CHK = 512 * 1024;
constexpr size_t WS_CHKBUF = WS_END;
__device__ __forceinline__ unsigned hsh(unsigned x) { x ^= x >> 16; x *= 0x7feb352du; x ^= x >> 15; x *= 0x846ca68bu; x ^= x >> 16; return x; }
__device__ __forceinline__ void chk_put(unsigned* CHK, int id, float err) { if (!(err >= 0.f)) err = 1e30f; atomicMax(CHK + id, __builtin_bit_cast(unsigned, err)); }
__device__ __forceinline__ float ref_rope_elem(const float* v, int nd, int idx, int t) {
    if (idx >= nd) return 0.f;
    const int h = nd / 2, half = h / 2; const int sec = idx / h, ii = idx % h; const float pos = sec == 0 ? (float)(t / 64) : (float)(t % 64);
    const int i = ii % half; const float inv = powf(10000.0f, -(float)i / (float)half); const float ang = pos * inv, cs = cosf(ang), sn = sinf(ang);
    const float x1 = v[sec * h + i], x2 = v[sec * h + half + i];
    return ii < half ? x1 * cs - x2 * sn : x1 * sn + x2 * cs;
}
__global__ void chk_kernel(Args args, int which, int l) {
    unsigned char* ws = args.ws; unsigned* CHK = (unsigned*)(ws + WS_CHK);
    const float* const* in = args.in;
    const bf16_t* H = (const bf16_t*)(ws + WS_H); const bf16_t* PROJ = (const bf16_t*)(ws + WS_PROJ); const bf16_t* VT = (const bf16_t*)(ws + WS_VT);
    const float* MOD = (const float*)(ws + WS_MOD); const float* XCTX = (const float*)(ws + WS_XCTX); const unsigned* ROUTE = (const unsigned*)(ws + WS_ROUTE); const float* ROWW = (const float*)(ws + WS_ROWW);
    float* CB = (float*)(ws + WS_CHKBUF);
    const int s = blockIdx.x, tid = threadIdx.x; const unsigned h1 = hsh(s * 2654435761u + 12345u + (which == 5 ? 4 : which) * 977u), h2 = hsh(h1 + 0x9e3779b9u), h3 = hsh(h2 + 77u);
    const int id = l * 16 + which;
    __shared__ float sh[4608]; __shared__ float red[64];
    if (which == 0) {
        if (tid != 0) return; const int ll = s & 1, bb = (s >> 1) % 9, j = h1 % 6144; float acc = 0.f;
        for (int k = 0; k < 1024; ++k) { const float v = bb < 8 ? in[I_C][bb * 1024 + k] : in[I_CCTX][k]; acc += v / (1.f + expf(-v)) * in[I_WMOD][((size_t)ll * 1024 + k) * 6144 + j]; }
        acc += in[I_BMOD][ll * 6144 + j]; chk_put(CHK, id, fabsf(acc - MOD[((size_t)ll * 9 + bb) * 6144 + j]));
    } else if (which == 1) {
        if (tid != 0) return; const int row = h1 % T, col = h2 % 1024, b = row / TPB, t = row % TPB; const bool ic = t >= SEQ;
        const float* x = ic ? in[I_CTX] + ((size_t)b * CTXL + t - SEQ) * D : in[I_X] + ((size_t)b * SEQ + t) * D; float ss = 0.f;
        for (int k = 0; k < 1024; ++k) ss += x[k] * x[k];
        const float r = 1.0f / sqrtf(ss / 1024.f + 1e-6f); const float* m = MOD + (size_t)(ic ? 8 : b) * 6144;
        const float e = x[col] * r * in[I_GMIX][col] * (1.f + m[1024 + col]) + m[col]; chk_put(CHK, id, fabsf(e - bf2f(PROJ[(size_t)row * LDP + C_H + col])));
    } else if (which == 2) {
        if (tid != 0) return; const int row = h1 % T, col = h2 % 2304; float acc = 0.f;
        for (int k = 0; k < 1024; ++k) acc += bf2f(PROJ[(size_t)row * LDP + C_H + k]) * in[I_WIN][((size_t)l * 1024 + k) * NIN + col];
        chk_put(CHK, id, fabsf(acc - bf2f(PROJ[(size_t)row * LDP + col])));
    } else if (which == 3) {
        const int kind = s % 7, row = h1 % T, b = row / TPB, t = row % TPB; const bool ic = t >= SEQ;
        int c0 = 0, nd = 64; const int hh = h2 & 3;
        if (kind == 0) { c0 = C_DQ + 32 * (h2 & 7); nd = 32; } else if (kind == 1) { c0 = C_DK + 32 * (h2 & 7); nd = 32; } else if (kind == 2) c0 = C_GQ + 64 * hh; else if (kind == 3) c0 = C_GK + 64 * (hh & 1);
        else if (kind == 4) c0 = C_NQ + 64 * hh; else if (kind == 5) c0 = 64 * hh; else c0 = (h3 % 10 < 4 ? C_DV + 64 * (h3 % 10) : (h3 % 10 < 8 ? C_NV + 64 * (h3 % 10 - 4) : C_GV + 64 * (h3 % 10 - 8)));
        if (kind == 5) {
            const int ch = c0 + tid, win = 2 << (ch / 64), n = ic ? CTXL : SEQ, ts = ic ? t - SEQ : t, lo = max(ts - win / 2, 0), hi = min(ts + win / 2, n); float sum = 0.f, self = 0.f;
            for (int i = lo; i < hi; ++i) { const size_t r2 = (size_t)(row - ts + i); float acc = 0.f; for (int k = 0; k < 1024; ++k) acc += bf2f(PROJ[r2 * LDP + C_H + k]) * in[I_WIN][((size_t)l * 1024 + k) * NIN + ch]; sum += acc; if (i == ts) self = acc; }
            chk_put(CHK, id, fabsf(sum / (float)(hi - lo) - self - bf2f(PROJ[(size_t)row * LDP + C_POOL + ch]))); return; }
        float acc = 0.f; if (tid < nd) for (int k = 0; k < 1024; ++k) acc += bf2f(PROJ[(size_t)row * LDP + C_H + k]) * in[I_WIN][((size_t)l * 1024 + k) * NIN + c0 + tid];
        sh[tid] = acc; __syncthreads();
        if (kind == 6) { const int vh = h3 % 10; chk_put(CHK, id, fabsf(acc - bf2f(VT[(((size_t)b * 10 + vh) * 64 + tid) * TPB + t]))); return; }
        float* v = sh + 64;
        if (kind == 2 || kind == 3) { float ss = 0.f; for (int i = 0; i < 64; ++i) ss += sh[i] * sh[i]; const float r = 1.f / sqrtf(ss / 64.f + 1e-6f); const float* g = (kind == 2 ? in[I_QN] : in[I_KN]) + l * 64; v[tid] = sh[tid] * r * g[tid]; }
        else v[tid] = sh[tid];
        __syncthreads();
        float e = v[tid]; if (!ic && kind <= 3) e = ref_rope_elem(v, nd, tid, t);
        if (kind == 0) e *= 0.17677669529663687f * LOG2E; if (kind == 2 || kind == 4) e *= 0.125f * LOG2E;
        if (tid < nd) chk_put(CHK, id, fabsf(e - bf2f(PROJ[(size_t)row * LDP + c0 + tid])));
    } else if (which == 4 || which == 5) {
        const int mode = s % 3, nq = l == 0 ? 17 : 16, b = h1 % NB, h = h2 & 3, qt = h3 % nq, q = qt * 256 + (hsh(h3) & 255); const size_t rowb = (size_t)b * TPB;
        const int qcol = mode == 0 ? C_GQ + 64 * h : (mode == 1 ? C_DQ + 64 * h : C_NQ + 64 * h), kcol = mode == 0 ? C_GK + 64 * (h >> 1) : (mode == 1 ? C_DK + 64 * h : C_NK + 64 * h), vcol = mode == 0 ? C_GV + 64 * (h >> 1) : (mode == 1 ? C_DV + 64 * h : C_NV + 64 * h);
        if (which == 5) { const float er = fabsf(CB[s * 64 + tid] - bf2f(PROJ[(rowb + q) * LDP + qcol + tid])); chk_put(CHK, l * 16 + (mode == 0 ? 5 : 11 + mode), er);
            if (l == 0 && mode == MK_CHK_MODE) { const float ex = CB[s * 64 + tid], gt = bf2f(PROJ[(rowb + q) * LDP + qcol + tid]);
                atomicAdd((float*)(CHK + 60), ex * gt); atomicAdd((float*)(CHK + 61), ex * ex); atomicAdd((float*)(CHK + 62), gt * gt); } return; }
        const bool ic = q >= SEQ; const int k_lo = ic ? SEQ : 0, k_hi = TPB;
        float outv = 0.f, out2 = 0.f;
        for (int map = 0; map < (mode == 1 ? 2 : 1); ++map) {
            float mx = -3e38f;
            for (int k = k_lo + tid; k < k_hi; k += 64) { float sc = 0.f; const int d0 = mode == 1 ? 32 * map : 0, dn = mode == 1 ? 32 : 64;
                for (int d = 0; d < dn; ++d) sc += bf2f(PROJ[(rowb + q) * LDP + qcol + d0 + d]) * bf2f(PROJ[(rowb + k) * LDP + kcol + d0 + d]);
                if (mode == 2 && !ic) { if (k < SEQ) { const int r = q / 64, j = q % 64, kr = k / 64, kj = k % 64, ws_ = min(max(r - 4, 0), 56), cs = min(max(j - 8, 0), 48);
                        if (kr >= ws_ && kr < ws_ + 8 && kj >= cs && kj < cs + 16) sc += in[I_RPB][(((size_t)l * 4 + h) * 15 + (kr - r + 7)) * 31 + min(max(kj - j, -15), 15) + 15] * LOG2E; else sc = -1e30f; } }
                sh[k] = sc; mx = fmaxf(mx, sc); }
            red[tid] = mx; __syncthreads(); mx = -3e38f; for (int i = 0; i < 64; ++i) mx = fmaxf(mx, red[i]); __syncthreads();
            float sum = 0.f, o = 0.f;
            for (int k = k_lo; k < k_hi; ++k) { const float p = exp2f(sh[k] - mx); sum += p; o += p * bf2f(PROJ[(rowb + k) * LDP + vcol + tid]); }
            __syncthreads();
            if (map == 0) outv = o / sum; else out2 = o / sum;
        }
        if (mode == 1) { const float lam = MOD[131072 + l], li = 0.8f - 0.6f * expf(-0.3f * (float)l); const float v = outv - lam * out2; red[tid] = v * v; __syncthreads(); float ss = 0.f; for (int i = 0; i < 64; ++i) ss += red[i];
            outv = v / sqrtf(ss / 64.f + 1e-6f) * in[I_DNG][l * 64 + tid] * (1.f - li); }
        CB[s * 64 + tid] = outv;
    } else if (which == 12) {
        const unsigned hh = hsh(h1 + tid * 7919u); const int b = hh % NB, vh = (hh >> 4) % 10, d = (hh >> 8) & 63; int key = (hh >> 14) % TPB; if (tid & 1) key = SEQ + (key & 255);
        const int vcol = vh < 4 ? C_DV + 64 * vh : (vh < 8 ? C_NV + 64 * (vh - 4) : C_GV + 64 * (vh - 8));
        if (VT[(((size_t)b * 10 + vh) * 64 + d) * TPB + key] != PROJ[((size_t)b * TPB + key) * LDP + vcol + d]) { atomicAdd(CHK + 58, 1u); atomicOr(CHK + 59, (1u << vh) | (key >= SEQ ? 1024u : 2048u)); }
    } else if (which == 6) {
        if (tid != 0) return; const int nM = l == 0 ? T : NB * SEQ; int row = h1 % nM; if (l == 1) row = (row / SEQ) * TPB + row % SEQ; const int n = h2 % 1024; float tot = 0.f;
        for (int br = 0; br < 4; ++br) { float acc = 0.f;
            if (br == 0) { for (int g = 0; g < 4; ++g) for (int dp = 0; dp < 64; ++dp) { float y = 0.f; for (int c = 0; c < 64; ++c) y += bf2f(PROJ[(size_t)row * LDP + C_POOL + 64 * g + c]) * in[I_POOLW][(((size_t)l * 4 + g) * 64 + c) * 64 + dp];
                    acc += y * in[I_POOLS][l * 256 + 64 * g + dp] * in[I_WBR][(((size_t)l * 4 + 0) * 256 + 64 * g + dp) * D + n]; } }
            else { const int c0 = branch_col(br); for (int k = 0; k < 256; ++k) acc += bf2f(PROJ[(size_t)row * LDP + c0 + k]) * in[I_WBR][(((size_t)l * 4 + br) * 256 + k) * D + n]; }
            float gl = 0.f; for (int k = 0; k < 1024; ++k) gl += bf2f(PROJ[(size_t)row * LDP + C_H + k]) * in[I_WIN][((size_t)l * 1024 + k) * NIN + 2304 + br * 1024 + n];
            tot += acc / (1.f + expf(-gl)); }
        chk_put(CHK, id, fabsf(tot - bf2f(H[(size_t)row * D + n])));
    } else if (which == 7) {
        if (tid != 0 || l != 0) return; const int row = h1 % T, n = h2 % 1024, b = row / TPB, t = row % TPB; const bool ic = t >= SEQ; float acc = 0.f;
        for (int k = 0; k < 1024; ++k) acc += bf2f(H[(size_t)row * D + k]) * in[I_WOUT][((size_t)l * 1024 + k) * D + n];
        const size_t xo = ic ? ((size_t)b * CTXL + t - SEQ) * D + n : ((size_t)b * SEQ + t) * D + n;
        const float e = (ic ? in[I_CTX] : in[I_X])[xo] + MOD[((size_t)l * 9 + (ic ? 8 : b)) * 6144 + 2048 + n] * acc; chk_put(CHK, id, fabsf(e - (ic ? XCTX : args.out)[xo]));
    } else if (which == 8) {
        if (tid != 0) return; int row = h1 % T; if (l == 1) { row = h1 % (NB * SEQ); row = (row / SEQ) * TPB + row % SEQ; } const int b = row / TPB, t = row % TPB; const bool ic = t >= SEQ;
        const float* x = ic ? XCTX + ((size_t)b * CTXL + t - SEQ) * D : args.out + ((size_t)b * SEQ + t) * D; float ss = 0.f; for (int k = 0; k < 1024; ++k) ss += x[k] * x[k];
        const float r = 1.f / sqrtf(ss / 1024.f + 1e-6f); const float* m = MOD + ((size_t)l * 9 + (ic ? 8 : b)) * 6144; float* lg = red; for (int o = 0; o < 36; ++o) lg[o] = 0.f; float herr = 0.f;
        for (int k = 0; k < 1024; ++k) { const float hv = x[k] * r * in[I_GFFN][l * 1024 + k] * (1.f + m[4096 + k]) + m[3072 + k]; herr = fmaxf(herr, fabsf(hv - bf2f(H[(size_t)row * D + k])));
            for (int o = 0; o < 4; ++o) lg[o] += hv * in[I_WRG][((size_t)l * 1024 + k) * 4 + o]; for (int o = 0; o < 32; ++o) lg[4 + o] += hv * in[I_WRE][((size_t)l * 1024 + k) * 32 + o]; }
        for (int o = 0; o < 4; ++o) lg[o] += in[I_BRG][l * 4 + o]; for (int o = 0; o < 32; ++o) lg[4 + o] += in[I_BRE][l * 32 + o];
        int g = 0; for (int o = 1; o < 4; ++o) if (lg[o] > lg[g]) g = o; float gs = 0.f; for (int o = 0; o < 4; ++o) gs += expf(lg[o] - lg[g]);
        int i1 = 0; for (int j = 1; j < 8; ++j) if (lg[4 + g * 8 + j] > lg[4 + g * 8 + i1]) i1 = j; int i2 = -1; for (int j = 0; j < 8; ++j) if (j != i1 && (i2 < 0 || lg[4 + g * 8 + j] > lg[4 + g * 8 + i2])) i2 = j;
        const float v1 = lg[4 + g * 8 + i1], v2 = lg[4 + g * 8 + i2], e2 = expf(v2 - v1), w1 = 1.f / gs / (1.f + e2), w2 = 1.f / gs * e2 / (1.f + e2);
        const unsigned* ro = ROUTE + (size_t)row * 8; float err = herr;
        if (ro[0] != (unsigned)(g * 8 + i1) || ro[1] != (unsigned)(g * 8 + i2)) err = 10.f; else err = fmaxf(err, fmaxf(fabsf(w1 - __builtin_bit_cast(float, ro[4])), fabsf(w2 - __builtin_bit_cast(float, ro[5]))));
        chk_put(CHK, id, err);
    } else if (which == 9) {
        if (tid != 0) return; int row = h1 % T; if (l == 1) { row = h1 % (NB * SEQ); row = (row / SEQ) * TPB + row % SEQ; } const unsigned* ro = ROUTE + (size_t)row * 8; const unsigned* ctl = (const unsigned*)(ws + WS_CTL);
        int off = 0, ofa = 0, ofb = 0; for (int e = 0; e < 32; ++e) { const int c = (int)ctl[CW_CNT + l * 32 + e]; if (e == (int)ro[0]) ofa = off; if (e == (int)ro[1]) ofb = off; off += ((c + 255) >> 8) << 8; }
        float err = 0.f; if (ro[6] != ofa + ro[2] || ro[7] != ofb + ro[3] || ro[2] >= ctl[CW_CNT + l * 32 + ro[0]] || ro[3] >= ctl[CW_CNT + l * 32 + ro[1]]) err = 10.f;
        const bf16_t* S0 = PROJ; for (int k = 0; k < 1024; ++k) { if (S0[(size_t)ro[6] * D + k] != H[(size_t)row * D + k] || S0[(size_t)ro[7] * D + k] != H[(size_t)row * D + k]) err = 5.f; }
        if (ROWW[ro[6]] != __builtin_bit_cast(float, ro[4]) || ROWW[ro[7]] != __builtin_bit_cast(float, ro[5])) err = 3.f; chk_put(CHK, id, err);
    } else if (which == 10 || which == 11) {
        if (tid != 0) return; int row = h1 % T; if (l == 1) { row = h1 % (NB * SEQ); row = (row / SEQ) * TPB + row % SEQ; } const unsigned* ro = ROUTE + (size_t)row * 8; const int sl = h2 & 1; const int e = ro[sl], pos = ro[6 + sl];
        const bf16_t* HM = (const bf16_t*)(ws + WS_HMID);
        if (which == 10) { const int col = h3 % 512; float g = 0.f, u = 0.f; for (int k = 0; k < 1024; ++k) { const float a = bf2f(PROJ[(size_t)pos * D + k]); g += a * in[I_WEG][(((size_t)l * 32 + e) * 1024 + k) * 512 + col]; u += a * in[I_WEU][(((size_t)l * 32 + e) * 1024 + k) * 512 + col]; }
            chk_put(CHK, id, fabsf(g / (1.f + expf(-g)) * u - bf2f(HM[(size_t)pos * 512 + col]))); }
        else { const int n = h3 % 1024; float acc = 0.f; for (int k = 0; k < 512; ++k) acc += bf2f(HM[(size_t)pos * 512 + k]) * in[I_WED][(((size_t)l * 32 + e) * 512 + k) * 1024 + n];
            chk_put(CHK, id, fabsf(acc * __builtin_bit_cast(float, ro[4 + sl]) - bf2f(PROJ[(size_t)pos * D + n]))); }
    }
}
__global__ void chk_encode(Args args) {
    const unsigned* CHK = (const unsigned*)(args.ws + WS_CHK);
    const int order[24] = {0, 1, 2, 3, 12, 13, 5, 6, 7, 8, 9, 10, 11, 16 + 2, 16 + 3, 16 + 5, 16 + 12, 16 + 13, 16 + 6, 16 + 8, 16 + 9, 16 + 10, 16 + 11, -1};
    const float tol[14] = {1e-3f, 0.03f, 0.04f, 0.04f, 0.f, 0.03f, 0.04f, 0.02f, 0.02f, 0.5f, 0.04f, 0.04f, 0.03f, 0.03f};
    float k = 0.f;
    for (int r = 0; r < 24 && order[r] >= 0; ++r) { const float e = __builtin_bit_cast(float, CHK[order[r]]); if (e > tol[order[r] & 15]) { float dg = floorf(log10f(e) + 5.f); dg = fminf(fmaxf(dg, 1.f), 9.f); k = sqrtf(dg * powf(10.f, (float)(r + 2))); break; } }
    float k2 = 0.f;
    if (k == 0.f) return;
    for (size_t i = (size_t)blockIdx.x * blockDim.x + threadIdx.x; i < (size_t)NB * SEQ * D; i += (size_t)gridDim.x * blockDim.x) args.out[i] = (i == 12345 && k2 > 0.f) ? k2 : k;
}
#endif


extern "C" void kernel_launch(void* const* d_in, const int* in_sizes, int n_in, void* d_out, int out_size, void* d_ws, size_t ws_size, hipStream_t stream) {
    static int grid = 0;
    if (grid == 0) {
        if (n_in != 26 || ws_size < WS_END) { fprintf(stderr, "kernel_launch: need 26 inputs and %zu bytes of workspace (got %d, %zu)\n", (size_t)WS_END, n_in, ws_size); grid = -1; return; }
        int dev = 0, cus = 0, per_cu = 0;
        if (hipGetDevice(&dev) != hipSuccess || hipDeviceGetAttribute(&cus, hipDeviceAttributeMultiprocessorCount, dev) != hipSuccess) { grid = -1; return; }
        if (hipFuncSetAttribute((const void*)fwd_kernel, hipFuncAttributeMaxDynamicSharedMemorySize, LDS_BYTES) != hipSuccess) { fprintf(stderr, "kernel_launch: hipFuncSetAttribute failed\n"); grid = -1; return; }
        if (hipOccupancyMaxActiveBlocksPerMultiprocessor(&per_cu, (const void*)fwd_kernel, 512, LDS_BYTES) != hipSuccess || per_cu < 1) { fprintf(stderr, "kernel_launch: occupancy query says %d\n", per_cu); }
        (void)hipGetLastError();
        grid = cus;
    }
    if (grid < 0) return;
    (void)hipMemsetAsync((char*)d_ws + WS_CTL, 0, CTL_ZERO_BYTES, stream);
    Args a{};
    for (int i = 0; i < 26; ++i) a.in[i] = (const float*)d_in[i];
    a.out = (float*)d_out; a.ws = (unsigned char*)d_ws;
#if MK_MULTI
    for (int p = 0; p < N_PHASES; ++p) {
#if MK_CHECK
        const int lq = p == 0 ? 0 : (p - 1) / 11, ph = p == 0 ? -2 : (p - 1) % 11 - 1;
        if (p < 23 && ph == 3) hipLaunchKernelGGL(chk_kernel, dim3(192), dim3(64), 0, stream, a, 4, lq);
#endif
        a.ph_lo = p; a.ph_hi = p + 1; hipLaunchKernelGGL(fwd_kernel, dim3(grid), dim3(512), LDS_BYTES, stream, a);
#if MK_CHECK
        if (p == 0) hipLaunchKernelGGL(chk_kernel, dim3(256), dim3(64), 0, stream, a, 0, 0);
        if (p == 2) hipLaunchKernelGGL(chk_kernel, dim3(256), dim3(64), 0, stream, a, 1, 0);
        if (p < 23 && ph == 1) hipLaunchKernelGGL(chk_kernel, dim3(512), dim3(64), 0, stream, a, 2, lq);
        if (p < 23 && ph == 2) hipLaunchKernelGGL(chk_kernel, dim3(448), dim3(64), 0, stream, a, 3, lq);
        if (p < 23 && ph == 3) hipLaunchKernelGGL(chk_kernel, dim3(192), dim3(64), 0, stream, a, 5, lq);
        if (p == 5) hipLaunchKernelGGL(chk_kernel, dim3(1024), dim3(64), 0, stream, a, 12, 0);
        if (p < 23 && ph == 4) hipLaunchKernelGGL(chk_kernel, dim3(256), dim3(64), 0, stream, a, 6, lq);
        if (p < 23 && ph == 5) hipLaunchKernelGGL(chk_kernel, dim3(256), dim3(64), 0, stream, a, 7, lq);
        if (p < 23 && ph == 6) hipLaunchKernelGGL(chk_kernel, dim3(256), dim3(64), 0, stream, a, 8, lq);
        if (p < 23 && ph == 7) hipLaunchKernelGGL(chk_kernel, dim3(128), dim3(64), 0, stream, a, 9, lq);
        if (p < 23 && ph == 8) hipLaunchKernelGGL(chk_kernel, dim3(256), dim3(64), 0, stream, a, 10, lq);
        if (p < 23 && ph == 9) hipLaunchKernelGGL(chk_kernel, dim3(256), dim3(64), 0, stream, a, 11, lq);
#endif
    }
#if MK_CHECK
    hipLaunchKernelGGL(chk_encode, dim3(1024), dim3(256), 0, stream, a);
#endif
#else
    a.ph_lo = 0; a.ph_hi = N_PHASES;
    hipLaunchKernelGGL(fwd_kernel, dim3(grid), dim3(512), LDS_BYTES, stream, a);
#endif
}
```

```cpp
#include <hip/hip_runtime.h>
#include <cstdint>
#include <cstdio>

#ifndef MK_CHECK
#define MK_CHECK 0
#endif
#ifndef MK_CHK_MODE
#define MK_CHK_MODE 0
#endif
#ifndef MK_STAMP
#define MK_STAMP 0
#endif
#ifndef MK_STAMP_A
#define MK_STAMP_A 0
#define MK_STAMP_B 0
#endif
#ifndef MK_MULTI
#define MK_MULTI 0
#endif

#define GAS __attribute__((address_space(1)))
#define LAS __attribute__((address_space(3)))
typedef unsigned short bf16_t;
typedef short bf16x8 __attribute__((ext_vector_type(8)));
typedef float f32x4 __attribute__((ext_vector_type(4)));
typedef float f32x2 __attribute__((ext_vector_type(2)));
typedef float f32x16 __attribute__((ext_vector_type(16)));
typedef unsigned u32x4 __attribute__((ext_vector_type(4)));
typedef unsigned u32x2 __attribute__((ext_vector_type(2)));

constexpr int D = 1024, NB = 8, SEQ = 4096, CTXL = 256, TPB = SEQ + CTXL  , T = NB * TPB  ;
constexpr int LDP = 3584;
constexpr int NGATE = 4096, NIN = 6400;
constexpr int C_DQ = 256, C_DK = 512, C_DV = 768, C_NQ = 1024, C_NK = 1280, C_NV = 1536, C_GQ = 1792, C_GK = 2048, C_GV = 2176, C_POOL = 2304, C_H = 2560;
constexpr int NEXP = 32, DEXP = 512;
constexpr int MPAD = 77824;
constexpr float RMS_EPS = 1e-6f;
constexpr float LOG2E = 1.4426950408889634f;

constexpr size_t MiB = 1u << 20;
constexpr size_t WS_CTL = 0, CTL_ZERO_BYTES = 1 * MiB;
constexpr size_t WS_MOD = 1 * MiB;
constexpr size_t WS_ROUTE = 2 * MiB;
constexpr size_t WS_ROWW = 4 * MiB;
constexpr size_t WS_XCTX = 5 * MiB;
constexpr size_t WS_WIN = 13 * MiB;
constexpr size_t WS_WOUT = 38 * MiB;
constexpr size_t WS_WBR = 42 * MiB;
constexpr size_t WS_H = 58 * MiB;
constexpr size_t WS_PROJ = 126 * MiB;
constexpr size_t WS_X2 = 364 * MiB;
constexpr size_t WS_VT = 536 * MiB;
constexpr size_t WS_END = 624 * MiB;
constexpr size_t WS_DT = WS_X2, WS_HMID = WS_X2 + 32 * MiB, WS_GUT = WS_X2 + 108 * MiB;
constexpr size_t WS_SLAB = WS_VT + 43 * MiB;
constexpr size_t WS_PRIV = WS_SLAB + 16 * MiB;
constexpr size_t WS_Y = WS_GUT;
static_assert((size_t)T * LDP * 2 <= WS_X2 - WS_PROJ && (size_t)MPAD * 1024 * 2 <= WS_X2 - WS_PROJ, "proj region");
static_assert(108 * MiB + 64 * MiB == WS_VT - WS_X2 && WS_Y + (size_t)MPAD * 1024 * 2 <= WS_END, "x2 / y region");
static_assert((size_t)NB * 10 * 64 * TPB * 2 <= WS_END - WS_VT, "vt region");
constexpr int CW_BAR = 1024;
constexpr int CW_CNT = 8192;
constexpr int CW_Q = 8448;
constexpr int CW_XQ = 16384;

constexpr int RING_BYTES = 131072;
constexpr int LDS_MISC = 155648;
constexpr int LDS_BYTES = 159744;
constexpr int LDS_TILE_E = LDS_MISC + 512;
static_assert(LDS_TILE_E + 320 * 4 <= LDS_BYTES, "lds map");

#define RLX_AGENT __ATOMIC_RELAXED, __HIP_MEMORY_SCOPE_AGENT
__device__ __forceinline__ unsigned f2bf(float f) { unsigned u = __builtin_bit_cast(unsigned, f); return (u + 0x7fffu + ((u >> 16) & 1u)) >> 16; }
__device__ __forceinline__ unsigned pk2(float lo, float hi) { return f2bf(lo) | (f2bf(hi) << 16); }
__device__ __forceinline__ float bflo(unsigned w) { return __builtin_bit_cast(float, w << 16); }
__device__ __forceinline__ float bfhi(unsigned w) { return __builtin_bit_cast(float, w & 0xffff0000u); }
__device__ __forceinline__ float bf2f(bf16_t h) { return __builtin_bit_cast(float, (unsigned)h << 16); }
typedef __bf16 bf16x2_t __attribute__((ext_vector_type(2)));
__device__ __forceinline__ unsigned cvt_pk_bf16(float lo, float hi) { f32x2 v = {lo, hi}; bf16x2_t b = __builtin_convertvector(v, bf16x2_t); return __builtin_bit_cast(unsigned, b); }
template <int CTRL, int ROWM = 0xf> __device__ __forceinline__ float dpp_f(float v) { return __builtin_bit_cast(float, __builtin_amdgcn_update_dpp(0, __builtin_bit_cast(int, v), CTRL, ROWM, 0xf, false)); }
template <int M> __device__ __forceinline__ float swz_xor(float v) {
    static_assert(M == 1 || M == 2, "quad permutes only");
    return M == 1 ? dpp_f<0xB1>(v) : dpp_f<0x4E>(v);
}
__device__ __forceinline__ float sum8(float v) { v += dpp_f<0xB1>(v); v += dpp_f<0x4E>(v); v += dpp_f<0x141>(v); return v; }
__device__ __forceinline__ void plswap32(float& a, float& b) { asm volatile("s_nop 1\n\tv_permlane32_swap_b32 %0, %1\n\ts_nop 1" : "+v"(a), "+v"(b)); }
__device__ __forceinline__ void plswap32u(unsigned& a, unsigned& b) { asm volatile("s_nop 1\n\tv_permlane32_swap_b32 %0, %1\n\ts_nop 1" : "+v"(a), "+v"(b)); }
__device__ __forceinline__ float half_sum(float v) { float a = v, b = v; plswap32(a, b); return a + b; }
__device__ __forceinline__ float half_max(float v) { float a = v, b = v; plswap32(a, b); return fmaxf(a, b); }
__device__ __forceinline__ float wave_sum(float v) {
    v = sum8(v); v += dpp_f<0x140>(v);
    v += __builtin_bit_cast(float, __builtin_amdgcn_update_dpp(0, __builtin_bit_cast(int, v), 0x142, 0xa, 0xf, true));
    v += __builtin_bit_cast(float, __builtin_amdgcn_update_dpp(0, __builtin_bit_cast(int, v), 0x143, 0xc, 0xf, true));
    return __builtin_bit_cast(float, __builtin_amdgcn_readlane(__builtin_bit_cast(int, v), 63));
}
__device__ __forceinline__ float fast_exp2(float x) { return __builtin_amdgcn_exp2f(x); }
__device__ __forceinline__ float fast_rcp(float x) { return __builtin_amdgcn_rcpf(x); }
__device__ __forceinline__ float sigmoidf_(float x) { return fast_rcp(1.0f + fast_exp2(-x * LOG2E)); }

#define XB_TMO      128
#define XB_XCNT(j)  (256  + 64 * (j))
#define XB_XSUB(j)  (1280 + 64 * (j))
#define XB_XGEN(j)  (2304 + 64 * (j))
#define XB_TOP      3328
#define XB_TOPGEN   3392
#define XCD_BAR_WORDS 3456
#define XB_SPIN_CAP (1u << 20)
__device__ __forceinline__ unsigned xb_ld(unsigned* p)              { return __hip_atomic_load(p, __ATOMIC_RELAXED, __HIP_MEMORY_SCOPE_AGENT); }
__device__ __forceinline__ unsigned xb_add(unsigned* p, unsigned v) { return __hip_atomic_fetch_add(p, v, __ATOMIC_RELAXED, __HIP_MEMORY_SCOPE_AGENT); }
__device__ __forceinline__ unsigned xb_xcc_id() { return (unsigned)__builtin_amdgcn_s_getreg((3 << 11) | 20) & 0xFu; }
#define XB_SPIN(cond, bar) do { unsigned _sp = 0; while (cond) { __builtin_amdgcn_s_sleep(1); \
    if ((++_sp & 255u) == 0u) { if (xb_ld(&(bar)[XB_TMO])) break; if (_sp > XB_SPIN_CAP) { atomicAdd(&(bar)[XB_TMO], 1u); break; } } } } while (0)
struct XcdBarrier { unsigned* bar; unsigned x; volatile LAS unsigned* st; };
__device__ __forceinline__ XcdBarrier xcd_barrier_post(unsigned* bar, volatile LAS unsigned* st) {
    XcdBarrier b; b.bar = bar; b.x = xb_xcc_id(); b.st = st;
    if (threadIdx.x == 0) (void)xb_add(&bar[XB_XCNT(b.x)], 1u);
    return b;
}
__device__ __forceinline__ void xcd_barrier_complete(unsigned* bar, unsigned x, unsigned& nloc, unsigned& nx) {
    const unsigned G = gridDim.x * gridDim.y * gridDim.z;
    unsigned sum, cnt, mine, sp = 0u;
    for (;;) {
        sum = 0u; cnt = 0u; mine = 0u;
#pragma unroll
        for (unsigned j = 0; j < 16; ++j) { const unsigned c = xb_ld(&bar[XB_XCNT(j)]); sum += c; cnt += (c > 0u) ? 1u : 0u; mine = (j == x) ? c : mine; }
        if (sum == G) break;
        __builtin_amdgcn_s_sleep(1);
        if ((++sp & 255u) == 0u) { if (xb_ld(&bar[XB_TMO])) break; if (sp > XB_SPIN_CAP) { atomicAdd(&bar[XB_TMO], 1u); break; } }
    }
    nloc = mine > 0u ? mine : 1u; nx = cnt > 0u ? cnt : 1u;
}
__device__ __forceinline__ void xcd_barrier(const XcdBarrier& b) {
    asm volatile("s_waitcnt vmcnt(0)" ::: "memory");
    __syncthreads();
    if (threadIdx.x == 0) {
        unsigned* bar = b.bar;
        __builtin_amdgcn_s_waitcnt(0);
        unsigned nloc = b.st[0], nx = b.st[1];
        if (nloc == 0u) { xcd_barrier_complete(bar, b.x, nloc, nx); b.st[0] = nloc; b.st[1] = nx; }
        const unsigned old = xb_add(&bar[XB_XSUB(b.x)], 1u);
        const unsigned gen = old / nloc;
        if (old + 1u == (gen + 1u) * nloc) {
            __builtin_amdgcn_fence(__ATOMIC_RELEASE, "agent");
            asm volatile("s_waitcnt vmcnt(0)" ::: "memory");
            const unsigned og = xb_add(&bar[XB_TOP], 1u);
            const unsigned tg = og / nx;
            if (og + 1u == (tg + 1u) * nx) xb_add(&bar[XB_TOPGEN], 1u);
            else XB_SPIN(xb_ld(&bar[XB_TOPGEN]) == tg, bar);
            __builtin_amdgcn_fence(__ATOMIC_ACQUIRE, "agent");
            xb_add(&bar[XB_XGEN(b.x)], 1u);
            asm volatile("s_waitcnt vmcnt(0)" ::: "memory");
        } else {
            XB_SPIN(xb_ld(&bar[XB_XGEN(b.x)]) == gen, bar);
            __builtin_amdgcn_fence(__ATOMIC_ACQUIRE, "agent");
            asm volatile("s_waitcnt vmcnt(0)" ::: "memory");
        }
    }
    __syncthreads();
}

namespace pg8 {
constexpr int BM = 256, BK = 64, HALF = 128, HTB = HALF * BK * 2, STAGE_BYTES = 8 * HTB, NXCD = 8, WGM = 8;
__host__ __device__ __forceinline__ int lds_byte(int r, int c) { const int st = (r >> 4) * 2 + (c >> 5), rr = r & 15, cc = c & 31, ob = rr * 64 + cc * 2; return st * 1024 + (ob ^ (((ob >> 9) & 1) << 5)); }
__host__ __device__ __forceinline__ void stage_rc(int b, int& R, int& C) { const int st = b / 1024, sb = b % 1024, swz = sb ^ (((sb >> 9) & 1) << 5); R = (st >> 1) * 16 + swz / 64; C = (st & 1) * 32 + (swz % 64) / 2; }
__host__ __device__ __forceinline__ int perm32(int rho) { const int n = rho >> 4, i = rho & 15; return 8 * (i >> 2) + 4 * n + (i & 3); }

struct Unit { int pm, pn, aux, nt; const char* A; const char* B; };
struct Gemm { int lda, ldb; };

__device__ __forceinline__ bool tile_order(int nM, int nN, int G, int c, int i, int& pm, int& pn) {
    const int nwg = nM * nN; const long L = (long)i * G + c; if (L >= nwg) return false;
    int wgid = (int)L; { const int q = nwg / NXCD, r = nwg % NXCD, xcd = wgid % NXCD, off = wgid / NXCD; wgid = (xcd < r ? xcd * (q + 1) : r * (q + 1) + (xcd - r) * q) + off; }
    const int nig = WGM * nN, gid = wgid / nig, fm = gid * WGM, gsz = (nM - fm) < WGM ? (nM - fm) : WGM;
    pm = fm + ((wgid % nig) % gsz); pn = (wgid % nig) / gsz; return true;
}

template <class Epi, class Sched, bool ALIGN_EPI, bool GATHER = false>
__device__ __forceinline__ void gemm_phase(LAS unsigned char* lds, const Gemm g, const Sched& S, const Epi& E, const char* Abase = nullptr, const LAS int* rm = nullptr) {
    int tid_ = threadIdx.x; asm volatile("" : "+v"(tid_));
    const int tid = tid_, wid = __builtin_amdgcn_readfirstlane(tid >> 6), lane = tid & 63, wr = wid >> 2, wc = wid & 3, fr = lane & 15, fq = lane >> 4;
    unsigned voffA[2], voffB[2];
#pragma unroll
    for (int i = 0; i < 2; ++i) { int R, C; stage_rc(tid * 16 + i * 8192, R, C); const int Rb = (R & ~31) + perm32(R & 31);
        voffA[i] = (unsigned)(R * g.lda + C * 2); voffB[i] = (unsigned)(Rb * g.ldb + C * 2); }
    const size_t kstep = (size_t)(BK * 2);
    const size_t hsA = (size_t)HALF * g.lda, hsB = (size_t)HALF * g.ldb;
    int rIdx[2], cOff[2];
#pragma unroll
    for (int i = 0; i < 2; ++i) { int R, C; stage_rc(tid * 16 + i * 8192, R, C); rIdx[i] = R; cOff[i] = C * 2; }
    unsigned vgc[2][2], vgn[2][2];
    auto load_vg = [&](unsigned (&v)[2][2], int unit_i) {
#pragma unroll
        for (int h = 0; h < 2; ++h)
#pragma unroll
            for (int i = 0; i < 2; ++i) v[h][i] = (unsigned)rm[unit_i * 256 + h * 128 + rIdx[i]] * (unsigned)g.lda + (unsigned)cOff[i]; };
    const unsigned ldsw = (unsigned)wid * 1024u;
    const int aoff = lds_byte(wr * 64 + fr, fq * 8), boff = lds_byte(wc * 32 + fr, fq * 8);
#define PG8_SA(b, h) (((b) * 2 + (h)) * HTB)
#define PG8_SB(b, h) ((4 + (b) * 2 + (h)) * HTB)
#define PG8_STAGE(bufoff, gbase, voff) do { _Pragma("unroll") for (int _i = 0; _i < 2; ++_i) \
        __builtin_amdgcn_global_load_lds((const unsigned*)((const char*)(gbase) + (voff)[_i]), (LAS unsigned*)(lds + (bufoff) + ldsw + _i * 8192), 16, 0, 0); } while (0)
#define PG8_STAGE_A(bufoff, gptr, kt, h, nx) do { if constexpr (GATHER) { _Pragma("unroll") for (int _i = 0; _i < 2; ++_i) \
        __builtin_amdgcn_global_load_lds((const unsigned*)(Abase + (size_t)(kt) * kstep + ((nx) ? vgn[h][_i] : vgc[h][_i])), (LAS unsigned*)(lds + (bufoff) + ldsw + _i * 8192), 16, 0, 0); } \
        else { PG8_STAGE(bufoff, gptr, voffA); } } while (0)
#define PG8_LDA(dst, b, h) do { _Pragma("unroll") for (int m = 0; m < 4; ++m) _Pragma("unroll") for (int k = 0; k < 2; ++k) dst[m][k] = *(const LAS bf16x8*)(lds + PG8_SA(b, h) + aoff + m * 2048 + k * 1024); } while (0)
#define PG8_LDB(dst, b, h) do { _Pragma("unroll") for (int n = 0; n < 2; ++n) _Pragma("unroll") for (int k = 0; k < 2; ++k) dst[n][k] = *(const LAS bf16x8*)(lds + PG8_SB(b, h) + boff + n * 2048 + k * 1024); } while (0)
#define PG8_MMA(ai, bj, At, Bt) do { __builtin_amdgcn_s_setprio(1); _Pragma("unroll") for (int m = 0; m < 4; ++m) _Pragma("unroll") for (int n = 0; n < 2; ++n) _Pragma("unroll") for (int k = 0; k < 2; ++k) \
        acc[ai][bj][m][n] = __builtin_amdgcn_mfma_f32_16x16x32_bf16(Bt[n][k], At[m][k], acc[ai][bj][m][n], 0, 0, 0); __builtin_amdgcn_s_setprio(0); } while (0)
#define PG8_WAIT_V(n) asm volatile("s_waitcnt vmcnt(" #n ")" ::: "memory")
#define PG8_WAIT_L(n) asm volatile("s_waitcnt lgkmcnt(" #n ")" ::: "memory")
#define PG8_BAR __builtin_amdgcn_s_barrier()
#define PG8_SCHED __builtin_amdgcn_sched_barrier(0)
    Unit cur, nxt; int ui = 0;
    if (!S.next(0, cur)) return;
    f32x4 acc[2][2][4][2];
#pragma unroll
    for (int a = 0; a < 2; ++a)
#pragma unroll
        for (int b = 0; b < 2; ++b)
#pragma unroll
            for (int m = 0; m < 4; ++m)
#pragma unroll
                for (int n = 0; n < 2; ++n) acc[a][b][m][n] = (f32x4){0.f, 0.f, 0.f, 0.f};
    bf16x8 At[4][2], B0[2][2], B1[2][2];
    const char* cA = cur.A; const char* cB = cur.B;
    if constexpr (GATHER) load_vg(vgc, 0);
    PG8_STAGE(PG8_SB(0, 0), cB, voffB); PG8_STAGE(PG8_SB(0, 1), cB + hsB, voffB); PG8_STAGE_A(PG8_SA(0, 0), cA, 0, 0, false); PG8_STAGE_A(PG8_SA(0, 1), cA + hsA, 0, 1, false);
    if (wr == 1) PG8_BAR;
    PG8_WAIT_V(2); PG8_BAR;
    PG8_STAGE(PG8_SB(1, 0), cB + kstep, voffB); PG8_STAGE_A(PG8_SA(1, 0), cA + kstep, 1, 0, false); PG8_STAGE(PG8_SB(1, 1), cB + hsB + kstep, voffB);
    PG8_WAIT_V(6); PG8_BAR;
    for (;;) {
        const bool has_next = S.next(ui + 1, nxt);
        const int nt = cur.nt;
        if constexpr (GATHER) { if (has_next) load_vg(vgn, ui + 1); else { vgn[0][0] = vgc[0][0]; vgn[0][1] = vgc[0][1]; vgn[1][0] = vgc[1][0]; vgn[1][1] = vgc[1][1]; } }
        const char* nA = has_next ? nxt.A : cA; const char* nB = has_next ? nxt.B : cB;
        for (int t = 0; t < nt; t += 2) {
            const bool last = (t == nt - 2);
            const char* a1 = cA + (size_t)(t + 1) * kstep;
            const char* a2 = last ? nA : cA + (size_t)(t + 2) * kstep; const char* b2 = last ? nB : cB + (size_t)(t + 2) * kstep;
            const char* a3 = a2 + kstep; const char* b3 = b2 + kstep;
            PG8_LDB(B0, 0, 0); PG8_LDB(B1, 0, 1); PG8_SCHED; PG8_LDA(At, 0, 0); PG8_STAGE_A(PG8_SA(1, 1), a1 + hsA, t + 1, 1, false);
            PG8_WAIT_V(8); PG8_WAIT_L(0); PG8_BAR; PG8_MMA(0, 0, At, B0); PG8_MMA(0, 1, At, B1); PG8_BAR; PG8_SCHED;
            PG8_LDA(At, 0, 1); PG8_STAGE(PG8_SB(0, 0), b2, voffB); PG8_STAGE(PG8_SB(0, 1), b2 + hsB, voffB); PG8_STAGE_A(PG8_SA(0, 0), a2, (last ? 0 : t + 2), 0, last);
            PG8_WAIT_V(8); PG8_WAIT_L(0); PG8_BAR; PG8_MMA(1, 0, At, B0); PG8_MMA(1, 1, At, B1); PG8_BAR; PG8_SCHED;
            PG8_LDB(B0, 1, 0); PG8_LDB(B1, 1, 1); PG8_SCHED; PG8_LDA(At, 1, 0); PG8_STAGE_A(PG8_SA(0, 1), a2 + hsA, (last ? 0 : t + 2), 1, last);
            PG8_WAIT_V(8); PG8_WAIT_L(0); PG8_BAR; PG8_MMA(0, 0, At, B0); PG8_MMA(0, 1, At, B1); PG8_BAR; PG8_SCHED;
            PG8_LDA(At, 1, 1); PG8_STAGE(PG8_SB(1, 0), b3, voffB); PG8_STAGE(PG8_SB(1, 1), b3 + hsB, voffB); PG8_STAGE_A(PG8_SA(1, 0), a3, (last ? 1 : t + 3), 0, last);
            PG8_WAIT_V(8); PG8_WAIT_L(0); PG8_BAR; PG8_MMA(1, 0, At, B0); PG8_MMA(1, 1, At, B1); PG8_BAR; PG8_SCHED;
        }
        if constexpr (ALIGN_EPI) { if (wr == 0) PG8_BAR; }
        E(acc, cur, wr, wc, fr, fq);
        if (!has_next) break;
#pragma unroll
        for (int a = 0; a < 2; ++a)
#pragma unroll
            for (int b = 0; b < 2; ++b)
#pragma unroll
                for (int m = 0; m < 4; ++m)
#pragma unroll
                    for (int n = 0; n < 2; ++n) acc[a][b][m][n] = (f32x4){0.f, 0.f, 0.f, 0.f};
        cur = nxt; cA = nA; cB = nB; ++ui;
        if constexpr (GATHER) { vgc[0][0] = vgn[0][0]; vgc[0][1] = vgn[0][1]; vgc[1][0] = vgn[1][0]; vgc[1][1] = vgn[1][1]; }
        if constexpr (ALIGN_EPI) { if (wr == 1) PG8_BAR; }
    }
    PG8_WAIT_V(0);
    if constexpr (!ALIGN_EPI) { if (wr == 0) PG8_BAR; }
    PG8_BAR;
#undef PG8_SA
#undef PG8_SB
#undef PG8_STAGE
#undef PG8_STAGE_A
#undef PG8_LDA
#undef PG8_LDB
#undef PG8_MMA
#undef PG8_WAIT_V
#undef PG8_WAIT_L
#undef PG8_BAR
#undef PG8_SCHED
}
}

struct Args {
    const float* in[26];
    float* out; unsigned char* ws;
    int ph_lo, ph_hi;
};
struct Frame {
    LAS unsigned char* lds;
    unsigned char* ws; float* out;
    int tid, lane, wave, vcu, G, bx;
};
__device__ __forceinline__ const float* inptr(int i) {
    const __attribute__((address_space(4))) unsigned char* kp = (const __attribute__((address_space(4))) unsigned char*)__builtin_amdgcn_kernarg_segment_ptr();
    asm volatile("" : "+s"(kp));
    const __attribute__((address_space(1))) float* gp = *(const __attribute__((address_space(1))) float* const __attribute__((address_space(4)))*)(kp + 8 * i);
    return (const float*)gp;
}
__device__ __forceinline__ Frame launder(const Frame& F) {
    Frame P = F; int t = F.tid; int g = F.G, v = F.vcu, wv = F.wave, bx = F.bx;
    __attribute__((address_space(1))) unsigned char* w = (__attribute__((address_space(1))) unsigned char*)F.ws; __attribute__((address_space(1))) float* o = (__attribute__((address_space(1))) float*)F.out;
    asm volatile("" : "+v"(t), "+s"(w), "+s"(o), "+s"(g), "+s"(v), "+s"(wv), "+s"(bx));
    P.tid = t; P.lane = t & 63; P.ws = (unsigned char*)w; P.out = (float*)o; P.G = g; P.vcu = v; P.wave = wv; P.bx = bx; return P;
}
enum { I_X = 0, I_C, I_CTX, I_CCTX, I_WMOD, I_BMOD, I_GMIX, I_GFFN, I_WIN, I_POOLW, I_POOLS, I_DLAM, I_DNG, I_RPB, I_QN, I_KN, I_WBR, I_WOUT, I_WRG, I_BRG, I_WRE, I_BRE, I_WEG, I_WEU, I_WED, I_GFIN };
#define WSF(off) ((float*)(F.ws + (off)))
#define WSB(off) ((bf16_t*)(F.ws + (off)))
#define WSU(off) ((unsigned*)(F.ws + (off)))

template <class RowMap>
__device__ __forceinline__ void transpose_item(const float* W, int K, int N, bf16_t* WT, int ldt, LAS float* scr, int item, int lane, const RowMap& rm, const float scale = 1.0f) {
    const int nblk = N / 32, kb = item / nblk, nb = item % nblk, k0 = 64 * kb, n0 = 32 * nb;
    float wv[32];
#pragma unroll
    for (int i = 0; i < 32; ++i) { const int kk = 2 * i + (lane >> 5); wv[i] = __builtin_nontemporal_load(W + (size_t)(k0 + kk) * N + n0 + (lane & 31)); }
#pragma unroll
    for (int i = 0; i < 32; ++i) { const int kk = 2 * i + (lane >> 5); scr[kk * 33 + (lane & 31)] = wv[i]; }
    asm volatile("s_waitcnt lgkmcnt(0)" ::: "memory");
    const int c = lane & 7;
#pragma unroll
    for (int j = 0; j < 4; ++j) { const int n = (lane >> 3) + 8 * j; const LAS float* s = scr + (8 * c) * 33 + n;
        u32x4 o; o.x = pk2(s[0 * 33] * scale, s[1 * 33] * scale); o.y = pk2(s[2 * 33] * scale, s[3 * 33] * scale); o.z = pk2(s[4 * 33] * scale, s[5 * 33] * scale); o.w = pk2(s[6 * 33] * scale, s[7 * 33] * scale);
        *(u32x4*)(WT + (size_t)rm(n0 + n) * ldt + k0 + 8 * c) = o; }
    asm volatile("s_waitcnt lgkmcnt(0)" ::: "memory");
}
struct RowId { __device__ __forceinline__ int operator()(int n) const { return n; } };
struct RowGU { int up; __device__ __forceinline__ int operator()(int n) const { return 256 * (n >> 7) + 128 * up + (n & 127); } };

__device__ __forceinline__ void p0_prologue(Frame& F, int part) {
    LAS float* scr = (LAS float*)(F.lds + F.wave * 16384);
    const int gw = F.vcu * 8 + F.wave, NGW = F.G * 8;
    const float *w_in = inptr(I_WIN), *w_out = inptr(I_WOUT), *w_branch = inptr(I_WBR), *pool_w = inptr(I_POOLW), *pool_scale = inptr(I_POOLS);
    bf16_t *WIN = WSB(WS_WIN), *WOUT = WSB(WS_WOUT), *WBR = WSB(WS_WBR); float* MOD = WSF(WS_MOD);
    if (part == 1) {
    constexpr int I_IN = 16 * 200, I_OUT = 16 * 32, I_BR = 4 * 32;
    constexpr int PER_L = I_IN + I_OUT + 3 * I_BR, NITEMS = 2 * PER_L;
    for (int it = gw; it < NITEMS; it += NGW) {
        const int l = it / PER_L; int r = it % PER_L;
        if (r < I_IN) { transpose_item(w_in + (size_t)l * D * NIN, D, NIN, WIN + (size_t)l * NIN * D, D, scr, r, F.lane, RowId{}, (r % 200) >= 72 ? -LOG2E : 1.0f); continue; } r -= I_IN;
        if (r < I_OUT) { transpose_item(w_out + (size_t)l * D * D, D, D, WOUT + (size_t)l * D * D, D, scr, r, F.lane, RowId{}); continue; } r -= I_OUT;
        const int br = 1 + r / I_BR; r %= I_BR;
        transpose_item(w_branch + ((size_t)l * 4 + br) * 256 * D, 256, D, WBR + ((size_t)l * 4 + br) * D * D, D, scr, r, F.lane, RowId{}, 1.0f / 255.0f);
    }
    for (int it = gw; it < 2 * 4 * 16 * 8; it += NGW) {
        const int l = it >> 9, g = (it >> 7) & 3, n = ((it >> 3) & 15) * 64 + F.lane, c8 = it & 7;
        const float* pw = pool_w + (size_t)(l * 4 + g) * 4096 + c8 * 8 * 64;
        const float* ps = pool_scale + l * 256 + 64 * g;
        const float* wb = w_branch + ((size_t)(l * 4 + 0) * 256 + 64 * g) * D + n;
        float o[8];
#pragma unroll
        for (int cc = 0; cc < 8; ++cc) o[cc] = 0.f;
        float wbv[64];
#pragma unroll
        for (int cp = 0; cp < 64; ++cp) wbv[cp] = wb[(size_t)cp * D];
#pragma unroll
        for (int cp = 0; cp < 64; ++cp) { const float w = ps[cp] * wbv[cp];
#pragma unroll
            for (int cc = 0; cc < 8; ++cc) o[cc] += pw[cc * 64 + cp] * w; }
        constexpr float I255 = 1.0f / 255.0f;
        u32x4 w; w.x = pk2(o[0] * I255, o[1] * I255); w.y = pk2(o[2] * I255, o[3] * I255); w.z = pk2(o[4] * I255, o[5] * I255); w.w = pk2(o[6] * I255, o[7] * I255);
        *(u32x4*)(WBR + ((size_t)l * 4 + 0) * D * D + (size_t)n * D + 64 * g + c8 * 8) = w;
    }
    return; }
    if (F.vcu < 192) {
        const float *cvec = inptr(I_C), *c_ctx = inptr(I_CCTX), *w_mod = inptr(I_WMOD), *b_mod = inptr(I_BMOD);
        __syncthreads();
        LAS float* sv = (LAS float*)(F.lds);
        LAS float* part = (LAS float*)(F.lds + 65536);
        for (int i = F.tid; i < 9 * 1024; i += 512) { const int bb = i >> 10, k = i & 1023; const float v = bb < 8 ? cvec[bb * 1024 + k] : c_ctx[k]; sv[i] = v / (1.0f + __expf(-v)); }
        __syncthreads();
        const int l = F.vcu / 96, j = (F.vcu % 96) * 64 + F.lane;
        float acc[9];
#pragma unroll
        for (int bb = 0; bb < 9; ++bb) acc[bb] = 0.f;
        const float* wm = w_mod + (size_t)l * D * 6144 + j;
        for (int k0 = F.wave * 128; k0 < F.wave * 128 + 128; k0 += 16) { float w[16];
#pragma unroll
            for (int u = 0; u < 16; ++u) w[u] = __builtin_nontemporal_load(wm + (size_t)(k0 + u) * 6144);
#pragma unroll
            for (int u = 0; u < 16; ++u)
#pragma unroll
                for (int bb = 0; bb < 9; ++bb) acc[bb] += sv[bb * 1024 + k0 + u] * w[u]; }
#pragma unroll
        for (int bb = 0; bb < 9; ++bb) part[(F.wave * 9 + bb) * 64 + F.lane] = acc[bb];
        __syncthreads();
        for (int i = F.tid; i < 9 * 64; i += 512) { const int bb = i >> 6, jj = i & 63; float s = 0.f;
#pragma unroll
            for (int w = 0; w < 8; ++w) s += part[(w * 9 + bb) * 64 + jj];
            const int col = (F.vcu % 96) * 64 + jj;
            MOD[((size_t)l * 9 + bb) * 6144 + col] = s + b_mod[l * 6144 + col]; }
        __syncthreads();
    }
    if (F.vcu == 200 && F.tid < 2) {
        const float* diff_lambda = inptr(I_DLAM);
        const int l = F.tid; const float* lf = diff_lambda + l * 128; float s0 = 0.f, s1 = 0.f;
        for (int i = 0; i < 32; ++i) { s0 += lf[i] * lf[32 + i]; s1 += lf[64 + i] * lf[96 + i]; }
        const float lam_init = 0.8f - 0.6f * expf(-0.3f * (float)l);
        MOD[131072 + l] = expf(s0) - expf(s1) + lam_init;
    }
}

__device__ __forceinline__ void phase_modulate(Frame& F, int l, int part) {
    const int gw = F.vcu * 8 + F.wave, NGW = F.G * 8;
    const float *xin = inptr(I_X), *ctxin = inptr(I_CTX), *g_mix = inptr(I_GMIX), *g_final = inptr(I_GFIN);
    float *MOD = WSF(WS_MOD), *XCTX = WSF(WS_XCTX); unsigned* ROUTE = WSU(WS_ROUTE); bf16_t *Y = WSB(WS_Y), *PROJ = WSB(WS_PROJ);
    const bool comb = (l > 0) && (part != 2);
    f32x4 vn[2][4]; bool okn[2]; float* xrn[2]; u32x2 ppn[2];
    auto issue = [&](const int row0) {
#pragma unroll
        for (int q = 0; q < 2; ++q) {
            const int row = row0 + q * NGW; okn[q] = row < T; xrn[q] = nullptr; ppn[q] = (u32x2){0u, 0u};
            if (okn[q]) { const int b = row / TPB, t = row % TPB; const bool isctx = t >= SEQ;
                if (isctx && l == 2) { okn[q] = false; }
                else {
                    const float* src0 = (l == 0) ? (isctx ? ctxin + ((size_t)b * CTXL + (t - SEQ)) * D : xin + ((size_t)b * SEQ + t) * D)
                                                 : (isctx ? XCTX + ((size_t)b * CTXL + (t - SEQ)) * D : F.out + ((size_t)b * SEQ + t) * D);
                    xrn[q] = const_cast<float*>(src0);
                    const f32x4* src = (const f32x4*)src0 + F.lane;
#pragma unroll
                    for (int j = 0; j < 4; ++j) vn[q][j] = src[64 * j];
                    if (comb) ppn[q] = *(const u32x2*)(ROUTE + (size_t)row * 8 + 6);
                } }
        } };
    issue(gw);
    for (int row0 = gw; row0 < T; row0 += 2 * NGW) {
        f32x4 v[2][4]; bool ok[2]; float* xr[2]; u32x2 pp[2]; u32x2 ya[2][4], yb[2][4];
#pragma unroll
        for (int q = 0; q < 2; ++q) { ok[q] = okn[q]; xr[q] = xrn[q]; pp[q] = ppn[q];
#pragma unroll
            for (int j = 0; j < 4; ++j) v[q][j] = vn[q][j]; }
        if (comb) {
#pragma unroll
            for (int q = 0; q < 2; ++q) if (ok[q]) {
                const u32x2* y0 = (const u32x2*)(Y + (size_t)pp[q].x * D) + F.lane; const u32x2* y1 = (const u32x2*)(Y + (size_t)pp[q].y * D) + F.lane;
#pragma unroll
                for (int j = 0; j < 4; ++j) { ya[q][j] = y0[64 * j]; yb[q][j] = y1[64 * j]; } }
        }
        issue(row0 + 2 * NGW);
#pragma unroll
        for (int q = 0; q < 2; ++q) if (ok[q]) {
            const int row = row0 + q * NGW; const int b = row / TPB, t = row % TPB; const bool isctx = t >= SEQ; const int mb = isctx ? 8 : b;
            if (comb) {
                const f32x4* gt = (const f32x4*)(MOD + ((size_t)(l - 1) * 9 + mb) * 6144 + 5 * 1024) + F.lane;
#pragma unroll
                for (int j = 0; j < 4; ++j) { const u32x2 a = ya[q][j], c2 = yb[q][j]; const f32x4 g = gt[64 * j];
                    v[q][j].x += g.x * (bflo(a.x) + bflo(c2.x)); v[q][j].y += g.y * (bfhi(a.x) + bfhi(c2.x)); v[q][j].z += g.z * (bflo(a.y) + bflo(c2.y)); v[q][j].w += g.w * (bfhi(a.y) + bfhi(c2.y)); }
                if (l < 2) { f32x4* dst = (f32x4*)xr[q] + F.lane;
#pragma unroll
                    for (int j = 0; j < 4; ++j) dst[64 * j] = v[q][j]; }
            }
            if (part == 1) continue;
            float ss = 0.f;
#pragma unroll
            for (int j = 0; j < 4; ++j) ss += (v[q][j].x * v[q][j].x + v[q][j].y * v[q][j].y) + (v[q][j].z * v[q][j].z + v[q][j].w * v[q][j].w);
            const float r = rsqrtf(wave_sum(ss) * (1.0f / D) + RMS_EPS);
            if (l == 2) {
                f32x4* dst = (f32x4*)(F.out + ((size_t)b * SEQ + t) * D) + F.lane; const f32x4* g = (const f32x4*)g_final + F.lane;
#pragma unroll
                for (int j = 0; j < 4; ++j) dst[64 * j] = v[q][j] * r * g[64 * j];
            } else {
                const f32x4* g = (const f32x4*)(g_mix + l * D) + F.lane;
                const f32x4* sh = (const f32x4*)(MOD + ((size_t)l * 9 + mb) * 6144) + F.lane; const f32x4* sc = sh + 256;
                u32x2* dst = (u32x2*)(PROJ + (size_t)row * LDP + C_H) + F.lane;
#pragma unroll
                for (int j = 0; j < 4; ++j) { const f32x4 o = (v[q][j] * r * g[64 * j]) * (sc[64 * j] + 1.0f) + sh[64 * j]; u32x2 w; w.x = pk2(o.x, o.y); w.y = pk2(o.z, o.w); dst[64 * j] = w; }
            }
        }
    }
}

struct SchedIn {
    int G, c; const char* A; const char* B;
    __device__ __forceinline__ bool next(int i, pg8::Unit& u) const {
        int pm, pn; if (!pg8::tile_order(T / 256, 9, G, c, i, pm, pn)) return false;
        u.pm = pm; u.pn = pn; u.aux = 0; u.nt = D / 64; u.A = A + (size_t)pm * 256 * (LDP * 2); u.B = B + (size_t)pn * 256 * (D * 2); return true; }
};
struct EpiIn {
    bf16_t* PROJ;
    __device__ __forceinline__ void operator()(const f32x4 (&acc)[2][2][4][2], const pg8::Unit& u, int wr, int wc, int fr, int fq) const {
        const int row0 = u.pm * 256 + wr * 64 + fr;
        bf16_t* base = PROJ + (size_t)u.pn * 256 + wc * 32 + 8 * fq;
#pragma unroll
        for (int ai = 0; ai < 2; ++ai)
#pragma unroll
            for (int m = 0; m < 4; ++m) { bf16_t* rowp = base + (size_t)(row0 + ai * 128 + m * 16) * LDP;
#pragma unroll
                for (int bj = 0; bj < 2; ++bj) { const f32x4 v0 = acc[ai][bj][m][0], v1 = acc[ai][bj][m][1];
                    u32x4 w; w.x = cvt_pk_bf16(v0.x, v0.y); w.y = cvt_pk_bf16(v0.z, v0.w); w.z = cvt_pk_bf16(v1.x, v1.y); w.w = cvt_pk_bf16(v1.z, v1.w);
                    *(u32x4*)(rowp + bj * 128) = w; } }
    }
};
__device__ __forceinline__ int branch_col(int br) { return br == 0 ? C_POOL : (br == 1 ? C_DQ : (br == 2 ? C_NQ : C_GQ)); }
struct SchedMerge {
    int G, c, nM, skip, split; const char* PROJ; const char* WG; const char* WBR;
    __device__ __forceinline__ bool next(int i, pg8::Unit& u) const {
        int pm, pn, sub, aux;
        if (split && c < 128 && i < 2) { const int ct = c >> 2, br = c & 3; pm = (ct >> 2) * 17 + 16; pn = ct & 3; sub = 2 * br + i; aux = sub | 8; }
        else { const int ii = (split && c < 128) ? i - 2 : i;
            if (!pg8::tile_order(nM, 4, G, c, ii >> 3, pm, pn)) return false;
            if (skip) pm += pm >> 4;
            sub = ii & 7; aux = sub; }
        const int br = sub >> 1; u.pm = pm; u.pn = pn; u.aux = aux;
        if ((sub & 1) == 0) { u.nt = D / 64; u.A = PROJ + ((size_t)pm * 256 * LDP + C_H) * 2; u.B = WG + ((size_t)br * 1024 + (size_t)pn * 256) * (D * 2); }
        else { u.nt = 4; u.A = PROJ + ((size_t)pm * 256 * LDP + branch_col(br)) * 2; u.B = WBR + ((size_t)br * 1024 + (size_t)pn * 256) * (D * 2); }
        return true; }
};
struct EpiMerge {
    mutable unsigned gp[32];
    bf16_t* MERGED; bf16_t* SCR; bf16_t* SLAB;
    __device__ __forceinline__ void operator()(const f32x4 (&acc)[2][2][4][2], const pg8::Unit& u, int wr, int wc, int fr, int fq) const {
        const int sub = u.aux & 7, br = sub >> 1; const bool sjob = (u.aux & 8) != 0;
        int fr_ = fr, fq_ = fq; asm volatile("" : "+v"(fr_), "+v"(fq_));
        const int r0 = wr * 64 + fr_, c0 = wc * 32 + 8 * fq_;
        const int row0 = u.pm * 256 + r0, col0 = u.pn * 256 + c0;
        if ((sub & 1) == 0) {
#pragma unroll
            for (int ai = 0; ai < 2; ++ai)
#pragma unroll
                for (int bj = 0; bj < 2; ++bj)
#pragma unroll
                    for (int m = 0; m < 4; ++m)
#pragma unroll
                        for (int n = 0; n < 2; ++n) { const f32x4 v = acc[ai][bj][m][n]; unsigned w = 0u;
                            w = __builtin_amdgcn_cvt_pk_u8_f32(fast_rcp(__builtin_fmaf(fast_exp2(v.x), 1.0f / 255.0f, 1.0f / 255.0f)), 0, w); w = __builtin_amdgcn_cvt_pk_u8_f32(fast_rcp(__builtin_fmaf(fast_exp2(v.y), 1.0f / 255.0f, 1.0f / 255.0f)), 1, w);
                            w = __builtin_amdgcn_cvt_pk_u8_f32(fast_rcp(__builtin_fmaf(fast_exp2(v.z), 1.0f / 255.0f, 1.0f / 255.0f)), 2, w); w = __builtin_amdgcn_cvt_pk_u8_f32(fast_rcp(__builtin_fmaf(fast_exp2(v.w), 1.0f / 255.0f, 1.0f / 255.0f)), 3, w);
                            gp[((ai * 2 + bj) * 4 + m) * 2 + n] = w; }
        } else {
            const bool rd = (br > 0) && !sjob;
#pragma unroll
            for (int ai = 0; ai < 2; ++ai) {
                u32x4 oq[4][2];
#pragma unroll
                for (int m = 0; m < 4; ++m) { const int rl = r0 + ai * 128 + m * 16;
#pragma unroll
                    for (int bj = 0; bj < 2; ++bj) {
                        const u32x4* sp = sjob ? (const u32x4*)(SLAB + ((size_t)br * 2048 + (size_t)(u.pm / 17) * 256 + rl) * D + col0 + bj * 128)
                                               : (const u32x4*)(MERGED + (size_t)(row0 + ai * 128 + m * 16) * D + col0 + bj * 128);
                        oq[m][bj] = rd ? *sp : (u32x4){0u, 0u, 0u, 0u}; } }
#pragma unroll
                for (int m = 0; m < 4; ++m) { const int rl = r0 + ai * 128 + m * 16;
#pragma unroll
                    for (int bj = 0; bj < 2; ++bj) {
                        f32x4 v0 = acc[ai][bj][m][0], v1 = acc[ai][bj][m][1]; const u32x4 o = oq[m][bj];
                        const unsigned g0 = gp[((ai * 2 + bj) * 4 + m) * 2 + 0], g1 = gp[((ai * 2 + bj) * 4 + m) * 2 + 1];
                        v0.x = v0.x * (float)(g0 & 0xffu) + bflo(o.x); v0.y = v0.y * (float)((g0 >> 8) & 0xffu) + bfhi(o.x);
                        v0.z = v0.z * (float)((g0 >> 16) & 0xffu) + bflo(o.y); v0.w = v0.w * (float)(g0 >> 24) + bfhi(o.y);
                        v1.x = v1.x * (float)(g1 & 0xffu) + bflo(o.z); v1.y = v1.y * (float)((g1 >> 8) & 0xffu) + bfhi(o.z);
                        v1.z = v1.z * (float)((g1 >> 16) & 0xffu) + bflo(o.w); v1.w = v1.w * (float)(g1 >> 24) + bfhi(o.w);
                        u32x4 w; w.x = cvt_pk_bf16(v0.x, v0.y); w.y = cvt_pk_bf16(v0.z, v0.w); w.z = cvt_pk_bf16(v1.x, v1.y); w.w = cvt_pk_bf16(v1.z, v1.w);
                        u32x4* sp = sjob ? (u32x4*)(SLAB + ((size_t)br * 2048 + (size_t)(u.pm / 17) * 256 + rl) * D + col0 + bj * 128)
                                         : (u32x4*)(MERGED + (size_t)(row0 + ai * 128 + m * 16) * D + col0 + bj * 128);
                        *sp = w; } }
            }
        }
    }
};
struct SchedOut {
    int G, c, nM, skip; const char* A; const char* B; const char* PRIV;
    __device__ __forceinline__ bool next(int i, pg8::Unit& u) const {
        int pm, pn;
        if (PRIV != nullptr) {
            if (c < 32) { if (i == 0) { pm = (c >> 2) * 17 + 16; pn = c & 3; } else return false; }
            else if (c < 64 && i == 2) { if (!pg8::tile_order(128, 4, G, c - 32, 1, pm, pn)) return false; pm += pm >> 4; }
            else if (c >= 64 && c < 96 && i == 2) { if (!pg8::tile_order(128, 4, G, c - 64, 0, pm, pn)) return false; pm += pm >> 4; }
            else { if (i >= 2 || !pg8::tile_order(128, 4, G, c, i, pm, pn)) return false; pm += pm >> 4; }
        } else { if (!pg8::tile_order(nM, 4, G, c, i, pm, pn)) return false; if (skip) pm += pm >> 4; }
        u.pm = pm; u.pn = pn; u.aux = 0; u.nt = D / 64; u.B = B + (size_t)pn * 256 * (D * 2);
        u.A = (PRIV != nullptr && pm % 17 == 16) ? PRIV + (size_t)((pm / 17) * 4 + pn) * (256 * D * 2) : A + (size_t)pm * 256 * (D * 2);
        return true; }
};
__device__ __forceinline__ void sum_ctx_slabs(Frame& F, const SchedOut& S) {
    const bf16_t* SLAB = WSB(WS_SLAB); bf16_t* PRIV = WSB(WS_PRIV);
    for (int i = 0; i < 4; ++i) { pg8::Unit u; if (!S.next(i, u)) break;
        if (u.pm % 17 != 16) continue;
        const int b = u.pm / 17; bf16_t* dst = PRIV + (size_t)(b * 4 + u.pn) * 256 * D;
        for (int ch0 = F.tid; ch0 < 256 * 128; ch0 += 8 * 512) {
            u32x4 w[8][4];
#pragma unroll
            for (int q = 0; q < 8; ++q) { const int ch = ch0 + q * 512, r = ch >> 7, c8 = (ch & 127) * 8;
#pragma unroll
                for (int br = 0; br < 4; ++br) w[q][br] = *(const u32x4*)(SLAB + ((size_t)br * 2048 + (size_t)b * 256 + r) * D + c8); }
#pragma unroll
            for (int q = 0; q < 8; ++q) { const int ch = ch0 + q * 512, r = ch >> 7, c8 = (ch & 127) * 8; float s[8];
#pragma unroll
                for (int e = 0; e < 8; ++e) s[e] = 0.f;
#pragma unroll
                for (int br = 0; br < 4; ++br) { const u32x4 x = w[q][br];
                    s[0] += bflo(x.x); s[1] += bfhi(x.x); s[2] += bflo(x.y); s[3] += bfhi(x.y); s[4] += bflo(x.z); s[5] += bfhi(x.z); s[6] += bflo(x.w); s[7] += bfhi(x.w); }
                u32x4 o; o.x = pk2(s[0], s[1]); o.y = pk2(s[2], s[3]); o.z = pk2(s[4], s[5]); o.w = pk2(s[6], s[7]);
                *(u32x4*)(dst + (size_t)r * D + c8) = o; } } }
    asm volatile("s_waitcnt vmcnt(0)" ::: "memory");
    __syncthreads();
}
struct EpiOut {
    bf16_t* Y2; float* out; const float* MODL; int defer;
    __device__ __forceinline__ void operator()(const f32x4 (&acc)[2][2][4][2], const pg8::Unit& u, int wr, int wc, int fr, int fq) const {
        const int b = u.pm / 17, j = u.pm % 17; const bool isctx = j == 16;
        const float* gt = MODL + (size_t)(isctx ? 8 : b) * 6144 + 2 * 1024;
        const int r0 = wr * 64 + fr, col0 = u.pn * 256 + wc * 32 + 8 * fq;
        f32x4 g[2][2];
#pragma unroll
        for (int bj = 0; bj < 2; ++bj) { g[bj][0] = *(const f32x4*)(gt + col0 + bj * 128); g[bj][1] = *(const f32x4*)(gt + col0 + bj * 128 + 4); }
        if (defer) {
#pragma unroll
            for (int ai = 0; ai < 2; ++ai)
#pragma unroll
                for (int m = 0; m < 4; ++m) { const size_t off = ((size_t)u.pm * 256 + r0 + ai * 128 + m * 16) * D + col0;
#pragma unroll
                    for (int bj = 0; bj < 2; ++bj) { const f32x4 v0 = g[bj][0] * acc[ai][bj][m][0], v1 = g[bj][1] * acc[ai][bj][m][1];
                        u32x4 w; w.x = cvt_pk_bf16(v0.x, v0.y); w.y = cvt_pk_bf16(v0.z, v0.w); w.z = cvt_pk_bf16(v1.x, v1.y); w.w = cvt_pk_bf16(v1.z, v1.w);
                        *(u32x4*)(Y2 + off + bj * 128) = w; } }
        } else {
            const size_t rbase = (size_t)b * SEQ + j * 256;
#pragma unroll
            for (int ai = 0; ai < 2; ++ai) {
                f32x4 xs[4][2][2];
#pragma unroll
                for (int m = 0; m < 4; ++m) { const size_t off = (rbase + r0 + ai * 128 + m * 16) * D + col0;
#pragma unroll
                    for (int bj = 0; bj < 2; ++bj) { xs[m][bj][0] = *(const f32x4*)(out + off + bj * 128); xs[m][bj][1] = *(const f32x4*)(out + off + bj * 128 + 4); } }
#pragma unroll
                for (int m = 0; m < 4; ++m) { const size_t off = (rbase + r0 + ai * 128 + m * 16) * D + col0;
#pragma unroll
                    for (int bj = 0; bj < 2; ++bj) {
                        *(f32x4*)(out + off + bj * 128) = xs[m][bj][0] + g[bj][0] * acc[ai][bj][m][0];
                        *(f32x4*)(out + off + bj * 128 + 4) = xs[m][bj][1] + g[bj][1] * acc[ai][bj][m][1]; } }
            }
        }
    }
};
template <int KD>
struct SchedMoe {
    int G, c, ntiles; const LAS int* tile_e; const char* A; const char* B;
    __device__ __forceinline__ bool next(int i, pg8::Unit& u) const {
        const int L = i * G + c; if (L >= ntiles * 4) return false;
        const int k = L >> 2, j = L & 3, e = __builtin_amdgcn_readfirstlane(tile_e[k]);
        u.pm = k; u.pn = j; u.aux = e; u.nt = KD / 64; u.A = A + (size_t)k * (256 * KD * 2); u.B = B + ((size_t)e * 1024 + (size_t)j * 256) * (KD * 2); return true; }
};
struct EpiGU {
    bf16_t* HMID;
    __device__ __forceinline__ void operator()(const f32x4 (&acc)[2][2][4][2], const pg8::Unit& u, int wr, int wc, int fr, int fq) const {
        const int row0 = u.pm * 256 + wr * 64 + fr, col0 = u.pn * 128 + wc * 32 + 8 * fq;
#pragma unroll
        for (int ai = 0; ai < 2; ++ai)
#pragma unroll
            for (int m = 0; m < 4; ++m) {
                float h[8];
#pragma unroll
                for (int n = 0; n < 2; ++n)
#pragma unroll
                    for (int e = 0; e < 4; ++e) { const float gv = acc[ai][0][m][n][e], uv = acc[ai][1][m][n][e]; h[n * 4 + e] = gv * sigmoidf_(gv) * uv; }
                u32x4 w; w.x = cvt_pk_bf16(h[0], h[1]); w.y = cvt_pk_bf16(h[2], h[3]); w.z = cvt_pk_bf16(h[4], h[5]); w.w = cvt_pk_bf16(h[6], h[7]);
                *(u32x4*)(HMID + (size_t)(row0 + ai * 128 + m * 16) * DEXP + col0) = w; }
    }
};
struct EpiDown {
    bf16_t* Y; const float* ROWW;
    __device__ __forceinline__ void operator()(const f32x4 (&acc)[2][2][4][2], const pg8::Unit& u, int wr, int wc, int fr, int fq) const {
        const int row0 = u.pm * 256 + wr * 64 + fr, col0 = u.pn * 256 + wc * 32 + 8 * fq;
#pragma unroll
        for (int ai = 0; ai < 2; ++ai)
#pragma unroll
            for (int m = 0; m < 4; ++m) { const size_t row = (size_t)(row0 + ai * 128 + m * 16); const float w8 = ROWW[row];
#pragma unroll
                for (int bj = 0; bj < 2; ++bj) { const f32x4 v0 = acc[ai][bj][m][0] * w8, v1 = acc[ai][bj][m][1] * w8;
                    u32x4 w; w.x = cvt_pk_bf16(v0.x, v0.y); w.y = cvt_pk_bf16(v0.z, v0.w); w.z = cvt_pk_bf16(v1.x, v1.y); w.w = cvt_pk_bf16(v1.z, v1.w);
                    *(u32x4*)(Y + row * D + col0 + bj * 128) = w; } }
    }
};

constexpr int ROPE_T8 = 131072, ROPE_T16 = 131072 + 64 * 8 * 2 * 4;
template <int NF>
__device__ __forceinline__ void rope8(float (&v)[8], float (&o)[8], const LAS f32x2* tab, int pos, int i0, bool second) {
#pragma unroll
    for (int e = 0; e < 8; ++e) { const f32x2 cs = tab[pos * NF + i0 + e]; v[e] = second ? (o[e] * cs.y + v[e] * cs.x) : (v[e] * cs.x - o[e] * cs.y); }
}
__device__ __forceinline__ void phase_post(Frame& F, int l) {
    const int gw = F.vcu * 8 + F.wave, NGW = F.G * 8, lane = F.lane;
    const float *gqa_q_norm = inptr(I_QN), *gqa_k_norm = inptr(I_KN); bf16_t *PROJ = WSB(WS_PROJ), *VT = WSB(WS_VT);
    { LAS f32x2* t8 = (LAS f32x2*)(F.lds + ROPE_T8); LAS f32x2* t16 = (LAS f32x2*)(F.lds + ROPE_T16);
      for (int i = F.tid; i < 64 * 8; i += 512) { const int pos = i >> 3, f = i & 7; float sn, cs; sincosf((float)pos * exp2f(-(float)f * (13.287712379549449f / 8.0f)), &sn, &cs); t8[i] = (f32x2){cs, sn}; }
      for (int i = F.tid; i < 64 * 16; i += 512) { const int pos = i >> 4, f = i & 15; float sn, cs; sincosf((float)pos * exp2f(-(float)f * (13.287712379549449f / 16.0f)), &sn, &cs); t16[i] = (f32x2){cs, sn}; }
      __syncthreads(); }
    const LAS f32x2* t8 = (const LAS f32x2*)(F.lds + ROPE_T8); const LAS f32x2* t16 = (const LAS f32x2*)(F.lds + ROPE_T16);
    for (int row = gw; row < T; row += NGW) {
        const int b = row / TPB, t = row % TPB; const bool isctx = t >= SEQ; (void)b;
        bf16_t* pr = PROJ + (size_t)row * LDP;
        const int prow = t >> 6, pcol = t & 63;
        const bool gact = lane < 48; const int lc = gact ? lane : 0;
        const u32x4 wD = *(const u32x4*)(pr + C_DQ + lane * 8);
        const u32x4 wN = *(const u32x4*)(pr + C_NQ + (lane & 31) * 8);
        const u32x4 wG = *(const u32x4*)(pr + C_GQ + lc * 8);
        const int win = 2 << (lane >> 4), nseq = isctx ? CTXL : SEQ, ts = isctx ? t - SEQ : t;
        const int lo = max(ts - win / 2, 0), hi = min(ts + win / 2, nseq);
        const bf16_t* ub = PROJ + ((size_t)(row - ts)) * LDP + lane * 4;
        u32x2 wu[16];
#pragma unroll
        for (int i = 0; i < 16; ++i) { const int ii = ts - 8 + i; wu[i] = (ii >= lo && ii < hi) ? *(const u32x2*)(ub + (size_t)ii * LDP) : (u32x2){0u, 0u}; }
        const u32x2 wself = *(const u32x2*)(ub + (size_t)ts * LDP);
        {
            u32x4 w = wD;
            float v[8] = {bflo(w.x), bfhi(w.x), bflo(w.y), bfhi(w.y), bflo(w.z), bfhi(w.z), bflo(w.w), bfhi(w.w)};
            if (!isctx) {
                float o[8];
#pragma unroll
                for (int e = 0; e < 8; ++e) o[e] = swz_xor<1>(v[e]);
                rope8<8>(v, o, t8, (lane & 2) ? pcol : prow, 0, (lane & 1) != 0);
            }
            const float sc = lane < 32 ? 0.17677669529663687f * LOG2E : 1.0f;
#pragma unroll
            for (int e = 0; e < 8; ++e) v[e] *= sc;
            w.x = pk2(v[0], v[1]); w.y = pk2(v[2], v[3]); w.z = pk2(v[4], v[5]); w.w = pk2(v[6], v[7]);
            *(u32x4*)(pr + C_DQ + lane * 8) = w;
        }
        if (lane < 32) {
            u32x4 w = wN; const float sc = 0.125f * LOG2E;
            w.x = pk2(bflo(w.x) * sc, bfhi(w.x) * sc); w.y = pk2(bflo(w.y) * sc, bfhi(w.y) * sc); w.z = pk2(bflo(w.z) * sc, bfhi(w.z) * sc); w.w = pk2(bflo(w.w) * sc, bfhi(w.w) * sc);
            *(u32x4*)(pr + C_NQ + lane * 8) = w;
        }
        {
            u32x4 w = wG;
            float v[8] = {bflo(w.x), bfhi(w.x), bflo(w.y), bfhi(w.y), bflo(w.z), bfhi(w.z), bflo(w.w), bfhi(w.w)};
            float ss = 0.f;
#pragma unroll
            for (int e = 0; e < 8; ++e) ss += v[e] * v[e];
            ss = sum8(ss);
            const float r = rsqrtf(ss * (1.0f / 64.0f) + RMS_EPS);
            const float* gn = (lc < 32 ? gqa_q_norm : gqa_k_norm) + l * 64 + (lc & 7) * 8;
#pragma unroll
            for (int e = 0; e < 8; ++e) v[e] = v[e] * r * gn[e];
            float o[8];
#pragma unroll
            for (int e = 0; e < 8; ++e) o[e] = swz_xor<2>(v[e]);
            if (!isctx) rope8<16>(v, o, t16, (lc & 4) ? pcol : prow, (lc & 1) * 8, (lc & 2) != 0);
            const float sc = lc < 32 ? 0.125f * LOG2E : 1.0f;
#pragma unroll
            for (int e = 0; e < 8; ++e) v[e] *= sc;
            w.x = pk2(v[0], v[1]); w.y = pk2(v[2], v[3]); w.z = pk2(v[4], v[5]); w.w = pk2(v[6], v[7]);
            if (gact) *(u32x4*)(pr + C_GQ + lc * 8) = w;
        }
        {
            float s0 = 0.f, s1 = 0.f, s2 = 0.f, s3 = 0.f;
#pragma unroll
            for (int i = 0; i < 16; ++i) { s0 += bflo(wu[i].x); s1 += bfhi(wu[i].x); s2 += bflo(wu[i].y); s3 += bfhi(wu[i].y); }
            const float inv = 1.0f / (float)(hi - lo);
            u32x2 o; o.x = pk2(s0 * inv - bflo(wself.x), s1 * inv - bfhi(wself.x)); o.y = pk2(s2 * inv - bflo(wself.y), s3 * inv - bfhi(wself.y));
            *(u32x2*)(pr + C_POOL + lane * 4) = o;
        }
    }
    LAS bf16_t* scr = (LAS bf16_t*)(F.lds + F.wave * 16384);
    for (int it = gw; it < (T / 64) * 10; it += NGW) {
        const int tt = it / 10, vh = it % 10, b = tt / 68, key0 = (tt % 68) * 64;
        const int vcol = vh < 4 ? C_DV + 64 * vh : (vh < 8 ? C_NV + 64 * (vh - 4) : C_GV + 64 * (vh - 8));
        const int lt = lane >> 3, lch = lane & 7;
        u32x4 w[8];
#pragma unroll
        for (int g = 0; g < 8; ++g) w[g] = *(const u32x4*)(PROJ + ((size_t)tt * 64 + g * 8 + lt) * LDP + vcol + lch * 8);
#pragma unroll
        for (int g = 0; g < 8; ++g) { const int tok = g * 8 + lt; LAS bf16_t* s = scr + (lch * 8) * 66 + tok;
            s[0 * 66] = (bf16_t)(w[g].x & 0xffff); s[1 * 66] = (bf16_t)(w[g].x >> 16); s[2 * 66] = (bf16_t)(w[g].y & 0xffff); s[3 * 66] = (bf16_t)(w[g].y >> 16);
            s[4 * 66] = (bf16_t)(w[g].z & 0xffff); s[5 * 66] = (bf16_t)(w[g].z >> 16); s[6 * 66] = (bf16_t)(w[g].w & 0xffff); s[7 * 66] = (bf16_t)(w[g].w >> 16); }
        asm volatile("s_waitcnt lgkmcnt(0)" ::: "memory");
#pragma unroll
        for (int g = 0; g < 8; ++g) { const int d = g * 8 + lt; const LAS unsigned* rd = (const LAS unsigned*)(scr + d * 66) + 8 * (lch >> 1) + 2 * (lch & 1);
            u32x4 o; o.x = rd[0]; o.y = rd[1]; o.z = rd[4]; o.w = rd[5];
            *(u32x4*)(VT + (((size_t)b * 10 + vh) * 64 + d) * TPB + key0 + lch * 8) = o; }
        asm volatile("s_waitcnt lgkmcnt(0)" ::: "memory");
    }
}

constexpr int ATT_K = 0, ATT_V = 16384, ATT_BIAS = 32768, ATT_Q = 36864;
constexpr float ATT_BIG = 1.0e12f;
template <int MODE>
__device__ __forceinline__ void attn_unit(Frame& F, int l, int b, int h, int qt) {
    LAS unsigned char* lds = F.lds;
    bf16_t* PROJ = WSB(WS_PROJ); const bf16_t* VT = WSB(WS_VT);
    int tid_ = F.tid; asm volatile("" : "+v"(tid_));
    const int tid = tid_, lane = tid & 63, wid = F.wave, r32 = lane & 31, hi = lane >> 5;
    const int qcol = MODE == 0 ? C_GQ + 64 * h : (MODE == 1 ? C_DQ + 64 * h : C_NQ + 64 * h);
    const int kcol = MODE == 0 ? C_GK + 64 * (h >> 1) : (MODE == 1 ? C_DK + 64 * h : C_NK + 64 * h);
    const int vh = MODE == 0 ? 8 + (h >> 1) : (MODE == 1 ? h : 4 + h);
    const size_t rowbase = (size_t)b * TPB;
    const size_t qrow = rowbase + (size_t)qt * 256 + wid * 32 + r32;
    int a0, nA, b0 = 0, nBt = 0;
    if (qt == 16) { a0 = 64; nA = 4; }
    else if (MODE == 2) { a0 = 64; nA = 4; b0 = min(max(4 * qt - 4, 0), 56); nBt = min(max(4 * qt - 1, 0), 56) + 8 - b0; }
    else { a0 = 0; nA = 68; }
    const int ntl = nA + nBt;
    bf16x8 qr[4];
    { const bf16_t* qp = PROJ + qrow * LDP + qcol + 8 * hi;
#pragma unroll
      for (int s = 0; s < 4; ++s) qr[s] = *(const bf16x8*)(qp + 16 * s); }
    const int srow = tid >> 3, sch = tid & 7;
    const bf16_t* kg = PROJ + (rowbase + srow) * LDP + kcol + sch * 8;
    const bf16_t* vg = VT + (((size_t)b * 10 + vh) * 64 + srow) * TPB + sch * 8;
    const int swz = (srow >> 1) & 7;
    const int kst = srow * 128 + ((sch ^ swz) << 4), vst = ATT_V + srow * 128 + ((sch ^ swz) << 4);
    const int rsw = (r32 >> 1) & 7;
    const int kfr = r32 * 128;
    const int vfr = ATT_V + r32 * 128;
    if (MODE == 2 && qt < 16) { for (int i = tid; i < 465; i += 512) ((LAS float*)(lds + ATT_BIAS))[i] = inptr(I_RPB)[((size_t)l * 4 + h) * 465 + i] * LOG2E; }
    float m0 = 0.f, l0 = 0.f, m1 = 0.f, l1 = 0.f;
    f32x16 oA[2], oB[2];
#pragma unroll
    for (int i = 0; i < 2; ++i) { oA[i] = (f32x16){}; oB[i] = (f32x16){}; }
    f32x16 ngm0 = (f32x16){}, ngm1 = (f32x16){};
    const int qgr = 4 * qt + (wid >> 1), qj = 32 * (wid & 1) + r32;
    const int wstart = min(max(qgr - 4, 0), 56), cst = min(max(qj - 8, 0), 48);

    auto tile_key0 = [&](int i) -> int { return (i < nA ? a0 + i : b0 + (i - nA)) * 64; };
    if constexpr (MODE == 0) {
        constexpr int PV0 = 32768;
        const int nst = ntl >> 1;
        u32x4 kr[2], vr[2];
#pragma unroll
        for (int u = 0; u < 2; ++u) { const int k0 = tile_key0(u); kr[u] = *(const u32x4*)(kg + (size_t)k0 * LDP); vr[u] = *(const u32x4*)(vg + k0); }
#pragma unroll
        for (int u = 0; u < 2; ++u) { *(LAS u32x4*)(lds + u * 8192 + kst) = kr[u]; const u32x4 vv = vr[u]; *(LAS u32x4*)(lds + PV0 - ATT_V + u * 8192 + vst) = vv; }
        __syncthreads();
        for (int ip = 0; ip < nst; ++ip) {
            const int buf = (ip & 1) * 16384;
            if (ip + 1 < nst) {
#pragma unroll
                for (int u = 0; u < 2; ++u) { const int k0 = tile_key0(2 * ip + 2 + u); kr[u] = *(const u32x4*)(kg + (size_t)k0 * LDP); vr[u] = *(const u32x4*)(vg + k0); } }
            f32x16 p[2][2];
            auto qk2 = [&]() {
#pragma unroll
                for (int u = 0; u < 2; ++u) { p[u][0] = ngm0; p[u][1] = ngm0;
#pragma unroll
                    for (int s = 0; s < 4; ++s) {
                        const bf16x8 k0f = *(const LAS bf16x8*)(lds + buf + u * 8192 + kfr + (((2 * s + hi) ^ rsw) << 4));
                        const bf16x8 k1f = *(const LAS bf16x8*)(lds + buf + u * 8192 + kfr + 4096 + (((2 * s + hi) ^ rsw) << 4));
                        p[u][0] = __builtin_amdgcn_mfma_f32_32x32x16_bf16(k0f, qr[s], p[u][0], 0, 0, 0);
                        p[u][1] = __builtin_amdgcn_mfma_f32_32x32x16_bf16(k1f, qr[s], p[u][1], 0, 0, 0);
                    } } };
            auto exact2 = [&](const bool first) {
                float mxa = -3.0e38f, mxb = -3.0e38f;
#pragma unroll
                for (int u = 0; u < 2; ++u)
#pragma unroll
                    for (int r = 0; r < 16; r += 2) { mxa = __builtin_fmaxf(__builtin_fmaxf(mxa, p[u][0][r]), p[u][0][r + 1]); mxb = __builtin_fmaxf(__builtin_fmaxf(mxb, p[u][1][r]), p[u][1][r + 1]); }
                const float dgrow = half_max(__builtin_fmaxf(mxa, mxb));
                const float dn = first ? dgrow : __builtin_fmaxf(dgrow, 0.f);
                const float alpha = first ? 0.f : fast_exp2(-dn);
                l0 *= alpha; oA[0] = oA[0] * alpha; oA[1] = oA[1] * alpha; ngm0 = ngm0 - dn;
#pragma unroll
                for (int u = 0; u < 2; ++u) { p[u][0] = p[u][0] - dn; p[u][1] = p[u][1] - dn; } };
            auto expsum2 = [&]() -> float {
                float ts = 0.f;
#pragma unroll
                for (int u = 0; u < 2; ++u) {
#pragma unroll
                    for (int r = 0; r < 16; ++r) { p[u][0][r] = fast_exp2(p[u][0][r]); p[u][1][r] = fast_exp2(p[u][1][r]); }
                    const f32x16 sv = p[u][0] + p[u][1]; const f32x4 s4 = (f32x4){sv[0], sv[1], sv[2], sv[3]} + (f32x4){sv[4], sv[5], sv[6], sv[7]} + (f32x4){sv[8], sv[9], sv[10], sv[11]} + (f32x4){sv[12], sv[13], sv[14], sv[15]};
                    ts += (s4.x + s4.y) + (s4.z + s4.w); }
                return ts; };
            qk2();
            if (ip == 0) exact2(true);
            float ts = expsum2();
            if (__builtin_amdgcn_ballot_w64(!(ts < ATT_BIG)) != 0ull) { qk2(); exact2(false); ts = expsum2(); }
            l0 += ts;
            bf16x8 pk[2][4];
#pragma unroll
            for (int u = 0; u < 2; ++u) {
#pragma unroll
                for (int s = 0; s < 4; ++s) { u32x4 w; const f32x16& pp = p[u][s >> 1]; const int q8 = 8 * (s & 1);
                    w.x = cvt_pk_bf16(pp[q8 + 0], pp[q8 + 1]); w.y = cvt_pk_bf16(pp[q8 + 2], pp[q8 + 3]); w.z = cvt_pk_bf16(pp[q8 + 4], pp[q8 + 5]); w.w = cvt_pk_bf16(pp[q8 + 6], pp[q8 + 7]);
                    pk[u][s] = __builtin_bit_cast(bf16x8, w); }
            }
            if (ip + 1 < nst) { const int nb = ((ip + 1) & 1) * 16384;
#pragma unroll
                for (int u = 0; u < 2; ++u) { *(LAS u32x4*)(lds + nb + u * 8192 + kst) = kr[u]; const u32x4 vv = vr[u]; *(LAS u32x4*)(lds + PV0 - ATT_V + nb + u * 8192 + vst) = vv; } }
#pragma unroll
            for (int u = 0; u < 2; ++u)
#pragma unroll
                for (int db = 0; db < 2; ++db)
#pragma unroll
                    for (int s = 0; s < 4; ++s) {
                        const bf16x8 vf = *(const LAS bf16x8*)(lds + PV0 - ATT_V + buf + u * 8192 + vfr + 4096 * db + (((2 * s + hi) ^ rsw) << 4));
                        oA[db] = __builtin_amdgcn_mfma_f32_32x32x16_bf16(vf, pk[u][s], oA[db], 0, 0, 0);
                    }
            __syncthreads();
        }
    } else {
    u32x4 kreg, vreg;
    { const int k0 = tile_key0(0); kreg = *(const u32x4*)(kg + (size_t)k0 * LDP); vreg = *(const u32x4*)(vg + k0); }
    { *(LAS u32x4*)(lds + kst) = kreg; const u32x4 vv = vreg; *(LAS u32x4*)(lds + vst) = vv; }
    __syncthreads();
    for (int i = 0; i < ntl; ++i) {
        const int buf = (i & 1) * 8192;
        if (i + 1 < ntl) { const int k0 = tile_key0(i + 1); kreg = *(const u32x4*)(kg + (size_t)k0 * LDP); vreg = *(const u32x4*)(vg + k0); }
        bool part = true; int dr = 0;
        if (MODE == 2 && i >= nA) { const int kr = b0 + (i - nA); part = (kr >= wstart) && (kr < wstart + 8); dr = kr - qgr + 7; }
        if (part) {
            bf16x8 pk[MODE == 1 ? 2 : 1][4];
#pragma unroll
            for (int c = 0; c < (MODE == 1 ? 2 : 1); ++c) {
                f32x16& ngm = (c == 0) ? ngm0 : ngm1;
                float& ll = (c == 0) ? l0 : l1; f32x16* oo = (c == 0) ? oA : oB;
                f32x16 p0, p1;
                auto qk1 = [&]() {
                    p0 = ngm; p1 = ngm;
#pragma unroll
                    for (int s = (MODE == 1 ? 2 * c : 0); s < (MODE == 1 ? 2 * c + 2 : 4); ++s) {
                        const bf16x8 k0f = *(const LAS bf16x8*)(lds + buf + kfr + (((2 * s + hi) ^ rsw) << 4));
                        const bf16x8 k1f = *(const LAS bf16x8*)(lds + buf + kfr + 4096 + (((2 * s + hi) ^ rsw) << 4));
                        p0 = __builtin_amdgcn_mfma_f32_32x32x16_bf16(k0f, qr[s], p0, 0, 0, 0);
                        p1 = __builtin_amdgcn_mfma_f32_32x32x16_bf16(k1f, qr[s], p1, 0, 0, 0);
                    }
                    if (MODE == 2 && i >= nA) {
                        const LAS float* bt = (const LAS float*)(lds + ATT_BIAS) + dr * 31 + 15 - qj;
#pragma unroll
                        for (int r = 0; r < 16; ++r) { const int kj = (r & 3) + 8 * (r >> 2) + 4 * hi;
                            { const int ix = min(max(kj - qj, -15), 15) + qj; const bool ok = (kj >= cst) && (kj < cst + 16); p0[r] = ok ? p0[r] + bt[ix] : -1e30f; }
                            { const int k2 = kj + 32; const int ix = min(max(k2 - qj, -15), 15) + qj; const bool ok = (k2 >= cst) && (k2 < cst + 16); p1[r] = ok ? p1[r] + bt[ix] : -1e30f; } }
                    } };
                auto exact1 = [&](const bool first) {
                    float mxa = __builtin_fmaxf(__builtin_fmaxf(p0[0], p0[1]), p1[0]), mxb = __builtin_fmaxf(__builtin_fmaxf(p0[2], p0[3]), p1[1]);
                    mxa = __builtin_fmaxf(__builtin_fmaxf(mxa, p1[2]), p1[3]);
#pragma unroll
                    for (int r = 4; r < 16; r += 4) { mxa = __builtin_fmaxf(__builtin_fmaxf(mxa, p0[r]), p0[r + 1]); mxb = __builtin_fmaxf(__builtin_fmaxf(mxb, p0[r + 2]), p0[r + 3]);
                        mxa = __builtin_fmaxf(__builtin_fmaxf(mxa, p1[r]), p1[r + 1]); mxb = __builtin_fmaxf(__builtin_fmaxf(mxb, p1[r + 2]), p1[r + 3]); }
                    const float dgrow = half_max(__builtin_fmaxf(mxa, mxb));
                    const float dn = first ? dgrow : __builtin_fmaxf(dgrow, 0.f);
                    const float alpha = first ? 0.f : fast_exp2(-dn);
                    ll *= alpha; oo[0] = oo[0] * alpha; oo[1] = oo[1] * alpha; ngm = ngm - dn; p0 = p0 - dn; p1 = p1 - dn; };
                auto expsum1 = [&]() -> float {
#pragma unroll
                    for (int r = 0; r < 16; ++r) { p0[r] = fast_exp2(p0[r]); p1[r] = fast_exp2(p1[r]); }
                    const f32x16 sv = p0 + p1; const f32x4 s4 = (f32x4){sv[0], sv[1], sv[2], sv[3]} + (f32x4){sv[4], sv[5], sv[6], sv[7]} + (f32x4){sv[8], sv[9], sv[10], sv[11]} + (f32x4){sv[12], sv[13], sv[14], sv[15]};
                    return (s4.x + s4.y) + (s4.z + s4.w); };
                qk1();
                if (i == 0) exact1(true);
                float ts = expsum1();
                if (__builtin_amdgcn_ballot_w64(!(ts < ATT_BIG)) != 0ull) { qk1(); exact1(false); ts = expsum1(); }
                ll += ts;
#pragma unroll
                for (int s = 0; s < 4; ++s) { u32x4 w;
                    if (s < 2) { w.x = cvt_pk_bf16(p0[8 * s + 0], p0[8 * s + 1]); w.y = cvt_pk_bf16(p0[8 * s + 2], p0[8 * s + 3]); w.z = cvt_pk_bf16(p0[8 * s + 4], p0[8 * s + 5]); w.w = cvt_pk_bf16(p0[8 * s + 6], p0[8 * s + 7]); }
                    else { const int q8 = 8 * (s - 2); w.x = cvt_pk_bf16(p1[q8 + 0], p1[q8 + 1]); w.y = cvt_pk_bf16(p1[q8 + 2], p1[q8 + 3]); w.z = cvt_pk_bf16(p1[q8 + 4], p1[q8 + 5]); w.w = cvt_pk_bf16(p1[q8 + 6], p1[q8 + 7]); }
                    pk[c][s] = __builtin_bit_cast(bf16x8, w); }
            }
            if (MODE == 1 && i + 1 < ntl) { const int nb = ((i + 1) & 1) * 8192; *(LAS u32x4*)(lds + nb + kst) = kreg; const u32x4 vv = vreg; *(LAS u32x4*)(lds + nb + vst) = vv; }
#pragma unroll
            for (int db = 0; db < 2; ++db)
#pragma unroll
                for (int s = 0; s < 4; ++s) {
                    const bf16x8 vf = *(const LAS bf16x8*)(lds + buf + vfr + 4096 * db + (((2 * s + hi) ^ rsw) << 4));
                    oA[db] = __builtin_amdgcn_mfma_f32_32x32x16_bf16(vf, pk[0][s], oA[db], 0, 0, 0);
                    if (MODE == 1) oB[db] = __builtin_amdgcn_mfma_f32_32x32x16_bf16(vf, pk[MODE == 1 ? 1 : 0][s], oB[db], 0, 0, 0);
                }
        }
        if (MODE != 1 && i + 1 < ntl) { const int nb = ((i + 1) & 1) * 8192; *(LAS u32x4*)(lds + nb + kst) = kreg; const u32x4 vv = vreg; *(LAS u32x4*)(lds + nb + vst) = vv; }
        __syncthreads();
    }
    }
    bf16_t* op = PROJ + qrow * LDP + qcol;
    auto st16 = [&](u32x2 we, u32x2 wo, const int db, const int pi) {
        unsigned a0 = we.x, a1 = we.y, b0 = wo.x, b1 = wo.y;
        plswap32u(a0, b0); plswap32u(a1, b1);
        *(u32x4*)(op + 32 * db + 8 * (2 * pi + hi)) = (u32x4){a0, a1, b0, b1}; };
    if (MODE == 1) {
        const float lam = WSF(WS_MOD)[131072 + l], lam_init = 0.8f - 0.6f * expf(-0.3f * (float)l);
        const float i0 = 1.0f / half_sum(l0), i1 = lam / half_sum(l1);
        float ss = 0.f;
#pragma unroll
        for (int db = 0; db < 2; ++db)
#pragma unroll
            for (int r = 0; r < 16; ++r) { const float v = oA[db][r] * i0 - oB[db][r] * i1; oA[db][r] = v; ss += v * v; }
        ss = half_sum(ss);
        const float rn = rsqrtf(ss * (1.0f / 64.0f) + RMS_EPS) * (1.0f - lam_init);
        const float* gn = inptr(I_DNG) + l * 64 + 4 * hi;
#pragma unroll
        for (int db = 0; db < 2; ++db)
#pragma unroll
            for (int pi = 0; pi < 2; ++pi) { u32x2 w[2];
#pragma unroll
                for (int e = 0; e < 2; ++e) { const int g4 = 2 * pi + e; const f32x4 g = *(const f32x4*)(gn + 32 * db + 8 * g4);
                    w[e].x = pk2(oA[db][4 * g4 + 0] * rn * g.x, oA[db][4 * g4 + 1] * rn * g.y); w[e].y = pk2(oA[db][4 * g4 + 2] * rn * g.z, oA[db][4 * g4 + 3] * rn * g.w); }
                st16(w[0], w[1], db, pi); }
    } else {
        const float i0 = 1.0f / half_sum(l0);
#pragma unroll
        for (int db = 0; db < 2; ++db)
#pragma unroll
            for (int pi = 0; pi < 2; ++pi) { u32x2 w[2];
#pragma unroll
                for (int e = 0; e < 2; ++e) { const int g4 = 2 * pi + e; w[e].x = pk2(oA[db][4 * g4 + 0] * i0, oA[db][4 * g4 + 1] * i0); w[e].y = pk2(oA[db][4 * g4 + 2] * i0, oA[db][4 * g4 + 3] * i0); }
                st16(w[0], w[1], db, pi); }
    }
}
template <int MODE>
__device__ __forceinline__ void attn_queue(Frame& F, int l, unsigned* qbase, int nq) {
    const int per = 4 * nq;
    volatile LAS int* slot = (volatile LAS int*)(F.lds + LDS_MISC + 64);
    const int x0 = (int)(xb_xcc_id() & 7u);
    int x = x0;
    if (F.tid == 0) slot[0] = (int)__hip_atomic_fetch_add(qbase + x * 64, 1u, RLX_AGENT);
    for (;;) {
        __syncthreads();
        const int id = slot[0];
        __syncthreads();
        if (id < per) { const int qt = id % nq, bh = (id / nq) * 8 + x;
            int nid = 0; if (F.tid == 0) nid = (int)__hip_atomic_fetch_add(qbase + x * 64, 1u, RLX_AGENT);
            attn_unit<MODE>(F, l, bh >> 2, bh & 3, qt);
            if (F.tid == 0) slot[0] = nid;
            continue; }
        if (F.tid < 8) slot[1 + F.tid] = (int)__hip_atomic_load(qbase + F.tid * 64, RLX_AGENT);
        __syncthreads();
        int nx = -1;
        for (int dx = 7; dx >= 1; --dx) { const int xx = (x0 + dx) & 7; if (slot[1 + xx] < per) nx = xx; }
        __syncthreads();
        if (nx < 0) break;
        x = nx;
        if (F.tid == 0) slot[0] = (int)__hip_atomic_fetch_add(qbase + x * 64, 1u, RLX_AGENT);
    }
}

struct TrD { const float* W; bf16_t* WT; int N, ldt, kind, item; };
__device__ __forceinline__ void tr_load(const TrD& d, int lane, float (&wv)[32]) {
    const int nblk = d.N >> 5, kb = d.item / nblk, nb = d.item % nblk, k0 = 64 * kb, n0 = 32 * nb;
#pragma unroll
    for (int i = 0; i < 32; ++i) { const int kk = 2 * i + (lane >> 5); wv[i] = __builtin_nontemporal_load(d.W + (size_t)(k0 + kk) * d.N + n0 + (lane & 31)); }
}
__device__ __forceinline__ void tr_store(const TrD& d, int lane, const float (&wv)[32], LAS float* scr) {
    const int nblk = d.N >> 5, kb = d.item / nblk, nb = d.item % nblk, k0 = 64 * kb, n0 = 32 * nb;
#pragma unroll
    for (int i = 0; i < 32; ++i) { const int kk = 2 * i + (lane >> 5); scr[kk * 33 + (lane & 31)] = wv[i]; }
    asm volatile("s_waitcnt lgkmcnt(0)" ::: "memory");
    const int c = lane & 7;
#pragma unroll
    for (int j = 0; j < 4; ++j) { const int n = (lane >> 3) + 8 * j; const LAS float* s = scr + (8 * c) * 33 + n;
        u32x4 o; o.x = pk2(s[0 * 33], s[1 * 33]); o.y = pk2(s[2 * 33], s[3 * 33]); o.z = pk2(s[4 * 33], s[5 * 33]); o.w = pk2(s[6 * 33], s[7 * 33]);
        const int nn = n0 + n, row = d.kind == 2 ? nn : 256 * (nn >> 7) + 128 * d.kind + (nn & 127);
        *(u32x4*)(d.WT + (size_t)row * d.ldt + k0 + 8 * c) = o; }
    asm volatile("s_waitcnt lgkmcnt(0)" ::: "memory");
}
__device__ __forceinline__ void convert_experts_queue(Frame& F, int l, int max_chunks = 1 << 30) {
    const float *w_eg = inptr(I_WEG), *w_eu = inptr(I_WEU), *w_ed = inptr(I_WED);
    bf16_t *GUT = WSB(WS_GUT), *DT = WSB(WS_DT);
    LAS float* scr = (LAS float*)(F.lds + F.wave * 16384);
    volatile LAS int* slot = (volatile LAS int*)(F.lds + LDS_MISC + 64);
    unsigned* qctr = WSU(WS_CTL) + CW_XQ + l * 64;
    constexpr int I_G = 16 * 16, I_D = 8 * 32, PER_E = 2 * I_G + I_D, NCH = NEXP * PER_E / 64;
    int lane_ = F.tid; asm volatile("" : "+v"(lane_)); lane_ &= 63;
    for (int done = 0; done < max_chunks; ++done) {
        if (F.tid == 0) slot[0] = (int)__hip_atomic_fetch_add(qctr, 1u, RLX_AGENT);
        __syncthreads();
        const int ch = slot[0];
        __syncthreads();
        if (ch >= NCH) break;
        auto decode = [&](const int it) -> TrD {
            const int e = it / PER_E; int r = it % PER_E; const size_t eo = ((size_t)l * NEXP + e);
            if (r < I_G) return TrD{w_eg + eo * D * DEXP, GUT + (size_t)e * 1024 * 1024, DEXP, 1024, 0, r};
            r -= I_G;
            if (r < I_G) return TrD{w_eu + eo * D * DEXP, GUT + (size_t)e * 1024 * 1024, DEXP, 1024, 1, r};
            r -= I_G;
            return TrD{w_ed + eo * DEXP * D, DT + (size_t)e * 1024 * 512, D, 512, 2, r}; };
        const int it0 = ch * 64 + F.wave * 8;
        float wa[32], wb[32];
        TrD d0 = decode(it0), d1 = d0; tr_load(d0, lane_, wa);
#pragma unroll
        for (int j = 0; j < 8; j += 2) {
            d1 = decode(it0 + j + 1); tr_load(d1, lane_, wb);
            tr_store(d0, lane_, wa, scr);
            if (j + 2 < 8) { d0 = decode(it0 + j + 2); tr_load(d0, lane_, wa); }
            tr_store(d1, lane_, wb, scr);
        }
    }
}
__device__ __forceinline__ void phase_router(Frame& F, int l) {
    const float *w_rg = inptr(I_WRG), *w_re = inptr(I_WRE), *b_rg = inptr(I_BRG), *b_re = inptr(I_BRE), *g_ffn = inptr(I_GFFN);
    bf16_t *H = WSB(WS_H); float *XCTX = WSF(WS_XCTX), *MOD = WSF(WS_MOD); unsigned *ROUTE = WSU(WS_ROUTE), *ctl = WSU(WS_CTL);
    __syncthreads();
    LAS float* wt = (LAS float*)F.lds;
    LAS int* lcnt = (LAS int*)(F.lds + 147456);
    LAS unsigned* rinfo = (LAS unsigned*)(F.lds + 147456 + 256);
    { f32x4 tv[16];
#pragma unroll
      for (int i = 0; i < 16; ++i) { const int c = F.tid + 512 * i, k = c >> 3, o4 = c & 7; tv[i] = *(const f32x4*)(w_re + ((size_t)l * D + k) * 32 + o4 * 4); }
#pragma unroll
      for (int i = 0; i < 16; ++i) { const int c = F.tid + 512 * i, k = c >> 3, o4 = c & 7, rk = ((k & 255) >> 2) + 64 * (4 * (k >> 8) + (k & 3)); *(LAS f32x4*)(wt + rk * 36 + 4 + o4 * 4) = tv[i]; } }
#pragma unroll
    for (int k = F.tid; k < 1024; k += 512) { const int rk = ((k & 255) >> 2) + 64 * (4 * (k >> 8) + (k & 3)); *(LAS f32x4*)(wt + rk * 36) = *(const f32x4*)(w_rg + ((size_t)l * D + k) * 4); }
    if (F.tid < 64) lcnt[F.tid] = 0;
    __syncthreads();
    const int row_base = F.vcu * 136;
    const float* gf = g_ffn + l * D;
    LAS float* bias = (LAS float*)(F.lds + 150976 + 8 * 256);
    if (F.tid < 4) bias[F.tid] = b_rg[l * 4 + F.tid]; else if (F.tid < 36) bias[F.tid] = b_re[l * 32 + F.tid - 4];
    __syncthreads();
    const float* xs_lat = l == 0 ? inptr(I_X) : (const float*)F.out; const float* xs_ctx = l == 0 ? inptr(I_CTX) : (const float*)XCTX;
    const bf16_t* Y2 = WSB(WS_PROJ);
    auto xrow = [&](int rpq) -> const float* { const int row = row_base + (rpq < 17 ? F.wave + 8 * rpq : 0); const int b = row / TPB, t = row % TPB;
        return t >= SEQ ? xs_ctx + ((size_t)b * CTXL + (t - SEQ)) * D : xs_lat + ((size_t)b * SEQ + t) * D; };
    auto yrow = [&](int rpq) -> const u32x2* { const int row = row_base + (rpq < 17 ? F.wave + 8 * rpq : 0); return (const u32x2*)(Y2 + (size_t)row * D); };
    f32x4 xc[2][4], xn[2][4]; u32x2 yc[2][4], yn[2][4];
#pragma unroll
    for (int q = 0; q < 2; ++q) { const f32x4* xp = (const f32x4*)xrow(q) + F.lane; const u32x2* yp = yrow(q) + F.lane;
#pragma unroll
        for (int j = 0; j < 4; ++j) { xc[q][j] = xp[64 * j]; yc[q][j] = l == 0 ? yp[64 * j] : (u32x2){0u, 0u}; } }
    for (int rp = 0; rp < 17; rp += 2) {
        bool ok[2]; int rls[2]; const float* shp[2]; float rr[2];
#pragma unroll
        for (int q = 0; q < 2; ++q) {
            const int rl = F.wave + 8 * (rp + q); rls[q] = rl; ok[q] = (rp + q) < 17;
            const int row = row_base + (ok[q] ? rl : 0); const int b = row / TPB, t = row % TPB; const bool isctx = t >= SEQ;
            if (ok[q] && isctx && l == 1) { if (F.lane == 0) rinfo[rl * 6] = 0xffffffffu; ok[q] = false; }
            const int mb = isctx ? 8 : b;
            shp[q] = MOD + ((size_t)l * 9 + mb) * 6144 + 3 * 1024;
            float* xd = isctx ? XCTX + ((size_t)b * CTXL + (t - SEQ)) * D : F.out + ((size_t)b * SEQ + t) * D;
#pragma unroll
            for (int j = 0; j < (l == 0 ? 4 : 0); ++j) { const u32x2 y = yc[q][j]; const f32x4 x1 = xc[q][j] + (f32x4){bflo(y.x), bfhi(y.x), bflo(y.y), bfhi(y.y)}; xc[q][j] = x1;
                if (ok[q]) ((f32x4*)xd)[F.lane + 64 * j] = x1; }
        }
#pragma unroll
        for (int q = 0; q < 2; ++q) { float ss = 0.f;
#pragma unroll
            for (int j = 0; j < 4; ++j) { const f32x4 x4 = xc[q][j]; ss += (x4.x * x4.x + x4.y * x4.y) + (x4.z * x4.z + x4.w * x4.w); }
            rr[q] = rsqrtf(wave_sum(ss) * (1.0f / D) + RMS_EPS); }
        float hv[2][16];
#pragma unroll
        for (int j = 0; j < 4; ++j) {
            const f32x4 g4 = ((const f32x4*)gf)[F.lane + 64 * j];
#pragma unroll
            for (int q = 0; q < 2; ++q) { const f32x4 x4 = xc[q][j], s4 = ((const f32x4*)shp[q])[F.lane + 64 * j], c4 = ((const f32x4*)(shp[q] + 1024))[F.lane + 64 * j];
                const f32x4 h = (x4 * rr[q] * g4) * (c4 + 1.0f) + s4;
                hv[q][4 * j + 0] = h.x; hv[q][4 * j + 1] = h.y; hv[q][4 * j + 2] = h.z; hv[q][4 * j + 3] = h.w;
                if (ok[q]) { u32x2 w; w.x = pk2(h.x, h.y); w.y = pk2(h.z, h.w); ((u32x2*)(H + (size_t)(row_base + rls[q]) * D))[F.lane + 64 * j] = w; } }
        }
#pragma unroll
        for (int q = 0; q < 2; ++q) { const f32x4* xp = (const f32x4*)xrow(min(rp + 2 + q, 17)) + F.lane; const u32x2* yp = yrow(min(rp + 2 + q, 17)) + F.lane;
#pragma unroll
            for (int j = 0; j < 4; ++j) { xn[q][j] = xp[64 * j]; yn[q][j] = l == 0 ? yp[64 * j] : (u32x2){0u, 0u}; } }
        float ag[2][4];
#pragma unroll
        for (int q = 0; q < 2; ++q)
#pragma unroll
            for (int o = 0; o < 4; ++o) ag[q][o] = 0.f;
#pragma unroll
        for (int je = 0; je < 16; ++je) { const f32x4 w = *(const LAS f32x4*)(wt + (F.lane + 64 * je) * 36);
#pragma unroll
            for (int q = 0; q < 2; ++q) { ag[q][0] += hv[q][je] * w.x; ag[q][1] += hv[q][je] * w.y; ag[q][2] += hv[q][je] * w.z; ag[q][3] += hv[q][je] * w.w; } }
        int grp[2]; float wgrp[2];
#pragma unroll
        for (int q = 0; q < 2; ++q) {
#pragma unroll
            for (int o = 0; o < 4; ++o) ag[q][o] = wave_sum(ag[q][o]) + bias[o];
            int g0 = 0; float gm = ag[q][0];
#pragma unroll
            for (int g = 1; g < 4; ++g) if (ag[q][g] > gm) { gm = ag[q][g]; g0 = g; }
            float gs = 0.f;
#pragma unroll
            for (int g = 0; g < 4; ++g) gs += __expf(ag[q][g] - gm);
            grp[q] = __builtin_amdgcn_readfirstlane(g0); wgrp[q] = 1.0f / gs;
        }
        float ae[2][8];
#pragma unroll
        for (int q = 0; q < 2; ++q)
#pragma unroll
            for (int o = 0; o < 8; ++o) ae[q][o] = 0.f;
#pragma unroll
        for (int je = 0; je < 16; ++je) {
#pragma unroll
            for (int q = 0; q < 2; ++q) { const LAS f32x4* wp = (const LAS f32x4*)(wt + (F.lane + 64 * je) * 36 + 4 + 8 * grp[q]); const f32x4 w0 = wp[0], w1 = wp[1];
                ae[q][0] += hv[q][je] * w0.x; ae[q][1] += hv[q][je] * w0.y; ae[q][2] += hv[q][je] * w0.z; ae[q][3] += hv[q][je] * w0.w;
                ae[q][4] += hv[q][je] * w1.x; ae[q][5] += hv[q][je] * w1.y; ae[q][6] += hv[q][je] * w1.z; ae[q][7] += hv[q][je] * w1.w; } }
#pragma unroll
        for (int q = 0; q < 2; ++q) {
#pragma unroll
            for (int o = 0; o < 8; ++o) ae[q][o] = wave_sum(ae[q][o]) + bias[4 + 8 * grp[q] + o];
            int i1 = 0; float v1 = ae[q][0];
#pragma unroll
            for (int j = 1; j < 8; ++j) if (ae[q][j] > v1) { v1 = ae[q][j]; i1 = j; }
            int i2 = -1; float v2 = -3.0e38f;
#pragma unroll
            for (int j = 0; j < 8; ++j) if (j != i1 && ae[q][j] > v2) { v2 = ae[q][j]; i2 = j; }
            const float e2 = __expf(v2 - v1), w1 = wgrp[q] / (1.0f + e2), w2 = wgrp[q] * e2 / (1.0f + e2);
            if (ok[q] && F.lane == 0) {
                const int rl = rls[q];
                const int ea = grp[q] * 8 + i1, eb = grp[q] * 8 + i2;
                const int sa = __hip_atomic_fetch_add(lcnt + ea, 1, __ATOMIC_RELAXED, __HIP_MEMORY_SCOPE_WORKGROUP);
                const int sb = __hip_atomic_fetch_add(lcnt + eb, 1, __ATOMIC_RELAXED, __HIP_MEMORY_SCOPE_WORKGROUP);
                rinfo[rl * 6 + 0] = (unsigned)ea; rinfo[rl * 6 + 1] = (unsigned)eb; rinfo[rl * 6 + 2] = (unsigned)sa; rinfo[rl * 6 + 3] = (unsigned)sb;
                rinfo[rl * 6 + 4] = __builtin_bit_cast(unsigned, w1); rinfo[rl * 6 + 5] = __builtin_bit_cast(unsigned, w2);
            }
        }
#pragma unroll
        for (int q = 0; q < 2; ++q)
#pragma unroll
            for (int j = 0; j < 4; ++j) { xc[q][j] = xn[q][j]; yc[q][j] = yn[q][j]; }
    }
    __syncthreads();
    if (F.tid < 32) lcnt[32 + F.tid] = (int)__hip_atomic_fetch_add(ctl + CW_CNT + l * 32 + F.tid, (unsigned)lcnt[F.tid], RLX_AGENT);
    __syncthreads();
    if (F.tid < 136) { const int rl = F.tid; const unsigned ea = rinfo[rl * 6];
        if (ea != 0xffffffffu) { const unsigned eb = rinfo[rl * 6 + 1]; unsigned* ro = ROUTE + (size_t)(row_base + rl) * 8;
            ro[0] = ea; ro[1] = eb; ro[2] = rinfo[rl * 6 + 2] + (unsigned)lcnt[32 + ea]; ro[3] = rinfo[rl * 6 + 3] + (unsigned)lcnt[32 + eb]; ro[4] = rinfo[rl * 6 + 4]; ro[5] = rinfo[rl * 6 + 5]; } }
    __syncthreads();
}
__device__ __forceinline__ int build_tiles(Frame& F, int l) {
    LAS int* offs = (LAS int*)(F.lds + LDS_MISC + 128);
    LAS int* cnts = (LAS int*)(F.lds + LDS_MISC + 320);
    LAS int* tile_e = (LAS int*)(F.lds + LDS_TILE_E);
    __syncthreads();
    if (F.tid < NEXP) cnts[F.tid] = (int)__hip_atomic_load(WSU(WS_CTL) + CW_CNT + l * 32 + F.tid, RLX_AGENT);
    __syncthreads();
    LAS int* tst = (LAS int*)(F.lds + LDS_MISC + 2048);
    if (F.tid < 33) { int ts = 0; for (int e = 0; e < F.tid; ++e) ts += (cnts[e] + 255) >> 8;
        tst[F.tid] = ts; if (F.tid < 32) offs[F.tid] = ts << 8; else offs[32] = min(ts, MPAD / 256); }
    __syncthreads();
    if (F.tid < MPAD / 256 && F.tid < tst[32]) { int e = 0;
#pragma unroll 8
        for (int q = 1; q < 32; ++q) e += (tst[q] <= F.tid) ? 1 : 0;
        tile_e[F.tid] = e; }
    __syncthreads();
    return __builtin_amdgcn_readfirstlane(offs[32]);
}
constexpr size_t WS_ROWMAP = WS_ROWW + 512 * 1024;
__device__ __forceinline__ void phase_scatter(Frame& F, int l) {
    (void)build_tiles(F, l);
    const LAS int* offs = (const LAS int*)(F.lds + LDS_MISC + 128);
    const LAS int* cnts = (const LAS int*)(F.lds + LDS_MISC + 320);
    const int gw = F.vcu * 8 + F.wave, NGW = F.G * 8;
    unsigned* ROUTE = WSU(WS_ROUTE); float* ROWW = WSF(WS_ROWW); int* ROWMAP = (int*)(F.ws + WS_ROWMAP);
    for (int r0 = gw * 64 + F.lane; r0 < T; r0 += NGW * 64) {
        const int row = r0;
        if (l == 1 && (row % TPB) >= SEQ) continue;
        unsigned* ro = ROUTE + (size_t)row * 8;
        const u32x4 r4 = *(const u32x4*)ro;
        const unsigned pa = (unsigned)offs[r4.x] + r4.z, pb = (unsigned)offs[r4.y] + r4.w;
        if (pa < (unsigned)MPAD && pb < (unsigned)MPAD) {
            ROWW[pa] = __builtin_bit_cast(float, ro[4]); ROWW[pb] = __builtin_bit_cast(float, ro[5]); ro[6] = pa; ro[7] = pb; ROWMAP[pa] = row; ROWMAP[pb] = row; }
    }
    if (F.vcu < NEXP) { const int e = F.vcu, c = cnts[e], o = offs[e], end = o + (((c + 255) >> 8) << 8);
        for (int p = o + c + F.tid; p < end && p < MPAD; p += 512) { ROWMAP[p] = 0; ROWW[p] = 0.f; } }
}

#define IN(k) (lo <= (k) && (k) < hi)
#define SEAM(k) do { if (IN(k) && IN((k) + 1)) { XcdBarrier b2 = bar; asm volatile("" : "+s"(b2.bar)); xcd_barrier(b2); } } while (0)
#if MK_STAMP
#define STAMP(k) do { if (blockIdx.x == 0 && threadIdx.x == 0) ((unsigned long long*)(F0.ws + 262144))[k] = __builtin_amdgcn_s_memrealtime(); } while (0)
#else
#define STAMP(k) do { } while (0)
#endif
template <int l>
__device__ __forceinline__ void run_layer(const Frame& F0, const XcdBarrier& bar, int lo, int hi) {
    constexpr int P = 1 + 11 * l;
        STAMP(P + 0);
        STAMP(P + 1);
    if (IN(P + 1)) { Frame F = launder(F0); if (l == 0) p0_prologue(F, 1); phase_modulate(F, l, 0); } SEAM(P + 1);
        STAMP(P + 2);
    if (IN(P + 2)) { Frame F = launder(F0);
            pg8::Gemm g{LDP * 2, D * 2}; SchedIn S{F.G, F.bx, (const char*)(WSB(WS_PROJ) + C_H), (const char*)(WSB(WS_WIN) + (size_t)l * NIN * D)}; EpiIn E{WSB(WS_PROJ)};
            pg8::gemm_phase<EpiIn, SchedIn, true>(F.lds, g, S, E);
        } SEAM(P + 2);
        STAMP(P + 3);
    if (IN(P + 3)) { Frame F = launder(F0); phase_post(F, l); } SEAM(P + 3);
        STAMP(P + 4);
    if (IN(P + 4)) { Frame F = launder(F0);
            const int nq = l == 0 ? 17 : 16;
            const int cslot = (l == 1) ? (F.vcu & 3) : -1;
            if (cslot == 0) convert_experts_queue(F, l, 2);
            attn_queue<1>(F, l, WSU(WS_CTL) + CW_Q + ((l * 4 + 0) * 8) * 64, nq);
            if (cslot == 1) convert_experts_queue(F, l, 2);
            attn_queue<0>(F, l, WSU(WS_CTL) + CW_Q + ((l * 4 + 1) * 8) * 64, nq);
            if (cslot == 2) convert_experts_queue(F, l, 2);
            attn_queue<2>(F, l, WSU(WS_CTL) + CW_Q + ((l * 4 + 2) * 8) * 64, nq);
            if (cslot == 3) convert_experts_queue(F, l, 2);
        } SEAM(P + 4);
        STAMP(P + 5);
    if (IN(P + 5)) { Frame F = launder(F0);
            pg8::Gemm g{LDP * 2, D * 2}; SchedMerge S{F.G, F.bx, 128, 1, l == 0 ? 1 : 0, (const char*)WSB(WS_PROJ), (const char*)(WSB(WS_WIN) + ((size_t)l * NIN + 2304) * D), (const char*)(WSB(WS_WBR) + (size_t)l * 4 * D * D)};
            EpiMerge E{{}, WSB(WS_H), WSB(WS_VT) + (size_t)F.bx * 65536, WSB(WS_SLAB)};
            pg8::gemm_phase<EpiMerge, SchedMerge, true>(F.lds, g, S, E);
            convert_experts_queue(F, l);
        } SEAM(P + 5);
        STAMP(P + 6);
    if (IN(P + 6)) { Frame F = launder(F0);
            pg8::Gemm g{D * 2, D * 2}; SchedOut S{F.G, F.bx, l == 0 ? 136 : 128, l, (const char*)WSB(WS_H), (const char*)(WSB(WS_WOUT) + (size_t)l * D * D), l == 0 ? (const char*)WSB(WS_PRIV) : nullptr};
            if (l == 0) sum_ctx_slabs(F, S);
            EpiOut E{WSB(WS_PROJ), F.out, WSF(WS_MOD) + (size_t)l * 9 * 6144, l == 0};
            pg8::gemm_phase<EpiOut, SchedOut, true>(F.lds, g, S, E);
        } SEAM(P + 6);
        STAMP(P + 7);
    if (IN(P + 7)) { Frame F = launder(F0); phase_router(F, l); } SEAM(P + 7);
        STAMP(P + 8);
    if (IN(P + 8)) { Frame F = launder(F0); phase_scatter(F, l); } SEAM(P + 8);
        STAMP(P + 9);
    if (IN(P + 9)) { Frame F = launder(F0);
            const int ntiles = build_tiles(F, l);
            LAS int* rmt = (LAS int*)(F.lds + 131072);
            { const int* ROWMAP = (const int*)(F.ws + WS_ROWMAP);
              for (int i = 0; i < 8; ++i) { const int L = i * F.G + F.vcu; if (L < ntiles * 4 && F.tid < 256) rmt[i * 256 + F.tid] = ROWMAP[(size_t)(L >> 2) * 256 + F.tid]; }
              __syncthreads(); }
            pg8::Gemm g{D * 2, D * 2}; SchedMoe<1024> S{F.G, F.vcu, ntiles, (const LAS int*)(F.lds + LDS_TILE_E), (const char*)WSB(WS_H), (const char*)WSB(WS_GUT)}; EpiGU E{WSB(WS_HMID)};
            pg8::gemm_phase<EpiGU, SchedMoe<1024>, true, true>(F.lds, g, S, E, (const char*)WSB(WS_H), rmt);
        } SEAM(P + 9);
        STAMP(P + 10);
    if (IN(P + 10)) { Frame F = launder(F0);
            const int ntiles = build_tiles(F, l);
            pg8::Gemm g{DEXP * 2, DEXP * 2}; SchedMoe<512> S{F.G, F.vcu, ntiles, (const LAS int*)(F.lds + LDS_TILE_E), (const char*)WSB(WS_HMID), (const char*)WSB(WS_DT)}; EpiDown E{WSB(WS_Y), WSF(WS_ROWW)};
            pg8::gemm_phase<EpiDown, SchedMoe<512>, true>(F.lds, g, S, E);
        } SEAM(P + 10);
    }
constexpr int N_PHASES = 24;
__global__ void __launch_bounds__(512, 2) fwd_kernel(Args args) {
    extern __shared__ __attribute__((aligned(16))) unsigned char lds_raw[];
    Frame F0;
    F0.lds = (LAS unsigned char*)lds_raw;
    F0.tid = threadIdx.x; F0.lane = F0.tid & 63; F0.wave = __builtin_amdgcn_readfirstlane(F0.tid >> 6);
    F0.G = gridDim.x; F0.bx = blockIdx.x; { const int bx = blockIdx.x; F0.vcu = (F0.G % 8 == 0) ? (bx % 8) * (F0.G / 8) + bx / 8 : bx; }
    F0.ws = args.ws; F0.out = args.out;
    for (int u = F0.tid; u < (LDS_BYTES - LDS_MISC) / 4; u += 512) ((LAS unsigned*)(F0.lds + LDS_MISC))[u] = 0u;
    __syncthreads();
    const int lo = args.ph_lo, hi = args.ph_hi;
    XcdBarrier bar; bar.bar = ((unsigned*)(F0.ws + WS_CTL)) + CW_BAR; bar.x = 0; bar.st = nullptr;
    if (hi - lo > 1) bar = xcd_barrier_post(((unsigned*)(F0.ws + WS_CTL)) + CW_BAR, (volatile LAS unsigned*)(F0.lds + LDS_MISC + 32));

    STAMP(0);
    if (IN(0)) { Frame F = launder(F0); p0_prologue(F, 0); } SEAM(0);
    run_layer<0>(F0, bar, lo, hi);
    run_layer<1>(F0, bar, lo, hi);
    STAMP(23);
    if (IN(23)) { Frame F = launder(F0); phase_modulate(F, 2, 0); }
    STAMP(24);
#if MK_STAMP
    if (blockIdx.x == 0 && threadIdx.x == 0) {
        const unsigned long long* ts = (const unsigned long long*)(F0.ws + 262144);
        const unsigned long long wait = 4ull * (ts[MK_STAMP_A % 100] - ts[MK_STAMP_A / 100]), t0 = __builtin_amdgcn_s_memrealtime();
        while (__builtin_amdgcn_s_memrealtime() - t0 < wait) __builtin_amdgcn_s_sleep(32);
    }
#endif
#undef IN
#undef SEAM
}


#if MK_CHECK
constexpr size_t WS_CHK = 512 * 1024;
constexpr size_t WS_CHKBUF = WS_END;
__device__ __forceinline__ unsigned hsh(unsigned x) { x ^= x >> 16; x *= 0x7feb352du; x ^= x >> 15; x *= 0x846ca68bu; x ^= x >> 16; return x; }
__device__ __forceinline__ void chk_put(unsigned* CHK, int id, float err) { if (!(err >= 0.f)) err = 1e30f; atomicMax(CHK + id, __builtin_bit_cast(unsigned, err)); }
__device__ __forceinline__ float ref_rope_elem(const float* v, int nd, int idx, int t) {
    if (idx >= nd) return 0.f;
    const int h = nd / 2, half = h / 2; const int sec = idx / h, ii = idx % h; const float pos = sec == 0 ? (float)(t / 64) : (float)(t % 64);
    const int i = ii % half; const float inv = powf(10000.0f, -(float)i / (float)half); const float ang = pos * inv, cs = cosf(ang), sn = sinf(ang);
    const float x1 = v[sec * h + i], x2 = v[sec * h + half + i];
    return ii < half ? x1 * cs - x2 * sn : x1 * sn + x2 * cs;
}
__global__ void chk_kernel(Args args, int which, int l) {
    unsigned char* ws = args.ws; unsigned* CHK = (unsigned*)(ws + WS_CHK);
    const float* const* in = args.in;
    const bf16_t* H = (const bf16_t*)(ws + WS_H); const bf16_t* PROJ = (const bf16_t*)(ws + WS_PROJ); const bf16_t* VT = (const bf16_t*)(ws + WS_VT);
    const float* MOD = (const float*)(ws + WS_MOD); const float* XCTX = (const float*)(ws + WS_XCTX); const unsigned* ROUTE = (const unsigned*)(ws + WS_ROUTE); const float* ROWW = (const float*)(ws + WS_ROWW);
    float* CB = (float*)(ws + WS_CHKBUF);
    const int s = blockIdx.x, tid = threadIdx.x; const unsigned h1 = hsh(s * 2654435761u + 12345u + (which == 5 ? 4 : which) * 977u), h2 = hsh(h1 + 0x9e3779b9u), h3 = hsh(h2 + 77u);
    const int id = l * 16 + which;
    __shared__ float sh[4608]; __shared__ float red[64];
    if (which == 0) {
        if (tid != 0) return; const int ll = s & 1, bb = (s >> 1) % 9, j = h1 % 6144; float acc = 0.f;
        for (int k = 0; k < 1024; ++k) { const float v = bb < 8 ? in[I_C][bb * 1024 + k] : in[I_CCTX][k]; acc += v / (1.f + expf(-v)) * in[I_WMOD][((size_t)ll * 1024 + k) * 6144 + j]; }
        acc += in[I_BMOD][ll * 6144 + j]; chk_put(CHK, id, fabsf(acc - MOD[((size_t)ll * 9 + bb) * 6144 + j]));
    } else if (which == 1) {
        if (tid != 0) return; const int row = h1 % T, col = h2 % 1024, b = row / TPB, t = row % TPB; const bool ic = t >= SEQ;
        const float* x = ic ? in[I_CTX] + ((size_t)b * CTXL + t - SEQ) * D : in[I_X] + ((size_t)b * SEQ + t) * D; float ss = 0.f;
        for (int k = 0; k < 1024; ++k) ss += x[k] * x[k];
        const float r = 1.0f / sqrtf(ss / 1024.f + 1e-6f); const float* m = MOD + (size_t)(ic ? 8 : b) * 6144;
        const float e = x[col] * r * in[I_GMIX][col] * (1.f + m[1024 + col]) + m[col]; chk_put(CHK, id, fabsf(e - bf2f(PROJ[(size_t)row * LDP + C_H + col])));
    } else if (which == 2) {
        if (tid != 0) return; const int row = h1 % T, col = h2 % 2304; float acc = 0.f;
        for (int k = 0; k < 1024; ++k) acc += bf2f(PROJ[(size_t)row * LDP + C_H + k]) * in[I_WIN][((size_t)l * 1024 + k) * NIN + col];
        chk_put(CHK, id, fabsf(acc - bf2f(PROJ[(size_t)row * LDP + col])));
    } else if (which == 3) {
        const int kind = s % 7, row = h1 % T, b = row / TPB, t = row % TPB; const bool ic = t >= SEQ;
        int c0 = 0, nd = 64; const int hh = h2 & 3;
        if (kind == 0) { c0 = C_DQ + 32 * (h2 & 7); nd = 32; } else if (kind == 1) { c0 = C_DK + 32 * (h2 & 7); nd = 32; } else if (kind == 2) c0 = C_GQ + 64 * hh; else if (kind == 3) c0 = C_GK + 64 * (hh & 1);
        else if (kind == 4) c0 = C_NQ + 64 * hh; else if (kind == 5) c0 = 64 * hh; else c0 = (h3 % 10 < 4 ? C_DV + 64 * (h3 % 10) : (h3 % 10 < 8 ? C_NV + 64 * (h3 % 10 - 4) : C_GV + 64 * (h3 % 10 - 8)));
        if (kind == 5) {
            const int ch = c0 + tid, win = 2 << (ch / 64), n = ic ? CTXL : SEQ, ts = ic ? t - SEQ : t, lo = max(ts - win / 2, 0), hi = min(ts + win / 2, n); float sum = 0.f, self = 0.f;
            for (int i = lo; i < hi; ++i) { const size_t r2 = (size_t)(row - ts + i); float acc = 0.f; for (int k = 0; k < 1024; ++k) acc += bf2f(PROJ[r2 * LDP + C_H + k]) * in[I_WIN][((size_t)l * 1024 + k) * NIN + ch]; sum += acc; if (i == ts) self = acc; }
            chk_put(CHK, id, fabsf(sum / (float)(hi - lo) - self - bf2f(PROJ[(size_t)row * LDP + C_POOL + ch]))); return; }
        float acc = 0.f; if (tid < nd) for (int k = 0; k < 1024; ++k) acc += bf2f(PROJ[(size_t)row * LDP + C_H + k]) * in[I_WIN][((size_t)l * 1024 + k) * NIN + c0 + tid];
        sh[tid] = acc; __syncthreads();
        if (kind == 6) { const int vh = h3 % 10; chk_put(CHK, id, fabsf(acc - bf2f(VT[(((size_t)b * 10 + vh) * 64 + tid) * TPB + t]))); return; }
        float* v = sh + 64;
        if (kind == 2 || kind == 3) { float ss = 0.f; for (int i = 0; i < 64; ++i) ss += sh[i] * sh[i]; const float r = 1.f / sqrtf(ss / 64.f + 1e-6f); const float* g = (kind == 2 ? in[I_QN] : in[I_KN]) + l * 64; v[tid] = sh[tid] * r * g[tid]; }
        else v[tid] = sh[tid];
        __syncthreads();
        float e = v[tid]; if (!ic && kind <= 3) e = ref_rope_elem(v, nd, tid, t);
        if (kind == 0) e *= 0.17677669529663687f * LOG2E; if (kind == 2 || kind == 4) e *= 0.125f * LOG2E;
        if (tid < nd) chk_put(CHK, id, fabsf(e - bf2f(PROJ[(size_t)row * LDP + c0 + tid])));
    } else if (which == 4 || which == 5) {
        const int mode = s % 3, nq = l == 0 ? 17 : 16, b = h1 % NB, h = h2 & 3, qt = h3 % nq, q = qt * 256 + (hsh(h3) & 255); const size_t rowb = (size_t)b * TPB;
        const int qcol = mode == 0 ? C_GQ + 64 * h : (mode == 1 ? C_DQ + 64 * h : C_NQ + 64 * h), kcol = mode == 0 ? C_GK + 64 * (h >> 1) : (mode == 1 ? C_DK + 64 * h : C_NK + 64 * h), vcol = mode == 0 ? C_GV + 64 * (h >> 1) : (mode == 1 ? C_DV + 64 * h : C_NV + 64 * h);
        if (which == 5) { const float er = fabsf(CB[s * 64 + tid] - bf2f(PROJ[(rowb + q) * LDP + qcol + tid])); chk_put(CHK, l * 16 + (mode == 0 ? 5 : 11 + mode), er);
            if (l == 0 && mode == MK_CHK_MODE) { const float ex = CB[s * 64 + tid], gt = bf2f(PROJ[(rowb + q) * LDP + qcol + tid]);
                atomicAdd((float*)(CHK + 60), ex * gt); atomicAdd((float*)(CHK + 61), ex * ex); atomicAdd((float*)(CHK + 62), gt * gt); } return; }
        const bool ic = q >= SEQ; const int k_lo = ic ? SEQ : 0, k_hi = TPB;
        float outv = 0.f, out2 = 0.f;
        for (int map = 0; map < (mode == 1 ? 2 : 1); ++map) {
            float mx = -3e38f;
            for (int k = k_lo + tid; k < k_hi; k += 64) { float sc = 0.f; const int d0 = mode == 1 ? 32 * map : 0, dn = mode == 1 ? 32 : 64;
                for (int d = 0; d < dn; ++d) sc += bf2f(PROJ[(rowb + q) * LDP + qcol + d0 + d]) * bf2f(PROJ[(rowb + k) * LDP + kcol + d0 + d]);
                if (mode == 2 && !ic) { if (k < SEQ) { const int r = q / 64, j = q % 64, kr = k / 64, kj = k % 64, ws_ = min(max(r - 4, 0), 56), cs = min(max(j - 8, 0), 48);
                        if (kr >= ws_ && kr < ws_ + 8 && kj >= cs && kj < cs + 16) sc += in[I_RPB][(((size_t)l * 4 + h) * 15 + (kr - r + 7)) * 31 + min(max(kj - j, -15), 15) + 15] * LOG2E; else sc = -1e30f; } }
                sh[k] = sc; mx = fmaxf(mx, sc); }
            red[tid] = mx; __syncthreads(); mx = -3e38f; for (int i = 0; i < 64; ++i) mx = fmaxf(mx, red[i]); __syncthreads();
            float sum = 0.f, o = 0.f;
            for (int k = k_lo; k < k_hi; ++k) { const float p = exp2f(sh[k] - mx); sum += p; o += p * bf2f(PROJ[(rowb + k) * LDP + vcol + tid]); }
            __syncthreads();
            if (map == 0) outv = o / sum; else out2 = o / sum;
        }
        if (mode == 1) { const float lam = MOD[131072 + l], li = 0.8f - 0.6f * expf(-0.3f * (float)l); const float v = outv - lam * out2; red[tid] = v * v; __syncthreads(); float ss = 0.f; for (int i = 0; i < 64; ++i) ss += red[i];
            outv = v / sqrtf(ss / 64.f + 1e-6f) * in[I_DNG][l * 64 + tid] * (1.f - li); }
        CB[s * 64 + tid] = outv;
    } else if (which == 12) {
        const unsigned hh = hsh(h1 + tid * 7919u); const int b = hh % NB, vh = (hh >> 4) % 10, d = (hh >> 8) & 63; int key = (hh >> 14) % TPB; if (tid & 1) key = SEQ + (key & 255);
        const int vcol = vh < 4 ? C_DV + 64 * vh : (vh < 8 ? C_NV + 64 * (vh - 4) : C_GV + 64 * (vh - 8));
        if (VT[(((size_t)b * 10 + vh) * 64 + d) * TPB + key] != PROJ[((size_t)b * TPB + key) * LDP + vcol + d]) { atomicAdd(CHK + 58, 1u); atomicOr(CHK + 59, (1u << vh) | (key >= SEQ ? 1024u : 2048u)); }
    } else if (which == 6) {
        if (tid != 0) return; const int nM = l == 0 ? T : NB * SEQ; int row = h1 % nM; if (l == 1) row = (row / SEQ) * TPB + row % SEQ; const int n = h2 % 1024; float tot = 0.f;
        for (int br = 0; br < 4; ++br) { float acc = 0.f;
            if (br == 0) { for (int g = 0; g < 4; ++g) for (int dp = 0; dp < 64; ++dp) { float y = 0.f; for (int c = 0; c < 64; ++c) y += bf2f(PROJ[(size_t)row * LDP + C_POOL + 64 * g + c]) * in[I_POOLW][(((size_t)l * 4 + g) * 64 + c) * 64 + dp];
                    acc += y * in[I_POOLS][l * 256 + 64 * g + dp] * in[I_WBR][(((size_t)l * 4 + 0) * 256 + 64 * g + dp) * D + n]; } }
            else { const int c0 = branch_col(br); for (int k = 0; k < 256; ++k) acc += bf2f(PROJ[(size_t)row * LDP + c0 + k]) * in[I_WBR][(((size_t)l * 4 + br) * 256 + k) * D + n]; }
            float gl = 0.f; for (int k = 0; k < 1024; ++k) gl += bf2f(PROJ[(size_t)row * LDP + C_H + k]) * in[I_WIN][((size_t)l * 1024 + k) * NIN + 2304 + br * 1024 + n];
            tot += acc / (1.f + expf(-gl)); }
        chk_put(CHK, id, fabsf(tot - bf2f(H[(size_t)row * D + n])));
    } else if (which == 7) {
        if (tid != 0 || l != 0) return; const int row = h1 % T, n = h2 % 1024, b = row / TPB, t = row % TPB; const bool ic = t >= SEQ; float acc = 0.f;
        for (int k = 0; k < 1024; ++k) acc += bf2f(H[(size_t)row * D + k]) * in[I_WOUT][((size_t)l * 1024 + k) * D + n];
        const size_t xo = ic ? ((size_t)b * CTXL + t - SEQ) * D + n : ((size_t)b * SEQ + t) * D + n;
        const float e = (ic ? in[I_CTX] : in[I_X])[xo] + MOD[((size_t)l * 9 + (ic ? 8 : b)) * 6144 + 2048 + n] * acc; chk_put(CHK, id, fabsf(e - (ic ? XCTX : args.out)[xo]));
    } else if (which == 8) {
        if (tid != 0) return; int row = h1 % T; if (l == 1) { row = h1 % (NB * SEQ); row = (row / SEQ) * TPB + row % SEQ; } const int b = row / TPB, t = row % TPB; const bool ic = t >= SEQ;
        const float* x = ic ? XCTX + ((size_t)b * CTXL + t - SEQ) * D : args.out + ((size_t)b * SEQ + t) * D; float ss = 0.f; for (int k = 0; k < 1024; ++k) ss += x[k] * x[k];
        const float r = 1.f / sqrtf(ss / 1024.f + 1e-6f); const float* m = MOD + ((size_t)l * 9 + (ic ? 8 : b)) * 6144; float* lg = red; for (int o = 0; o < 36; ++o) lg[o] = 0.f; float herr = 0.f;
        for (int k = 0; k < 1024; ++k) { const float hv = x[k] * r * in[I_GFFN][l * 1024 + k] * (1.f + m[4096 + k]) + m[3072 + k]; herr = fmaxf(herr, fabsf(hv - bf2f(H[(size_t)row * D + k])));
            for (int o = 0; o < 4; ++o) lg[o] += hv * in[I_WRG][((size_t)l * 1024 + k) * 4 + o]; for (int o = 0; o < 32; ++o) lg[4 + o] += hv * in[I_WRE][((size_t)l * 1024 + k) * 32 + o]; }
        for (int o = 0; o < 4; ++o) lg[o] += in[I_BRG][l * 4 + o]; for (int o = 0; o < 32; ++o) lg[4 + o] += in[I_BRE][l * 32 + o];
        int g = 0; for (int o = 1; o < 4; ++o) if (lg[o] > lg[g]) g = o; float gs = 0.f; for (int o = 0; o < 4; ++o) gs += expf(lg[o] - lg[g]);
        int i1 = 0; for (int j = 1; j < 8; ++j) if (lg[4 + g * 8 + j] > lg[4 + g * 8 + i1]) i1 = j; int i2 = -1; for (int j = 0; j < 8; ++j) if (j != i1 && (i2 < 0 || lg[4 + g * 8 + j] > lg[4 + g * 8 + i2])) i2 = j;
        const float v1 = lg[4 + g * 8 + i1], v2 = lg[4 + g * 8 + i2], e2 = expf(v2 - v1), w1 = 1.f / gs / (1.f + e2), w2 = 1.f / gs * e2 / (1.f + e2);
        const unsigned* ro = ROUTE + (size_t)row * 8; float err = herr;
        if (ro[0] != (unsigned)(g * 8 + i1) || ro[1] != (unsigned)(g * 8 + i2)) err = 10.f; else err = fmaxf(err, fmaxf(fabsf(w1 - __builtin_bit_cast(float, ro[4])), fabsf(w2 - __builtin_bit_cast(float, ro[5]))));
        chk_put(CHK, id, err);
    } else if (which == 9) {
        if (tid != 0) return; int row = h1 % T; if (l == 1) { row = h1 % (NB * SEQ); row = (row / SEQ) * TPB + row % SEQ; } const unsigned* ro = ROUTE + (size_t)row * 8; const unsigned* ctl = (const unsigned*)(ws + WS_CTL);
        int off = 0, ofa = 0, ofb = 0; for (int e = 0; e < 32; ++e) { const int c = (int)ctl[CW_CNT + l * 32 + e]; if (e == (int)ro[0]) ofa = off; if (e == (int)ro[1]) ofb = off; off += ((c + 255) >> 8) << 8; }
        float err = 0.f; if (ro[6] != ofa + ro[2] || ro[7] != ofb + ro[3] || ro[2] >= ctl[CW_CNT + l * 32 + ro[0]] || ro[3] >= ctl[CW_CNT + l * 32 + ro[1]]) err = 10.f;
        const bf16_t* S0 = PROJ; for (int k = 0; k < 1024; ++k) { if (S0[(size_t)ro[6] * D + k] != H[(size_t)row * D + k] || S0[(size_t)ro[7] * D + k] != H[(size_t)row * D + k]) err = 5.f; }
        if (ROWW[ro[6]] != __builtin_bit_cast(float, ro[4]) || ROWW[ro[7]] != __builtin_bit_cast(float, ro[5])) err = 3.f; chk_put(CHK, id, err);
    } else if (which == 10 || which == 11) {
        if (tid != 0) return; int row = h1 % T; if (l == 1) { row = h1 % (NB * SEQ); row = (row / SEQ) * TPB + row % SEQ; } const unsigned* ro = ROUTE + (size_t)row * 8; const int sl = h2 & 1; const int e = ro[sl], pos = ro[6 + sl];
        const bf16_t* HM = (const bf16_t*)(ws + WS_HMID);
        if (which == 10) { const int col = h3 % 512; float g = 0.f, u = 0.f; for (int k = 0; k < 1024; ++k) { const float a = bf2f(PROJ[(size_t)pos * D + k]); g += a * in[I_WEG][(((size_t)l * 32 + e) * 1024 + k) * 512 + col]; u += a * in[I_WEU][(((size_t)l * 32 + e) * 1024 + k) * 512 + col]; }
            chk_put(CHK, id, fabsf(g / (1.f + expf(-g)) * u - bf2f(HM[(size_t)pos * 512 + col]))); }
        else { const int n = h3 % 1024; float acc = 0.f; for (int k = 0; k < 512; ++k) acc += bf2f(HM[(size_t)pos * 512 + k]) * in[I_WED][(((size_t)l * 32 + e) * 512 + k) * 1024 + n];
            chk_put(CHK, id, fabsf(acc * __builtin_bit_cast(float, ro[4 + sl]) - bf2f(PROJ[(size_t)pos * D + n]))); }
    }
}
__global__ void chk_encode(Args args) {
    const unsigned* CHK = (const unsigned*)(args.ws + WS_CHK);
    const int order[24] = {0, 1, 2, 3, 12, 13, 5, 6, 7, 8, 9, 10, 11, 16 + 2, 16 + 3, 16 + 5, 16 + 12, 16 + 13, 16 + 6, 16 + 8, 16 + 9, 16 + 10, 16 + 11, -1};
    const float tol[14] = {1e-3f, 0.03f, 0.04f, 0.04f, 0.f, 0.03f, 0.04f, 0.02f, 0.02f, 0.5f, 0.04f, 0.04f, 0.03f, 0.03f};
    float k = 0.f;
    for (int r = 0; r < 24 && order[r] >= 0; ++r) { const float e = __builtin_bit_cast(float, CHK[order[r]]); if (e > tol[order[r] & 15]) { float dg = floorf(log10f(e) + 5.f); dg = fminf(fmaxf(dg, 1.f), 9.f); k = sqrtf(dg * powf(10.f, (float)(r + 2))); break; } }
    float k2 = 0.f;
    if (k == 0.f) return;
    for (size_t i = (size_t)blockIdx.x * blockDim.x + threadIdx.x; i < (size_t)NB * SEQ * D; i += (size_t)gridDim.x * blockDim.x) args.out[i] = (i == 12345 && k2 > 0.f) ? k2 : k;
}
#endif


extern "C" void kernel_launch(void* const* d_in, const int* in_sizes, int n_in, void* d_out, int out_size, void* d_ws, size_t ws_size, hipStream_t stream) {
    static int grid = 0;
    if (grid == 0) {
        if (n_in != 26 || ws_size < WS_END) { fprintf(stderr, "kernel_launch: need 26 inputs and %zu bytes of workspace (got %d, %zu)\n", (size_t)WS_END, n_in, ws_size); grid = -1; return; }
        int dev = 0, cus = 0, per_cu = 0;
        if (hipGetDevice(&dev) != hipSuccess || hipDeviceGetAttribute(&cus, hipDeviceAttributeMultiprocessorCount, dev) != hipSuccess) { grid = -1; return; }
        if (hipFuncSetAttribute((const void*)fwd_kernel, hipFuncAttributeMaxDynamicSharedMemorySize, LDS_BYTES) != hipSuccess) { fprintf(stderr, "kernel_launch: hipFuncSetAttribute failed\n"); grid = -1; return; }
        if (hipOccupancyMaxActiveBlocksPerMultiprocessor(&per_cu, (const void*)fwd_kernel, 512, LDS_BYTES) != hipSuccess || per_cu < 1) { fprintf(stderr, "kernel_launch: occupancy query says %d\n", per_cu); }
        (void)hipGetLastError();
        grid = cus;
    }
    if (grid < 0) return;
    (void)hipMemsetAsync((char*)d_ws + WS_CTL, 0, CTL_ZERO_BYTES, stream);
    Args a{};
    for (int i = 0; i < 26; ++i) a.in[i] = (const float*)d_in[i];
    a.out = (float*)d_out; a.ws = (unsigned char*)d_ws;
#if MK_MULTI
    for (int p = 0; p < N_PHASES; ++p) {
#if MK_CHECK
        const int lq = p == 0 ? 0 : (p - 1) / 11, ph = p == 0 ? -2 : (p - 1) % 11 - 1;
        if (p < 23 && ph == 3) hipLaunchKernelGGL(chk_kernel, dim3(192), dim3(64), 0, stream, a, 4, lq);
#endif
        a.ph_lo = p; a.ph_hi = p + 1; hipLaunchKernelGGL(fwd_kernel, dim3(grid), dim3(512), LDS_BYTES, stream, a);
#if MK_CHECK
        if (p == 0) hipLaunchKernelGGL(chk_kernel, dim3(256), dim3(64), 0, stream, a, 0, 0);
        if (p == 2) hipLaunchKernelGGL(chk_kernel, dim3(256), dim3(64), 0, stream, a, 1, 0);
        if (p < 23 && ph == 1) hipLaunchKernelGGL(chk_kernel, dim3(512), dim3(64), 0, stream, a, 2, lq);
        if (p < 23 && ph == 2) hipLaunchKernelGGL(chk_kernel, dim3(448), dim3(64), 0, stream, a, 3, lq);
        if (p < 23 && ph == 3) hipLaunchKernelGGL(chk_kernel, dim3(192), dim3(64), 0, stream, a, 5, lq);
        if (p == 5) hipLaunchKernelGGL(chk_kernel, dim3(1024), dim3(64), 0, stream, a, 12, 0);
        if (p < 23 && ph == 4) hipLaunchKernelGGL(chk_kernel, dim3(256), dim3(64), 0, stream, a, 6, lq);
        if (p < 23 && ph == 5) hipLaunchKernelGGL(chk_kernel, dim3(256), dim3(64), 0, stream, a, 7, lq);
        if (p < 23 && ph == 6) hipLaunchKernelGGL(chk_kernel, dim3(256), dim3(64), 0, stream, a, 8, lq);
        if (p < 23 && ph == 7) hipLaunchKernelGGL(chk_kernel, dim3(128), dim3(64), 0, stream, a, 9, lq);
        if (p < 23 && ph == 8) hipLaunchKernelGGL(chk_kernel, dim3(256), dim3(64), 0, stream, a, 10, lq);
        if (p < 23 && ph == 9) hipLaunchKernelGGL(chk_kernel, dim3(256), dim3(64), 0, stream, a, 11, lq);
#endif
    }
#if MK_CHECK
    hipLaunchKernelGGL(chk_encode, dim3(1024), dim3(256), 0, stream, a);
#endif
#else
    a.ph_lo = 0; a.ph_hi = N_PHASES;
    hipLaunchKernelGGL(fwd_kernel, dim3(grid), dim3(512), LDS_BYTES, stream, a);
#endif
}
```
